# Optimizing an MI355X kernel written in HIP

```python
import jax, jax.numpy as jnp
from jax import lax
import numpy as np

D_MODEL = 1024
BATCH = 8
SEQ = 4096
DEPTH = 4

GRID_W = 64
CTX_LEN = 256
BRANCH_WIDTH = 512
M_HEADS = 4
M_HEAD_DIM = BRANCH_WIDTH // M_HEADS
M_CHUNK = 64
NA_HEADS = 8
NA_HEAD_DIM = BRANCH_WIDTH // NA_HEADS
NA_ROWS = 8
NA_COLS = 16
G_GROUPS = 4
G_CHUNK = 128
N_BRANCH = 3
N_EXPERTS = 32
TOP_K = 4
D_EXPERT = 1024
SWIGLU_ALPHA = 1.702
SWIGLU_LIMIT = 7.0
MOE_BLOCK = 256
ROPE_THETA = 10000.0
LN_EPS = 1e-5
DEEPNORM_ALPHA = (2 * DEPTH) ** 0.25
DEEPNORM_BETA = (8 * DEPTH) ** -0.25
PART_NAMES = ('m_q', 'm_k', 'm_v', 'm_o', 'm_gate', 'na_q', 'na_k', 'na_v', 'sg_u', 'sg_v', 'branch_gate')
IN_SPLITS = (BRANCH_WIDTH, BRANCH_WIDTH, BRANCH_WIDTH, BRANCH_WIDTH, 4 * M_HEADS, BRANCH_WIDTH, BRANCH_WIDTH, BRANCH_WIDTH, BRANCH_WIDTH, BRANCH_WIDTH, N_BRANCH * D_MODEL)
D_IN = 9 * BRANCH_WIDTH + 4 * M_HEADS + N_BRANCH * D_MODEL

kernel_name = 'hybrid_mlstm_natten_sgu_moe_dit'


def layer_norm(x, g, b):
    xf = x.astype(jnp.float32)
    mu = jnp.mean(xf, -1, keepdims=True)
    var = jnp.mean(jnp.square(xf - mu), -1, keepdims=True)
    y = (xf - mu) * lax.rsqrt(var + LN_EPS) * g.astype(jnp.float32) + b.astype(jnp.float32)
    return y.astype(x.dtype)


def split_heads(t, n_heads):
    B, L, W = t.shape
    return t.reshape(B, L, n_heads, W // n_heads).transpose(0, 2, 1, 3)


def merge_heads(t):
    B, H, L, d = t.shape
    return t.transpose(0, 2, 1, 3).reshape(B, L, H * d)


def project_parts(h, w_in, names):
    offs = np.cumsum((0,) + IN_SPLITS)
    out = {}
    for name in names:
        i = PART_NAMES.index(name)
        out[name] = h @ w_in[:, int(offs[i]):int(offs[i + 1])]
    return out


def axial_rope_tables(L, dtype):
    t = jnp.arange(L)
    pos = jnp.stack([t // GRID_W, t % GRID_W], axis=-1).astype(jnp.float32)
    n_freq = M_HEAD_DIM // 4
    inv = ROPE_THETA ** (-jnp.arange(n_freq, dtype=jnp.float32) / n_freq)
    ang = pos[:, :, None] * inv
    return jnp.cos(ang).astype(dtype), jnp.sin(ang).astype(dtype)


def apply_rope(x, cos, sin):
    B, H, L, dh = x.shape
    xr = x.reshape(B, H, L, 2, 2, dh // 4)
    x1, x2 = xr[..., 0, :], xr[..., 1, :]
    out = jnp.stack([x1 * cos - x2 * sin, x2 * cos + x1 * sin], axis=-2)
    return out.reshape(B, H, L, dh)


def mlstm_gates(g, gate_bias):
    B, L, _ = g.shape
    pre = g.astype(jnp.float32).reshape(B, L, 4, M_HEADS) + gate_bias.astype(jnp.float32)
    pre = pre.transpose(2, 0, 3, 1)
    return (pre[0], jax.nn.log_sigmoid(pre[1]), pre[2], jax.nn.log_sigmoid(pre[3]))


def mlstm_zero_state(B):
    return (jnp.zeros((B, M_HEADS, M_HEAD_DIM, M_HEAD_DIM), jnp.float32),
            jnp.zeros((B, M_HEADS, M_HEAD_DIM), jnp.float32),
            jnp.zeros((B, M_HEADS), jnp.float32))


def mlstm_chunkwise(q, k, v, log_i, log_f, state):
    B, H, L, dk = q.shape
    dv = v.shape[-1]
    T = M_CHUNK
    nc = L // T

    def chunks(a):
        return jnp.moveaxis(a.astype(jnp.float32).reshape(B, H, nc, T, *a.shape[3:]), 2, 0)

    xs = (chunks(q), chunks(k), chunks(v), chunks(log_i), chunks(log_f))
    lower = jnp.tril(jnp.ones((T, T), dtype=bool))

    def step(carry, inp):
        C, n, m = carry
        qc, kc, vc, li, lf = inp
        b = jnp.cumsum(lf, axis=-1)
        d_mat = jnp.where(lower, b[..., :, None] - b[..., None, :] + li[..., None, :], -jnp.inf)
        inter = b + m[..., None]
        m_loc = jnp.maximum(inter, jnp.max(d_mat, axis=-1))
        w_inter = jnp.exp(inter - m_loc)
        s = jnp.einsum('bhtd,bhsd->bhts', qc, kc) * jnp.exp(d_mat - m_loc[..., None])
        num = w_inter[..., None] * jnp.einsum('bhvd,bhtd->bhtv', C, qc) + jnp.einsum('bhts,bhsv->bhtv', s, vc)
        den = w_inter * jnp.einsum('bhd,bhtd->bht', n, qc) + jnp.sum(s, axis=-1)
        h = num / jnp.maximum(jnp.abs(den), jnp.exp(-m_loc))[..., None]
        b_end = b[..., -1]
        g = b_end[..., None] - b + li
        m_new = jnp.maximum(b_end + m, jnp.max(g, axis=-1))
        decay = jnp.exp(b_end + m - m_new)
        w = jnp.exp(g - m_new[..., None])
        C_new = decay[..., None, None] * C + jnp.einsum('bhs,bhsv,bhsd->bhvd', w, vc, kc)
        n_new = decay[..., None] * n + jnp.einsum('bhs,bhsd->bhd', w, kc)
        return (C_new, n_new, m_new), h

    state, hs = lax.scan(step, state, xs)
    h = jnp.moveaxis(hs, 0, 2).reshape(B, H, L, dv)
    return h, state


def mlstm_bidirectional(q, k, v, gates, state_f, state_b):
    li_f, lf_f, li_b, lf_b = gates
    h_f, s_f = mlstm_chunkwise(q, k, v, li_f, lf_f, state_f)
    fl = lambda a: jnp.flip(a, axis=2)
    h_b, s_b = mlstm_chunkwise(fl(q), fl(k), fl(v), fl(li_b), fl(lf_b), state_b)
    return h_f + fl(h_b), s_f, s_b


def mlstm_output(h, o, norm_g):
    mu = jnp.mean(h, -1, keepdims=True)
    var = jnp.mean(jnp.square(h - mu), -1, keepdims=True)
    hn = merge_heads((h - mu) * lax.rsqrt(var + LN_EPS)) * norm_g.astype(jnp.float32)
    return (hn * jax.nn.sigmoid(o.astype(jnp.float32))).astype(o.dtype)


def neighborhood_attention(q, k, v, k_ctx, v_ctx, rpb):
    B, H, L, d = q.shape
    rows = L // GRID_W
    wr = min(NA_ROWS, rows)
    scale = d ** -0.5
    q5 = q.reshape(B, H, rows, GRID_W, d)
    k5 = k.reshape(B, H, rows, GRID_W, d)
    v5 = v.reshape(B, H, rows, GRID_W, d)
    col = jnp.arange(GRID_W)
    col_start = jnp.clip(col - NA_COLS // 2, 0, GRID_W - NA_COLS)
    col_mask = (col[None, :] >= col_start[:, None]) & (col[None, :] < col_start[:, None] + NA_COLS)
    dc_idx = jnp.clip(col[None, :] - col[:, None] + NA_COLS - 1, 0, 2 * NA_COLS - 2)
    n_band = wr * GRID_W

    def row_block(r):
        rs = jnp.clip(r - wr // 2, 0, rows - wr)
        qr = lax.dynamic_index_in_dim(q5, r, axis=2, keepdims=False)
        kb = lax.dynamic_slice_in_dim(k5, rs, wr, axis=2)
        vb = lax.dynamic_slice_in_dim(v5, rs, wr, axis=2)
        dr_idx = rs + jnp.arange(wr) - r + NA_ROWS - 1
        bias = rpb[:, dr_idx[:, None, None], dc_idx[None, :, :]]
        s_lat = jnp.einsum('bhqd,bhwkd->bhqwk', qr, kb).astype(jnp.float32) * scale
        s_lat = s_lat + jnp.transpose(bias, (0, 2, 1, 3)).astype(jnp.float32)
        s_lat = jnp.where(col_mask[:, None, :], s_lat, -jnp.inf)
        s_ctx = jnp.einsum('bhqd,bhcd->bhqc', qr, k_ctx).astype(jnp.float32) * scale
        s = jnp.concatenate([s_lat.reshape(B, H, GRID_W, n_band), s_ctx], axis=-1)
        p = jax.nn.softmax(s, axis=-1).astype(v.dtype)
        p_lat = p[..., :n_band].reshape(B, H, GRID_W, wr, GRID_W)
        return (jnp.einsum('bhqwk,bhwkd->bhqd', p_lat, vb)
                + jnp.einsum('bhqc,bhcd->bhqd', p[..., n_band:], v_ctx))

    out = lax.map(row_block, jnp.arange(rows))
    return out.transpose(1, 2, 0, 3, 4).reshape(B, H, L, d)


def context_attention(q, k, v):
    s = jnp.einsum('bhqd,bhkd->bhqk', q, k).astype(jnp.float32) * (q.shape[-1] ** -0.5)
    p = jax.nn.softmax(s, axis=-1).astype(v.dtype)
    return jnp.einsum('bhqk,bhkd->bhqd', p, v)


def spatial_gating(u, v, ln_g, ln_b, w_s, b_s):
    B, L, W = u.shape
    u = jax.nn.gelu(u)
    v = layer_norm(jax.nn.gelu(v), ln_g, ln_b)
    v5 = v.reshape(B, L // G_CHUNK, G_CHUNK, G_GROUPS, W // G_GROUPS)
    mixed = jnp.einsum('bnpgc,gqp->bnqgc', v5, w_s) + b_s.T[None, None, :, :, None]
    return u * mixed.reshape(B, L, W)


def branch_merge(a, b, c, gate_pre, w_branch, w_out):
    ga, gb, gc = jnp.split(gate_pre, N_BRANCH, axis=-1)
    merged = (jax.nn.sigmoid(ga) * (a @ w_branch[0]) + jax.nn.sigmoid(gb) * (b @ w_branch[1])
              + jax.nn.sigmoid(gc) * (c @ w_branch[2]))
    return merged @ w_out


def token_mixers(hl, hc, w_in, gate_bias, norm_g, rpb, sg_ln_g, sg_ln_b, sg_w, sg_b, w_branch, w_out, cos, sin, update_ctx):
    B = hl.shape[0]
    lat = project_parts(hl, w_in, PART_NAMES)
    ctx_names = PART_NAMES if update_ctx else ('m_q', 'm_k', 'm_v', 'm_gate', 'na_k', 'na_v')
    cx = project_parts(hc, w_in, ctx_names)
    qs = M_HEAD_DIM ** -0.5
    zero = mlstm_zero_state(B)
    h_cm, st_f, st_b = mlstm_bidirectional(
        split_heads(cx['m_q'], M_HEADS) * qs, split_heads(cx['m_k'], M_HEADS), split_heads(cx['m_v'], M_HEADS),
        mlstm_gates(cx['m_gate'], gate_bias), zero, zero)
    q_m = apply_rope(split_heads(lat['m_q'], M_HEADS) * qs, cos, sin)
    k_m = apply_rope(split_heads(lat['m_k'], M_HEADS), cos, sin)
    h_lm, _, _ = mlstm_bidirectional(q_m, k_m, split_heads(lat['m_v'], M_HEADS),
                                     mlstm_gates(lat['m_gate'], gate_bias), st_f, st_b)
    a_l = mlstm_output(h_lm, lat['m_o'], norm_g)
    k_nc = split_heads(cx['na_k'], NA_HEADS)
    v_nc = split_heads(cx['na_v'], NA_HEADS)
    b_l = merge_heads(neighborhood_attention(split_heads(lat['na_q'], NA_HEADS), split_heads(lat['na_k'], NA_HEADS),
                                             split_heads(lat['na_v'], NA_HEADS), k_nc, v_nc, rpb))
    c_l = spatial_gating(lat['sg_u'], lat['sg_v'], sg_ln_g, sg_ln_b, sg_w, sg_b)
    y_l = branch_merge(a_l, b_l, c_l, lat['branch_gate'], w_branch, w_out)
    if not update_ctx:
        return y_l, None
    a_c = mlstm_output(h_cm, cx['m_o'], norm_g)
    b_c = merge_heads(context_attention(split_heads(cx['na_q'], NA_HEADS), k_nc, v_nc))
    c_c = spatial_gating(cx['sg_u'], cx['sg_v'], sg_ln_g, sg_ln_b, sg_w, sg_b)
    y_c = branch_merge(a_c, b_c, c_c, cx['branch_gate'], w_branch, w_out)
    return y_l, y_c


def moe(h, router_w, router_b, w_gu, b_gu, w_dn, b_dn):
    N, D = h.shape
    nk = N * TOP_K
    logits = (h @ router_w + router_b).astype(jnp.float32)
    top_val, top_idx = lax.top_k(logits, TOP_K)
    gates = jax.nn.softmax(top_val, axis=-1)
    flat_e = top_idx.reshape(-1)
    flat_tok = jnp.repeat(jnp.arange(N, dtype=jnp.int32), TOP_K)
    flat_w = gates.reshape(-1)
    order = jnp.argsort(flat_e)
    se = flat_e[order]
    counts = jnp.bincount(flat_e, length=N_EXPERTS)
    starts = jnp.cumsum(counts) - counts
    padded = (counts + MOE_BLOCK - 1) // MOE_BLOCK * MOE_BLOCK
    pends = jnp.cumsum(padded)
    pstarts = pends - padded
    dest = pstarts[se] + (jnp.arange(nk) - starts[se])
    n_blocks = -(-nk // MOE_BLOCK) + N_EXPERTS
    n_rows = n_blocks * MOE_BLOCK
    row_tok = jnp.full((n_rows,), N, dtype=jnp.int32).at[dest].set(flat_tok[order])
    row_w = jnp.zeros((n_rows,), h.dtype).at[dest].set(flat_w[order].astype(h.dtype))
    blk_e = jnp.minimum(jnp.searchsorted(pends, jnp.arange(n_blocks) * MOE_BLOCK, side='right'), N_EXPERTS - 1)
    h_pad = jnp.concatenate([h, jnp.zeros((1, D), h.dtype)], axis=0)

    def expert_block(args):
        toks, e = args
        xb = h_pad[toks]
        gu = xb @ w_gu[e] + b_gu[e]
        gate, up = jnp.split(gu, 2, axis=-1)
        gate = jnp.minimum(gate, SWIGLU_LIMIT)
        up = jnp.clip(up, -SWIGLU_LIMIT, SWIGLU_LIMIT)
        act = gate * jax.nn.sigmoid(SWIGLU_ALPHA * gate) * (up + 1.0)
        return act @ w_dn[e] + b_dn[e]

    ys = lax.map(expert_block, (row_tok.reshape(n_blocks, MOE_BLOCK), blk_e))
    out = jnp.zeros((N + 1, D), h.dtype).at[row_tok].add(ys.reshape(n_rows, D) * row_w[:, None])
    return out[:N]


def setup_inputs(seed: int = 0) -> dict:
    key = jax.random.key(seed)
    ks = jax.random.split(key, 26)
    f32 = jnp.float32

    def nrm(k, shape, s):
        return jax.random.normal(k, shape, f32) * s

    gb_noise = nrm(ks[7], (DEPTH, 4, M_HEADS), 0.1)
    f_bias = jnp.linspace(3.0, 6.0, M_HEADS, dtype=f32)
    is_forget = jnp.array([0.0, 1.0, 0.0, 1.0], f32)
    return {
        'x': nrm(ks[0], (BATCH, SEQ, D_MODEL), 1.0),
        'c': nrm(ks[1], (BATCH, D_MODEL), 1.0),
        'ctx': nrm(ks[2], (BATCH, CTX_LEN, D_MODEL), 1.0),
        'c_ctx': nrm(ks[3], (D_MODEL,), 1.0),
        'w_mod': nrm(ks[4], (DEPTH, D_MODEL, 6 * D_MODEL), 0.5 * D_MODEL ** -0.5),
        'b_mod': nrm(ks[5], (DEPTH, 6 * D_MODEL), 0.01),
        'w_in': nrm(ks[6], (DEPTH, D_MODEL, D_IN), D_MODEL ** -0.5),
        'mlstm_gate_bias': gb_noise + is_forget[None, :, None] * f_bias[None, None, :],
        'mlstm_norm_g': 1.0 + nrm(ks[8], (DEPTH, BRANCH_WIDTH), 0.1),
        'na_rpb': nrm(ks[9], (DEPTH, NA_HEADS, 2 * NA_ROWS - 1, 2 * NA_COLS - 1), 0.1),
        'sgu_ln_g': 1.0 + nrm(ks[10], (DEPTH, BRANCH_WIDTH), 0.1),
        'sgu_ln_b': nrm(ks[11], (DEPTH, BRANCH_WIDTH), 0.01),
        'sgu_w': nrm(ks[12], (DEPTH, G_GROUPS, G_CHUNK, G_CHUNK), G_CHUNK ** -0.5),
        'sgu_b': 1.0 + nrm(ks[13], (DEPTH, G_GROUPS, G_CHUNK), 0.1),
        'w_branch': nrm(ks[14], (DEPTH, N_BRANCH, BRANCH_WIDTH, D_MODEL), BRANCH_WIDTH ** -0.5),
        'w_out': nrm(ks[15], (DEPTH, D_MODEL, D_MODEL), DEEPNORM_BETA * D_MODEL ** -0.5),
        'ln1_g': 1.0 + nrm(ks[16], (DEPTH, D_MODEL), 0.1),
        'ln1_b': nrm(ks[17], (DEPTH, D_MODEL), 0.01),
        'router_w': nrm(ks[18], (DEPTH, D_MODEL, N_EXPERTS), D_MODEL ** -0.5),
        'router_b': nrm(ks[19], (DEPTH, N_EXPERTS), 0.01),
        'exp_w_gu': nrm(ks[20], (DEPTH, N_EXPERTS, D_MODEL, 2 * D_EXPERT), D_MODEL ** -0.5),
        'exp_b_gu': nrm(ks[21], (DEPTH, N_EXPERTS, 2 * D_EXPERT), 0.01),
        'exp_w_dn': nrm(ks[22], (DEPTH, N_EXPERTS, D_EXPERT, D_MODEL), DEEPNORM_BETA * D_EXPERT ** -0.5),
        'exp_b_dn': nrm(ks[23], (DEPTH, N_EXPERTS, D_MODEL), 0.01),
        'ln2_g': 1.0 + nrm(ks[24], (DEPTH, D_MODEL), 0.1),
        'ln2_b': nrm(ks[25], (DEPTH, D_MODEL), 0.01),
    }


def reference(x, c, ctx, c_ctx, w_mod, b_mod, w_in, mlstm_gate_bias, mlstm_norm_g, na_rpb, sgu_ln_g, sgu_ln_b,
              sgu_w, sgu_b, w_branch, w_out, ln1_g, ln1_b, router_w, router_b, exp_w_gu, exp_b_gu, exp_w_dn,
              exp_b_dn, ln2_g, ln2_b):
    B, L, D = x.shape
    n_ctx = ctx.shape[1]
    cos, sin = axial_rope_tables(L, x.dtype)
    s_lat = jax.nn.silu(c)
    s_ctx = jax.nn.silu(c_ctx)
    xl, xc = x, ctx
    for layer in range(DEPTH):
        update_ctx = layer < DEPTH - 1
        mod_l = (s_lat @ w_mod[layer] + b_mod[layer])[:, None, :]
        mod_c = s_ctx @ w_mod[layer] + b_mod[layer]
        sh1, sc1, g1, sh2, sc2, g2 = jnp.split(mod_l, 6, axis=-1)
        csh1, csc1, cg1, csh2, csc2, cg2 = jnp.split(mod_c, 6, axis=-1)
        y_l, y_c = token_mixers(xl * (1.0 + sc1) + sh1, xc * (1.0 + csc1) + csh1, w_in[layer],
                                mlstm_gate_bias[layer], mlstm_norm_g[layer], na_rpb[layer], sgu_ln_g[layer],
                                sgu_ln_b[layer], sgu_w[layer], sgu_b[layer], w_branch[layer], w_out[layer],
                                cos, sin, update_ctx)
        xl = layer_norm(DEEPNORM_ALPHA * xl + g1 * y_l, ln1_g[layer], ln1_b[layer])
        h_l = xl * (1.0 + sc2) + sh2
        if update_ctx:
            xc = layer_norm(DEEPNORM_ALPHA * xc + cg1 * y_c, ln1_g[layer], ln1_b[layer])
            h_c = xc * (1.0 + csc2) + csh2
            tokens = jnp.concatenate([h_l.reshape(B * L, D), h_c.reshape(B * n_ctx, D)], axis=0)
        else:
            tokens = h_l.reshape(B * L, D)
        f = moe(tokens, router_w[layer], router_b[layer], exp_w_gu[layer], exp_b_gu[layer],
                exp_w_dn[layer], exp_b_dn[layer])
        xl = layer_norm(DEEPNORM_ALPHA * xl + g2 * f[:B * L].reshape(B, L, D), ln2_g[layer], ln2_b[layer])
        if update_ctx:
            xc = layer_norm(DEEPNORM_ALPHA * xc + cg2 * f[B * L:].reshape(B, n_ctx, D), ln2_g[layer], ln2_b[layer])
    return xl
```

```cpp
#include <hip/hip_runtime.h>
#include <cstdio>
#include <cstdint>

#define LAS __attribute__((address_space(3)))
typedef unsigned short bf16_t;
typedef short bf16x8 __attribute__((ext_vector_type(8)));
typedef short s16x4 __attribute__((ext_vector_type(4)));
typedef float f32x4 __attribute__((ext_vector_type(4)));
typedef float f32x2 __attribute__((ext_vector_type(2)));
typedef unsigned u32x4 __attribute__((ext_vector_type(4)));
typedef unsigned u32x2 __attribute__((ext_vector_type(2)));
#define DI __device__ __forceinline__

constexpr int D = 1024, NB = 8, SEQ = 4096, NCTX = 256, ML = NB * SEQ, MC = NB * NCTX, MT = ML + MC, DEPTH = 4;
constexpr int NPROJ = 7680, DIN = 7696, NEXP = 32, TOPK = 4;
constexpr int NROWS_MAX = (MT * TOPK / 256 + NEXP) * 256;
constexpr int NCHAIN = 2 * NB * 4, NSLOT = 68;
constexpr float LN_EPS = 1e-5f;
constexpr float DN_ALPHA = 1.6817928305074290f;
constexpr int PQ = 0, PK = 512, PV = 1024, PO = 1536, PNQ = 2048, PNK = 2560, PNV = 3072, PSU = 3584, PSV = 4096, PBG = 4608;

constexpr size_t al256(size_t x) { return (x + 255) & ~(size_t)255; }
constexpr size_t WS_CTL = 0, CTL_BYTES = 65536;
constexpr size_t WS_MOD = WS_CTL + CTL_BYTES;
constexpr size_t WS_ROPE = al256(WS_MOD + (size_t)4 * 9 * 6144 * 4);
constexpr size_t WS_WGATE = al256(WS_ROPE + 64 * 32 * 8);
constexpr size_t WS_WIN = al256(WS_WGATE + (size_t)4 * 16 * 1024 * 4);
constexpr size_t WS_WBR = al256(WS_WIN + (size_t)4 * NPROJ * 1024 * 2);
constexpr size_t WS_WOUT = al256(WS_WBR + (size_t)4 * 3 * 1024 * 512 * 2);
constexpr size_t WS_WGU = al256(WS_WOUT + (size_t)4 * 1024 * 1024 * 2);
constexpr size_t WS_WDN = al256(WS_WGU + (size_t)4 * 32 * 2048 * 1024 * 2);
constexpr size_t WS_X = al256(WS_WDN + (size_t)4 * 32 * 1024 * 1024 * 2);
constexpr size_t WS_H = al256(WS_X + (size_t)MT * D * 4);
constexpr size_t WS_H2 = al256(WS_H + (size_t)MT * D * 2);
constexpr size_t WS_P = al256(WS_H2 + (size_t)MT * D * 2);
constexpr size_t WS_GPRE = al256(WS_P + (size_t)MT * NPROJ * 2);
constexpr size_t WS_GA = al256(WS_GPRE + (size_t)MT * 16 * 4);
constexpr size_t WS_GCM = al256(WS_GA + (size_t)NCHAIN * NSLOT * 64 * 4);
constexpr size_t WS_GB = al256(WS_GCM + (size_t)NCHAIN * NSLOT * 64 * 4);
constexpr size_t WS_UC = al256(WS_GB + (size_t)NCHAIN * NSLOT * 64 * 4);
constexpr size_t WS_UN = al256(WS_UC + (size_t)NCHAIN * NSLOT * 128 * 128 * 2);
constexpr size_t WS_ABC = al256(WS_UN + (size_t)NCHAIN * NSLOT * 128 * 4);
constexpr size_t WS_MRG = al256(WS_ABC + (size_t)MT * 1536 * 2);
constexpr size_t WS_Y = al256(WS_MRG + (size_t)MT * D * 2);
constexpr size_t WS_TOPE = al256(WS_Y + (size_t)MT * D * 2);
constexpr size_t WS_TOPG = al256(WS_TOPE + (size_t)MT * 16);
constexpr size_t WS_TOPR = al256(WS_TOPG + (size_t)MT * 16);
constexpr size_t WS_DEST = al256(WS_TOPR + (size_t)MT * 16);
constexpr size_t WS_BASE = al256(WS_DEST + (size_t)MT * 16);
constexpr size_t WS_BLKE = al256(WS_BASE + 256 * 32 * 4);
constexpr size_t WS_XG = al256(WS_BLKE + 4096);
constexpr size_t WS_ACT = al256(WS_XG + (size_t)NROWS_MAX * D * 2);
constexpr size_t WS_YS = al256(WS_ACT + (size_t)NROWS_MAX * D * 2);
constexpr size_t SM_GBIAS = 0, SM_NORMG = SM_GBIAS + 64, SM_RPB = SM_NORMG + 2048, SM_SGLNG = SM_RPB + 14880, SM_SGLNB = SM_SGLNG + 2048, SM_SGW = SM_SGLNB + 2048, SM_SGB = SM_SGW + 262144,
                 SM_LN1G = SM_SGB + 2048, SM_LN1B = SM_LN1G + 4096, SM_RW = SM_LN1B + 4096, SM_RB = SM_RW + 131072, SM_BGU = SM_RB + 128, SM_BDN = SM_BGU + 262144, SM_LN2G = SM_BDN + 131072,
                 SM_LN2B = SM_LN2G + 4096, SM_END = SM_LN2B + 4096;
constexpr size_t WS_SM = al256(WS_YS + (size_t)NROWS_MAX * D * 2);
constexpr size_t WS_END = al256(WS_SM + SM_END * 4);
constexpr int CW_BAR = 0;
constexpr int CW_CNT = 16000;
static_assert((CW_CNT + 4 * 32) * 4 <= (int)CTL_BYTES, "ctl");

constexpr int LDS_BYTES = 147456;
constexpr int LDS_MISC = 147456 - 256;

DI unsigned f2bf(float f) { unsigned u = __builtin_bit_cast(unsigned, f); return (u + 0x7fffu + ((u >> 16) & 1u)) >> 16; }
DI unsigned pk2(float lo, float hi) { return f2bf(lo) | (f2bf(hi) << 16); }
DI float bf2f(unsigned b) { return __builtin_bit_cast(float, (b & 0xffffu) << 16); }
DI float bflo(unsigned w) { return __builtin_bit_cast(float, w << 16); }
DI float bfhi(unsigned w) { return __builtin_bit_cast(float, w & 0xffff0000u); }
DI unsigned cvt_pk_bf16(float lo, float hi) { unsigned r; asm volatile("v_cvt_pk_bf16_f32 %0, %1, %2" : "=v"(r) : "v"(lo), "v"(hi)); return r; }
DI float wave_sum(float v) { for (int o = 32; o >= 1; o >>= 1) v += __shfl_xor(v, o); return v; }
DI float wave_max(float v) { for (int o = 32; o >= 1; o >>= 1) v = fmaxf(v, __shfl_xor(v, o)); return v; }
DI float sigmoidf_(float x) { return 1.0f / (1.0f + __expf(-x)); }
DI float gelu_tanh(float x) { const float u = 0.7978845608028654f * (x + 0.044715f * x * x * x); const float e = __expf(2.0f * u); const float t = 1.0f - 2.0f / (e + 1.0f); return 0.5f * x * (1.0f + t); }
DI float log_sigmoid(float x) { return -(fmaxf(-x, 0.0f) + log1pf(expf(-fabsf(x)))); }
__host__ __device__ inline int rope_d(int p) { const int u = p >> 3, e = p & 7; return (u >> 3) * 64 + (e >> 2) * 32 + (u & 7) * 4 + (e & 3); }

DI int ltid() { int t = threadIdx.x; asm volatile("" : "+v"(t)); return t; }
DI int lbid() { int b = blockIdx.x; asm volatile("" : "+s"(b)); return b; }
DI int lgdim() { int g = gridDim.x; asm volatile("" : "+s"(g)); return g; }
template <int N> DI float bfly(float (&v)[N], int lane) {
    int off = 32;
#pragma unroll
    for (int n = N; n > 1; n >>= 1) {
        const unsigned mk = (lane & off) ? 0xffffffffu : 0u;
#pragma unroll
        for (int i = 0; i < n / 2; ++i) { const unsigned a = __builtin_bit_cast(unsigned, v[i]), b = __builtin_bit_cast(unsigned, v[i + n / 2]);
            const float keep = __builtin_bit_cast(float, (a & ~mk) | (b & mk)); const float send = __builtin_bit_cast(float, (b & ~mk) | (a & mk)); v[i] = keep + __shfl_xor(send, off); }
        off >>= 1;
    }
    for (; off >= 1; off >>= 1) v[0] += __shfl_xor(v[0], off);
    return v[0];
}

#define XB_TMO      128
#define XB_XCNT(j)  (256  + 64 * (j))
#define XB_XSUB(j)  (1280 + 64 * (j))
#define XB_XGEN(j)  (2304 + 64 * (j))
#define XB_TOP      3328
#define XB_TOPGEN   3392
#define XCD_BAR_WORDS 3456
#define XB_SPIN_CAP (1u << 22)
DI unsigned xb_ld(unsigned* p)              { return __hip_atomic_load(p, __ATOMIC_RELAXED, __HIP_MEMORY_SCOPE_AGENT); }
DI unsigned xb_add(unsigned* p, unsigned v) { return __hip_atomic_fetch_add(p, v, __ATOMIC_RELAXED, __HIP_MEMORY_SCOPE_AGENT); }
DI unsigned xb_xcc_id() { return (unsigned)__builtin_amdgcn_s_getreg((3 << 11) | 20) & 0xFu; }
#define XB_SPIN(cond, bar) do { unsigned _sp = 0; while (cond) { __builtin_amdgcn_s_sleep(1); \
    if ((++_sp & 255u) == 0u) { if (xb_ld(&(bar)[XB_TMO])) break; if (_sp > XB_SPIN_CAP) { atomicAdd(&(bar)[XB_TMO], 1u); break; } } } } while (0)
struct XcdBarrier { unsigned* bar; unsigned x; volatile LAS unsigned* st; };
DI XcdBarrier xcd_barrier_post(unsigned* bar, volatile LAS unsigned* st) {
    XcdBarrier b; b.bar = bar; b.x = xb_xcc_id(); b.st = st;
    if (threadIdx.x == 0) (void)xb_add(&bar[XB_XCNT(b.x)], 1u);
    return b;
}
DI void xcd_barrier_complete(unsigned* bar, unsigned x, unsigned& nloc, unsigned& nx) {
    const unsigned G = gridDim.x * gridDim.y * gridDim.z;
    unsigned sum, cnt, mine, sp = 0u;
    for (;;) {
        sum = 0u; cnt = 0u; mine = 0u;
#pragma unroll
        for (unsigned j = 0; j < 16; ++j) { const unsigned c = xb_ld(&bar[XB_XCNT(j)]); sum += c; cnt += (c > 0u) ? 1u : 0u; mine = (j == x) ? c : mine; }
        if (sum == G) break;
        __builtin_amdgcn_s_sleep(1);
        if ((++sp & 255u) == 0u) { if (xb_ld(&bar[XB_TMO])) break; if (sp > XB_SPIN_CAP) { atomicAdd(&bar[XB_TMO], 1u); break; } }
    }
    nloc = mine > 0u ? mine : 1u; nx = cnt > 0u ? cnt : 1u;
}
DI void xcd_barrier(const XcdBarrier& b) {
    asm volatile("s_waitcnt vmcnt(0)" ::: "memory");
    __syncthreads();
    if (threadIdx.x == 0) {
        unsigned* bar = b.bar;
        __builtin_amdgcn_s_waitcnt(0);
        unsigned nloc = b.st[0], nx = b.st[1];
        if (nloc == 0u) { xcd_barrier_complete(bar, b.x, nloc, nx); b.st[0] = nloc; b.st[1] = nx; }
        const unsigned old = xb_add(&bar[XB_XSUB(b.x)], 1u);
        const unsigned gen = old / nloc;
        if (old + 1u == (gen + 1u) * nloc) {
            __builtin_amdgcn_fence(__ATOMIC_RELEASE, "agent");
            asm volatile("s_waitcnt vmcnt(0)" ::: "memory");
            const unsigned og = xb_add(&bar[XB_TOP], 1u);
            const unsigned tg = og / nx;
            if (og + 1u == (tg + 1u) * nx) xb_add(&bar[XB_TOPGEN], 1u);
            else XB_SPIN(xb_ld(&bar[XB_TOPGEN]) == tg, bar);
            __builtin_amdgcn_fence(__ATOMIC_ACQUIRE, "agent");
            xb_add(&bar[XB_XGEN(b.x)], 1u);
            asm volatile("s_waitcnt vmcnt(0)" ::: "memory");
        } else {
            XB_SPIN(xb_ld(&bar[XB_XGEN(b.x)]) == gen, bar);
            __builtin_amdgcn_fence(__ATOMIC_ACQUIRE, "agent");
            asm volatile("s_waitcnt vmcnt(0)" ::: "memory");
        }
    }
    __syncthreads();
}
namespace pg8 {
constexpr int BM = 256, BK = 64, HALF = 128, HTB = HALF * BK * 2, STAGE_BYTES = 8 * HTB, NXCD = 8, WGM = 8;
__host__ __device__ __forceinline__ int lds_byte(int r, int c) { const int st = (r >> 4) * 2 + (c >> 5), rr = r & 15, cc = c & 31, ob = rr * 64 + cc * 2; return st * 1024 + (ob ^ (((ob >> 9) & 1) << 5)); }
__host__ __device__ __forceinline__ void stage_rc(int b, int& R, int& C) { const int st = b / 1024, sb = b % 1024, swz = sb ^ (((sb >> 9) & 1) << 5); R = (st >> 1) * 16 + swz / 64; C = (st & 1) * 32 + (swz % 64) / 2; }
__host__ __device__ __forceinline__ int perm32(int rho) { const int n = rho >> 4, i = rho & 15; return 8 * (i >> 2) + 4 * n + (i & 3); }

struct Unit { int pm, pn, aux; };

struct TileOrder {
    int nM, nN, nwg, G, c;
    __device__ void init(int nM_, int nN_, int G_, int c_) { nM = nM_; nN = nN_; nwg = nM * nN; G = G_; c = c_; }
    __device__ bool tile(int i, int& pm, int& pn) const {
        const long L = (long)i * G + c; if (L >= nwg) return false;
        int wgid = (int)L; { const int q = nwg / NXCD, r = nwg % NXCD, xcd = wgid % NXCD, off = wgid / NXCD; wgid = (xcd < r ? xcd * (q + 1) : r * (q + 1) + (xcd - r) * q) + off; }
        const int nig = WGM * nN, gid = wgid / nig, fm = gid * WGM, gsz = (nM - fm) < WGM ? (nM - fm) : WGM;
        pm = fm + ((wgid % nig) % gsz); pn = (wgid % nig) / gsz; return true;
    }
};

template <class Epi, class Sched>
__device__ __forceinline__ void gemm_phase(LAS unsigned char* lds, const int K, const Sched& S, const Epi& E) {
    const int tid = ltid(), wid = __builtin_amdgcn_readfirstlane(tid >> 6), lane = tid & 63, wr = wid >> 2, wc = wid & 3, fr = lane & 15, fq = lane >> 4;
    const int nt = K / BK;
    unsigned voffA[2], voffB[2]; const int lda = S.lda;
#pragma unroll
    for (int i = 0; i < 2; ++i) { int R, C; stage_rc(tid * 16 + i * 8192, R, C); const int Rb = (R & ~31) + perm32(R & 31); voffA[i] = (unsigned)(R * lda + C) * 2u; voffB[i] = (unsigned)(Rb * K + C) * 2u; }
    const size_t kstep = (size_t)(BK * 2);
    const size_t hstep = (size_t)HALF * K * 2;
    const size_t hstepA = (size_t)HALF * lda * 2;
    const unsigned ldsw = (unsigned)wid * 1024u;
    const int aoff = lds_byte(wr * 64 + fr, fq * 8), boff = lds_byte(wc * 32 + fr, fq * 8);
#define PG8_SA(b, h) (((b) * 2 + (h)) * HTB)
#define PG8_SB(b, h) ((4 + (b) * 2 + (h)) * HTB)
#define PG8_STAGE(bufoff, gbase, voff) do { _Pragma("unroll") for (int _i = 0; _i < 2; ++_i) \
        __builtin_amdgcn_global_load_lds((const unsigned*)((const char*)(gbase) + (voff)[_i]), (LAS unsigned*)(lds + (bufoff) + ldsw + _i * 8192), 16, 0, 0); } while (0)
#define PG8_LDA(dst, b, h) do { _Pragma("unroll") for (int m = 0; m < 4; ++m) _Pragma("unroll") for (int k = 0; k < 2; ++k) dst[m][k] = *(const LAS bf16x8*)(lds + PG8_SA(b, h) + aoff + m * 2048 + k * 1024); } while (0)
#define PG8_LDB(dst, b, h) do { _Pragma("unroll") for (int n = 0; n < 2; ++n) _Pragma("unroll") for (int k = 0; k < 2; ++k) dst[n][k] = *(const LAS bf16x8*)(lds + PG8_SB(b, h) + boff + n * 2048 + k * 1024); } while (0)
#define PG8_MMA(ai, bj, At, Bt) do { __builtin_amdgcn_s_setprio(1); _Pragma("unroll") for (int m = 0; m < 4; ++m) _Pragma("unroll") for (int n = 0; n < 2; ++n) _Pragma("unroll") for (int k = 0; k < 2; ++k) \
        acc[ai][bj][m][n] = __builtin_amdgcn_mfma_f32_16x16x32_bf16(Bt[n][k], At[m][k], acc[ai][bj][m][n], 0, 0, 0); __builtin_amdgcn_s_setprio(0); } while (0)
#define PG8_WAIT_V(n) asm volatile("s_waitcnt vmcnt(" #n ")" ::: "memory")
#define PG8_WAIT_L(n) asm volatile("s_waitcnt lgkmcnt(" #n ")" ::: "memory")
#define PG8_BAR __builtin_amdgcn_s_barrier()
#define PG8_SCHED __builtin_amdgcn_sched_barrier(0)
    Unit cur, nxt; int ui = 0;
    if (!S.next(0, cur)) return;
    f32x4 acc[2][2][4][2];
#pragma unroll
    for (int a = 0; a < 2; ++a)
#pragma unroll
        for (int b = 0; b < 2; ++b)
#pragma unroll
            for (int m = 0; m < 4; ++m)
#pragma unroll
                for (int n = 0; n < 2; ++n) acc[a][b][m][n] = (f32x4){0.f, 0.f, 0.f, 0.f};
    bf16x8 At[4][2], B0[2][2], B1[2][2];
    const char* cA = S.a_base(cur); const char* cB = S.b_base(cur);
    PG8_STAGE(PG8_SB(0, 0), cB, voffB); PG8_STAGE(PG8_SB(0, 1), cB + hstep, voffB); PG8_STAGE(PG8_SA(0, 0), cA, voffA); PG8_STAGE(PG8_SA(0, 1), cA + hstepA, voffA);
    if (wr == 1) PG8_BAR;
    PG8_WAIT_V(2); PG8_BAR;
    PG8_STAGE(PG8_SB(1, 0), cB + kstep, voffB); PG8_STAGE(PG8_SA(1, 0), cA + kstep, voffA); PG8_STAGE(PG8_SB(1, 1), cB + hstep + kstep, voffB);
    PG8_WAIT_V(6); PG8_BAR;
    for (;;) {
        const bool has_next = S.next(ui + 1, nxt);
        const char* nA = has_next ? S.a_base(nxt) : cA; const char* nB = has_next ? S.b_base(nxt) : cB;
        for (int t = 0; t < nt; t += 2) {
            const bool last = (t == nt - 2);
            const char* a1 = cA + (size_t)(t + 1) * kstep;
            const char* a2 = last ? nA : cA + (size_t)(t + 2) * kstep; const char* b2 = last ? nB : cB + (size_t)(t + 2) * kstep;
            const char* a3 = a2 + kstep; const char* b3 = b2 + kstep;
            PG8_LDB(B0, 0, 0); PG8_LDB(B1, 0, 1); PG8_SCHED; PG8_LDA(At, 0, 0); PG8_STAGE(PG8_SA(1, 1), a1 + hstepA, voffA);
            PG8_WAIT_V(8); PG8_WAIT_L(0); PG8_BAR; PG8_MMA(0, 0, At, B0); PG8_MMA(0, 1, At, B1); PG8_BAR; PG8_SCHED;
            PG8_LDA(At, 0, 1); PG8_STAGE(PG8_SB(0, 0), b2, voffB); PG8_STAGE(PG8_SB(0, 1), b2 + hstep, voffB); PG8_STAGE(PG8_SA(0, 0), a2, voffA);
            PG8_WAIT_V(8); PG8_WAIT_L(0); PG8_BAR; PG8_MMA(1, 0, At, B0); PG8_MMA(1, 1, At, B1); PG8_BAR; PG8_SCHED;
            PG8_LDB(B0, 1, 0); PG8_LDB(B1, 1, 1); PG8_SCHED; PG8_LDA(At, 1, 0); PG8_STAGE(PG8_SA(0, 1), a2 + hstepA, voffA);
            PG8_WAIT_V(8); PG8_WAIT_L(0); PG8_BAR; PG8_MMA(0, 0, At, B0); PG8_MMA(0, 1, At, B1); PG8_BAR; PG8_SCHED;
            PG8_LDA(At, 1, 1); PG8_STAGE(PG8_SB(1, 0), b3, voffB); PG8_STAGE(PG8_SB(1, 1), b3 + hstep, voffB); PG8_STAGE(PG8_SA(1, 0), a3, voffA);
            PG8_WAIT_V(8); PG8_WAIT_L(0); PG8_BAR; PG8_MMA(1, 0, At, B0); PG8_MMA(1, 1, At, B1); PG8_BAR; PG8_SCHED;
        }
        if (wr == 0) PG8_BAR;
        E(acc, cur, wr, wc, fr, fq);
        if (!has_next) break;
#pragma unroll
        for (int a = 0; a < 2; ++a)
#pragma unroll
            for (int b = 0; b < 2; ++b)
#pragma unroll
                for (int m = 0; m < 4; ++m)
#pragma unroll
                    for (int n = 0; n < 2; ++n) acc[a][b][m][n] = (f32x4){0.f, 0.f, 0.f, 0.f};
        cur = nxt; cA = nA; cB = nB; ++ui;
        if (wr == 1) PG8_BAR;
    }
    PG8_WAIT_V(0);
    PG8_BAR;
#undef PG8_SA
#undef PG8_SB
#undef PG8_STAGE
#undef PG8_LDA
#undef PG8_LDB
#undef PG8_MMA
#undef PG8_WAIT_V
#undef PG8_WAIT_L
#undef PG8_BAR
#undef PG8_SCHED
}
}
struct Params {
    const float *x, *c, *ctx, *c_ctx, *w_mod, *b_mod, *w_in, *gate_bias, *norm_g, *rpb, *sg_ln_g, *sg_ln_b, *sg_w, *sg_b, *w_branch, *w_out,
                *ln1_g, *ln1_b, *router_w, *router_b, *w_gu, *b_gu, *w_dn, *b_dn, *ln2_g, *ln2_b;
    float* out; unsigned char* ws;
    int ph_lo, ph_hi, li, pad;
};
template <class T> DI T* wsp(const Params& p, size_t off) { return (T*)(p.ws + off); }
#define SMP(o) (wsp<float>(p, WS_SM) + (o))

DI int row_of(int blk, int wave, int i) { return i < 16 ? blk * 128 + wave * 16 + i : ML + blk * 8 + wave; }
DI int bsel_of(int row) { return row < ML ? (row >> 12) : 8; }

template <int MAP> DI int cmap(int n) {
    if (MAP == 1) { if (n < 1024) return (n & ~127) + rope_d(n & 127); return n < 2048 ? n : n + 16; }
    if (MAP == 2) { const int u = n >> 3, e = n & 7; return e < 4 ? 4 * u + e : 1024 + 4 * u + (e - 4); }
    return n;
}
template <int MAP> DI void cvt_tile(const float* src, int ld, bf16_t* dst, int K, int k0, int n0, LAS float* tile) {
    const int tid = ltid();
    { const int kk = tid >> 7, n = tid & 127; const int sc = cmap<MAP>(n0 + n);
#pragma unroll 4
      for (int it = 0; it < 16; ++it) { const int k = it * 4 + kk; tile[k * 129 + n] = src[(size_t)(k0 + k) * ld + sc]; } }
    __syncthreads();
    { const int n = tid >> 2, kc = (tid & 3) * 16; unsigned w[8];
#pragma unroll
      for (int j = 0; j < 8; ++j) w[j] = pk2(tile[(kc + 2 * j) * 129 + n], tile[(kc + 2 * j + 1) * 129 + n]);
      bf16_t* d = dst + (size_t)(n0 + n) * K + k0 + kc;
      *(u32x4*)d = (u32x4){w[0], w[1], w[2], w[3]}; *(u32x4*)(d + 8) = (u32x4){w[4], w[5], w[6], w[7]}; }
    __syncthreads();
}
DI void phase_prologue_a(const Params& p, LAS unsigned char* lds) {
    const int tid = ltid(), G = lgdim(), blk = lbid();
    LAS float* tile = (LAS float*)lds;
    constexpr int T_IN = 4 * 16 * 60, T_BR = 12 * 8 * 8, T_OUT = 4 * 16 * 8, T_GU = 128 * 16 * 16, T_DN = 128 * 16 * 8;
    constexpr int T_ALL = T_IN + T_BR + T_OUT + T_GU + T_DN;
    for (int t = blk; t < T_ALL; t += G) {
        int u = t;
        if (u < T_IN) { const int l = u / 960, r = u % 960; cvt_tile<1>(p.w_in + (size_t)l * 1024 * DIN, DIN, wsp<bf16_t>(p, WS_WIN) + (size_t)l * NPROJ * 1024, 1024, (r / 60) * 64, (r % 60) * 128, tile); continue; }
        u -= T_IN;
        if (u < T_BR) { const int m = u / 64, r = u % 64; cvt_tile<0>(p.w_branch + (size_t)m * 512 * 1024, 1024, wsp<bf16_t>(p, WS_WBR) + (size_t)m * 1024 * 512, 512, (r / 8) * 64, (r % 8) * 128, tile); continue; }
        u -= T_BR;
        if (u < T_OUT) { const int l = u / 128, r = u % 128; cvt_tile<0>(p.w_out + (size_t)l * 1024 * 1024, 1024, wsp<bf16_t>(p, WS_WOUT) + (size_t)l * 1024 * 1024, 1024, (r / 8) * 64, (r % 8) * 128, tile); continue; }
        u -= T_OUT;
        if (u < T_GU) { const int m = u / 256, r = u % 256; cvt_tile<2>(p.w_gu + (size_t)m * 1024 * 2048, 2048, wsp<bf16_t>(p, WS_WGU) + (size_t)m * 2048 * 1024, 1024, (r / 16) * 64, (r % 16) * 128, tile); continue; }
        u -= T_GU;
        { const int m = u / 128, r = u % 128; cvt_tile<0>(p.w_dn + (size_t)m * 1024 * 1024, 1024, wsp<bf16_t>(p, WS_WDN) + (size_t)m * 1024 * 1024, 1024, (r / 8) * 64, (r % 8) * 128, tile); }
    }
    for (int i = blk * 512 + tid; i < 64 * 32; i += G * 512) { const int pos = i >> 5, f = i & 31; const float inv = powf(10000.0f, -(float)f / 32.0f); const float ang = (float)pos * inv;
        wsp<f32x2>(p, WS_ROPE)[i] = (f32x2){cosf(ang), sinf(ang)}; }
    for (int i = blk * 512 + tid; i < 4 * 16 * 1024; i += G * 512) { const int l = i >> 14, g = (i >> 10) & 15, k = i & 1023; wsp<float>(p, WS_WGATE)[i] = p.w_in[((size_t)l * 1024 + k) * DIN + 2048 + g]; }
    { const float* srcs[15] = {p.gate_bias, p.norm_g, p.rpb, p.sg_ln_g, p.sg_ln_b, p.sg_w, p.sg_b, p.ln1_g, p.ln1_b, p.router_w, p.router_b, p.b_gu, p.b_dn, p.ln2_g, p.ln2_b};
      const size_t offs[16] = {SM_GBIAS, SM_NORMG, SM_RPB, SM_SGLNG, SM_SGLNB, SM_SGW, SM_SGB, SM_LN1G, SM_LN1B, SM_RW, SM_RB, SM_BGU, SM_BDN, SM_LN2G, SM_LN2B, SM_END};
      float* dsm = wsp<float>(p, WS_SM);
#pragma unroll
      for (int a = 0; a < 15; ++a) { const int n = (int)(offs[a + 1] - offs[a]); const float* sp = srcs[a]; for (int i = blk * 512 + tid; i < n; i += G * 512) dsm[offs[a] + i] = sp[i]; } }
    LAS float* sl = (LAS float*)lds;
    LAS float* red = sl + 9 * 1024;
    for (int i = tid; i < 9 * 1024; i += 512) { const float v = i < 8192 ? p.c[i] : p.c_ctx[i - 8192]; sl[i] = v / (1.0f + __expf(-v)); }
    __syncthreads();
    for (int u = blk; u < 4 * 96; u += G) {
        const int l = u / 96, c0 = (u % 96) * 64, col = c0 + (tid & 63), kg = tid >> 6;
        float a[9];
#pragma unroll
        for (int b = 0; b < 9; ++b) a[b] = 0.f;
        const float* w = p.w_mod + ((size_t)l * 1024 + kg * 128) * 6144 + col;
#pragma unroll 4
        for (int k = 0; k < 128; ++k) { const float wv = w[(size_t)k * 6144];
#pragma unroll
            for (int b = 0; b < 9; ++b) a[b] += sl[b * 1024 + kg * 128 + k] * wv; }
#pragma unroll
        for (int b = 0; b < 9; ++b) red[(kg * 64 + (tid & 63)) * 9 + b] = a[b];
        __syncthreads();
        for (int i = tid; i < 64 * 9; i += 512) { const int cc = i / 9, b = i % 9; float s = 0.f;
#pragma unroll
            for (int g = 0; g < 8; ++g) s += red[(g * 64 + cc) * 9 + b];
            wsp<float>(p, WS_MOD)[((size_t)l * 9 + b) * 6144 + c0 + cc] = s + p.b_mod[(size_t)l * 6144 + c0 + cc]; }
        __syncthreads();
    }
}

DI void ld_row_f32(const float* p, float (&v)[16], int lane) {
#pragma unroll
    for (int j = 0; j < 4; ++j) { const f32x4 t = *(const f32x4*)(p + 256 * j + 4 * lane); v[4 * j] = t[0]; v[4 * j + 1] = t[1]; v[4 * j + 2] = t[2]; v[4 * j + 3] = t[3]; }
}
DI void st_row_f32(float* p, const float (&v)[16], int lane) {
#pragma unroll
    for (int j = 0; j < 4; ++j) *(f32x4*)(p + 256 * j + 4 * lane) = (f32x4){v[4 * j], v[4 * j + 1], v[4 * j + 2], v[4 * j + 3]};
}
DI void ld_row_bf16(const bf16_t* p, float (&v)[16], int lane) {
#pragma unroll
    for (int j = 0; j < 4; ++j) { const u32x2 t = *(const u32x2*)(p + 256 * j + 4 * lane); v[4 * j] = bflo(t[0]); v[4 * j + 1] = bfhi(t[0]); v[4 * j + 2] = bflo(t[1]); v[4 * j + 3] = bfhi(t[1]); }
}
DI void st_row_bf16(bf16_t* p, const float (&v)[16], int lane) {
#pragma unroll
    for (int j = 0; j < 4; ++j) *(u32x2*)(p + 256 * j + 4 * lane) = (u32x2){pk2(v[4 * j], v[4 * j + 1]), pk2(v[4 * j + 2], v[4 * j + 3])};
}
DI void ln_row(float (&v)[16], const float* g, const float* b, int lane) {
    float s = 0.f;
#pragma unroll
    for (int i = 0; i < 16; ++i) s += v[i];
    const float mean = wave_sum(s) * (1.0f / 1024.0f);
    float q = 0.f;
#pragma unroll
    for (int i = 0; i < 16; ++i) { const float d = v[i] - mean; q += d * d; }
    const float rstd = 1.0f / sqrtf(wave_sum(q) * (1.0f / 1024.0f) + LN_EPS);
    float gg[16], bb[16]; ld_row_f32(g, gg, lane); ld_row_f32(b, bb, lane);
#pragma unroll
    for (int i = 0; i < 16; ++i) v[i] = (v[i] - mean) * rstd * gg[i] + bb[i];
}
DI void modulate(const float (&v)[16], float (&h)[16], const float* sh, const float* sc, int lane) {
    float a[16], b[16]; ld_row_f32(sh, a, lane); ld_row_f32(sc, b, lane);
#pragma unroll
    for (int i = 0; i < 16; ++i) h[i] = v[i] * (1.0f + b[i]) + a[i];
}
template <int N> DI float row_dots(const float (&h)[16], const LAS float* wl, int lane) {
    float s[N];
#pragma unroll
    for (int e = 0; e < N; ++e) s[e] = 0.f;
#pragma unroll 1
    for (int eg = 0; eg < N / 4; ++eg) {
        float a[4];
#pragma unroll
        for (int i = 0; i < 4; ++i) { float t = 0.f;
#pragma unroll
            for (int j = 0; j < 4; ++j) { const f32x4 w = *(const LAS f32x4*)(wl + (eg * 4 + i) * 1024 + 256 * j + 4 * lane); t += h[4 * j] * w[0] + h[4 * j + 1] * w[1] + h[4 * j + 2] * w[2] + h[4 * j + 3] * w[3]; }
            a[i] = t; }
#pragma unroll
        for (int k = 0; k < N / 4; ++k) { const unsigned mk = (k == eg) ? 0xffffffffu : 0u;
#pragma unroll
            for (int i = 0; i < 4; ++i) s[4 * k + i] = __builtin_bit_cast(float, (__builtin_bit_cast(unsigned, s[4 * k + i]) & ~mk) | (__builtin_bit_cast(unsigned, a[i]) & mk)); }
    }
    return bfly<N>(s, lane);
}
DI void load_small_w(LAS float* wl, const float* src, int n  ) { for (int i = ltid(); i < n / 4; i += 512) *(LAS f32x4*)(wl + 4 * i) = *(const f32x4*)(src + 4 * i); __syncthreads(); }

DI void emit_h_and_gates(const Params& p, int layer, int row, const float (&x)[16], const LAS float* wg, int lane) {
    const float* mod = wsp<float>(p, WS_MOD) + ((size_t)layer * 9 + bsel_of(row)) * 6144;
    float h[16]; modulate(x, h, mod, mod + 1024, lane);
    st_row_bf16(wsp<bf16_t>(p, WS_H) + (size_t)row * D, h, lane);
    const float g = row_dots<16>(h, wg, lane);
    if ((lane & 3) == 0) wsp<float>(p, WS_GPRE)[(size_t)row * 16 + (lane >> 2)] = g;
}
DI void phase_init(const Params& p, LAS unsigned char* lds) {
    const int lane = ltid() & 63, wave = ltid() >> 6, blk = lbid();
    LAS float* wg = (LAS float*)lds; load_small_w(wg, wsp<float>(p, WS_WGATE), 16 * 1024);
#pragma unroll 1
    for (int i = 0; i < 17; ++i) { const int row = row_of(blk, wave, i);
        float x[16]; ld_row_f32(row < ML ? p.x + (size_t)row * D : p.ctx + (size_t)(row - ML) * D, x, lane);
        st_row_f32(wsp<float>(p, WS_X) + (size_t)row * D, x, lane);
        emit_h_and_gates(p, 0, row, x, wg, lane); }
}

DI void phase_ln1_router(const Params& p, int layer, LAS unsigned char* lds) {
    const int tid = ltid(), lane = tid & 63, wave = tid >> 6, blk = lbid();
    LAS float* rw = (LAS float*)lds;
    LAS int* cnt = (LAS int*)(lds + 32 * 1024 * 4);
    { const float* src = SMP(SM_RW) + (size_t)layer * 1024 * 32;
      for (int i = tid; i < 32 * 1024; i += 512) { const int k = i >> 5, e = i & 31; rw[e * 1024 + k] = src[i]; }
      if (tid < 32) cnt[tid] = 0; }
    __syncthreads();
    const bool last = (layer == DEPTH - 1);
#pragma unroll 1
    for (int i = 0; i < 17; ++i) { const int row = row_of(blk, wave, i);
        if (last && row >= ML) continue;
        const float* mod = wsp<float>(p, WS_MOD) + ((size_t)layer * 9 + bsel_of(row)) * 6144;
        float x[16], y[16], g1[16];
        ld_row_f32(wsp<float>(p, WS_X) + (size_t)row * D, x, lane); ld_row_bf16(wsp<bf16_t>(p, WS_Y) + (size_t)row * D, y, lane); ld_row_f32(mod + 2 * 1024, g1, lane);
#pragma unroll
        for (int j = 0; j < 16; ++j) x[j] = DN_ALPHA * x[j] + g1[j] * y[j];
        ln_row(x, SMP(SM_LN1G) + (size_t)layer * D, SMP(SM_LN1B) + (size_t)layer * D, lane);
        st_row_f32(wsp<float>(p, WS_X) + (size_t)row * D, x, lane);
        float h[16]; modulate(x, h, mod + 3 * 1024, mod + 4 * 1024, lane);
        st_row_bf16(wsp<bf16_t>(p, WS_H2) + (size_t)row * D, h, lane);
        float lg = row_dots<32>(h, rw, lane) + SMP(SM_RB)[layer * 32 + (lane >> 1)];
        int te[4]; float tv[4];
#pragma unroll
        for (int k = 0; k < 4; ++k) {
            float bv = lg; int be = lane >> 1;
#pragma unroll
            for (int o = 32; o >= 1; o >>= 1) { const float ov = __shfl_xor(bv, o); const int oe = __shfl_xor(be, o); if (ov > bv || (ov == bv && oe < be)) { bv = ov; be = oe; } }
            te[k] = be; tv[k] = bv; if ((lane >> 1) == be) lg = -3.0e38f;
        }
        const float e1 = __expf(tv[1] - tv[0]), e2 = __expf(tv[2] - tv[0]), e3 = __expf(tv[3] - tv[0]); const float inv = 1.0f / (1.0f + e1 + e2 + e3);
        if (lane < 4) { const int e = lane == 0 ? te[0] : lane == 1 ? te[1] : lane == 2 ? te[2] : te[3]; const float gk = (lane == 0 ? 1.0f : lane == 1 ? e1 : lane == 2 ? e2 : e3) * inv;
            const int r = atomicAdd((int*)&cnt[e], 1);
            wsp<int>(p, WS_TOPE)[(size_t)row * 4 + lane] = e; wsp<float>(p, WS_TOPG)[(size_t)row * 4 + lane] = gk; wsp<int>(p, WS_TOPR)[(size_t)row * 4 + lane] = r; }
    }
    __syncthreads();
    if (tid < 32) { const int c = cnt[tid]; int base = 0; if (c > 0) base = (int)atomicAdd(wsp<unsigned>(p, WS_CTL) + CW_CNT + layer * 32 + tid, (unsigned)c); wsp<int>(p, WS_BASE)[blk * 32 + tid] = base; }
}

DI void phase_scatter(const Params& p, int layer, LAS unsigned char* lds) {
    const int tid = ltid(), lane = tid & 63, wave = tid >> 6, blk = lbid();
    LAS int* pst = (LAS int*)lds;
    if (tid == 0) { int acc = 0; for (int e = 0; e < 32; ++e) { const int c = (int)__hip_atomic_load(wsp<unsigned>(p, WS_CTL) + CW_CNT + layer * 32 + e, __ATOMIC_RELAXED, __HIP_MEMORY_SCOPE_AGENT); pst[e] = acc; pst[32 + e] = c; acc += (c + 255) & ~255; } pst[64] = acc >> 8; }
    __syncthreads();
    if (blk == 0) { int* be = wsp<int>(p, WS_BLKE); if (tid == 0) be[0] = pst[64];
#pragma unroll 1
        for (int e = 0; e < 32; ++e) { const int b0 = pst[e] >> 8, nb = (pst[32 + e] + 255) >> 8; for (int j = tid; j < nb; j += 512) be[1 + b0 + j] = e; } }
    const bool last = (layer == DEPTH - 1);
#pragma unroll 1
    for (int i = 0; i < 17; ++i) { const int row = row_of(blk, wave, i);
        if (last && row >= ML) continue;
        const u32x4* src = (const u32x4*)(wsp<bf16_t>(p, WS_H2) + (size_t)row * D);
        const u32x4 v0 = src[lane], v1 = src[64 + lane];
#pragma unroll
        for (int k = 0; k < 4; ++k) { const int e = wsp<int>(p, WS_TOPE)[(size_t)row * 4 + k], r = wsp<int>(p, WS_TOPR)[(size_t)row * 4 + k];
            const int dest = pst[e] + wsp<int>(p, WS_BASE)[blk * 32 + e] + r;
            if (lane == 0) wsp<int>(p, WS_DEST)[(size_t)row * 4 + k] = dest;
            u32x4* d = (u32x4*)(wsp<bf16_t>(p, WS_XG) + (size_t)dest * D); d[lane] = v0; d[64 + lane] = v1; }
    }
}

DI void phase_ln2(const Params& p, int layer, LAS unsigned char* lds) {
    const int tid = ltid(), lane = tid & 63, wave = tid >> 6, blk = lbid();
    const bool last = (layer == DEPTH - 1);
    LAS float* wg = (LAS float*)lds;
    if (!last) load_small_w(wg, wsp<float>(p, WS_WGATE) + (size_t)(layer + 1) * 16 * 1024, 16 * 1024);
#pragma unroll 1
    for (int i = 0; i < 17; ++i) { const int row = row_of(blk, wave, i);
        if (last && row >= ML) continue;
        const float* mod = wsp<float>(p, WS_MOD) + ((size_t)layer * 9 + bsel_of(row)) * 6144;
        float x[16], f[16], g2[16];
#pragma unroll
        for (int j = 0; j < 16; ++j) f[j] = 0.f;
#pragma unroll
        for (int k = 0; k < 4; ++k) { const int dest = wsp<int>(p, WS_DEST)[(size_t)row * 4 + k]; const float gk = wsp<float>(p, WS_TOPG)[(size_t)row * 4 + k];
            float y[16]; ld_row_bf16(wsp<bf16_t>(p, WS_YS) + (size_t)dest * D, y, lane);
#pragma unroll
            for (int j = 0; j < 16; ++j) f[j] += gk * y[j]; }
        ld_row_f32(wsp<float>(p, WS_X) + (size_t)row * D, x, lane); ld_row_f32(mod + 5 * 1024, g2, lane);
#pragma unroll
        for (int j = 0; j < 16; ++j) x[j] = DN_ALPHA * x[j] + g2[j] * f[j];
        ln_row(x, SMP(SM_LN2G) + (size_t)layer * D, SMP(SM_LN2B) + (size_t)layer * D, lane);
        if (last) { st_row_f32(p.out + (size_t)row * D, x, lane); }
        else { st_row_f32(wsp<float>(p, WS_X) + (size_t)row * D, x, lane); emit_h_and_gates(p, layer + 1, row, x, wg, lane); }
    }
}
using pg8::Unit;
struct SchedDense {
    pg8::TileOrder T; const bf16_t* A; int lda; const bf16_t* Bt; int K;
    DI bool next(int i, Unit& u) const { u.aux = 0; return T.tile(i, u.pm, u.pn); }
    DI const char* a_base(const Unit& u) const { return (const char*)(A + (size_t)u.pm * 256 * lda); }
    DI const char* b_base(const Unit& u) const { return (const char*)(Bt + (size_t)u.pn * 256 * K); }
};
struct SchedMerge {
    pg8::TileOrder T; const bf16_t* A; const bf16_t* Bt; static constexpr int lda = 1536;
    DI bool next(int i, Unit& u) const { u.aux = i % 3; return T.tile(i / 3, u.pm, u.pn); }
    DI const char* a_base(const Unit& u) const { return (const char*)(A + (size_t)u.pm * 256 * 1536 + u.aux * 512); }
    DI const char* b_base(const Unit& u) const { return (const char*)(Bt + ((size_t)u.aux * 1024 + (size_t)u.pn * 256) * 512); }
};
template <int NT> struct SchedMoe {
    const int* blke; int nunits, G, c; const bf16_t* A; const bf16_t* Bt; size_t bstride; static constexpr int lda = 1024;
    DI void init(const int* blke_, int G_, int c_) { blke = blke_; nunits = blke_[0] * NT; G = G_; c = c_; }
    DI bool next(int i, Unit& u) const { const int L = i * G + c; if (L >= nunits) return false; u.pm = L / NT; u.pn = L % NT; u.aux = blke[1 + u.pm]; return true; }
    DI const char* a_base(const Unit& u) const { return (const char*)(A + (size_t)u.pm * 256 * 1024); }
    DI const char* b_base(const Unit& u) const { return (const char*)(Bt + (size_t)u.aux * bstride + (size_t)u.pn * 256 * 1024); }
};

#define EPI_ROWS_BEGIN _Pragma("unroll") for (int ai = 0; ai < 2; ++ai) _Pragma("unroll") for (int m = 0; m < 4; ++m) { const int row = u.pm * 256 + ai * 128 + wr * 64 + m * 16 + fr;
#define EPI_ROWS_END }
DI u32x4 pack8(const f32x4& a, const f32x4& b) { return (u32x4){cvt_pk_bf16(a[0], a[1]), cvt_pk_bf16(a[2], a[3]), cvt_pk_bf16(b[0], b[1]), cvt_pk_bf16(b[2], b[3])}; }

struct EpiInproj {
    bf16_t* P; const f32x2* rope;
    DI void operator()(const f32x4 (&acc)[2][2][4][2], const Unit& u, int wr, int wc, int fr, int fq) const {
        const int pn = u.pn; const int colb = pn * 256 + wc * 32 + 8 * fq;
        const int kind = pn < 2 ? 0 : pn < 4 ? 1 : pn < 6 ? 2 : pn < 8 ? 3 : pn < 10 ? 4 : pn < 14 ? 2 : pn < 18 ? 5 : 3;
        const bool latent = u.pm < 128;
        const int ra = wc >> 1, f0 = ((wc & 1) * 4 + fq) * 4;
        EPI_ROWS_BEGIN
            bf16_t* rowp = P + (size_t)row * NPROJ + colb;
            f32x4 cs[2]; if (kind <= 1 && latent) { const int t = row & 4095; const int pos = ra ? (t & 63) : (t >> 6); const f32x4* rp = (const f32x4*)(rope + pos * 32 + f0); cs[0] = rp[0]; cs[1] = rp[1]; }
#pragma unroll
            for (int bj = 0; bj < 2; ++bj) { f32x4 v0 = acc[ai][bj][m][0], v1 = acc[ai][bj][m][1];
                if (kind == 0) { v0 = v0 * 0.08838834764831845f; v1 = v1 * 0.08838834764831845f; }
                if (kind == 4) { v0 = v0 * 0.125f; v1 = v1 * 0.125f; }
                if (kind <= 1 && latent) {
                    const float c[4] = {cs[0][0], cs[0][2], cs[1][0], cs[1][2]}, s[4] = {cs[0][1], cs[0][3], cs[1][1], cs[1][3]};
#pragma unroll
                    for (int j = 0; j < 4; ++j) { const float x1 = v0[j], x2 = v1[j]; v0[j] = x1 * c[j] - x2 * s[j]; v1[j] = x2 * c[j] + x1 * s[j]; } }
                if (kind == 3) {
#pragma unroll
                    for (int j = 0; j < 4; ++j) { v0[j] = sigmoidf_(v0[j]); v1[j] = sigmoidf_(v1[j]); } }
                if (kind == 5) {
#pragma unroll
                    for (int j = 0; j < 4; ++j) { v0[j] = gelu_tanh(v0[j]); v1[j] = gelu_tanh(v1[j]); } }
                *(u32x4*)(rowp + bj * 128) = pack8(v0, v1); }
        EPI_ROWS_END
    }
};
struct EpiMerge {
    bf16_t* Mg; const bf16_t* P;
    DI void operator()(const f32x4 (&acc)[2][2][4][2], const Unit& u, int wr, int wc, int fr, int fq) const {
        const int colb = u.pn * 256 + wc * 32 + 8 * fq;
        EPI_ROWS_BEGIN
#pragma unroll
            for (int bj = 0; bj < 2; ++bj) { const int col = colb + bj * 128;
                const u32x4 g = *(const u32x4*)(P + (size_t)row * NPROJ + PBG + u.aux * 1024 + col);
                f32x4 v0 = acc[ai][bj][m][0], v1 = acc[ai][bj][m][1];
                v0 = v0 * (f32x4){bflo(g[0]), bfhi(g[0]), bflo(g[1]), bfhi(g[1])}; v1 = v1 * (f32x4){bflo(g[2]), bfhi(g[2]), bflo(g[3]), bfhi(g[3])};
                u32x4* dst = (u32x4*)(Mg + (size_t)row * D + col);
                if (u.aux > 0) { const u32x4 o = *dst; v0 = v0 + (f32x4){bflo(o[0]), bfhi(o[0]), bflo(o[1]), bfhi(o[1])}; v1 = v1 + (f32x4){bflo(o[2]), bfhi(o[2]), bflo(o[3]), bfhi(o[3])}; }
                *dst = pack8(v0, v1); }
        EPI_ROWS_END
    }
};
struct EpiStore {
    bf16_t* O; int ldo; const float* bias; int bias_stride;
    DI void operator()(const f32x4 (&acc)[2][2][4][2], const Unit& u, int wr, int wc, int fr, int fq) const {
        const int colb = u.pn * 256 + wc * 32 + 8 * fq;
        f32x4 bv[2][2];
#pragma unroll
        for (int bj = 0; bj < 2; ++bj)
#pragma unroll
            for (int n = 0; n < 2; ++n) bv[bj][n] = bias ? *(const f32x4*)(bias + (size_t)u.aux * bias_stride + colb + bj * 128 + 4 * n) : (f32x4){0.f, 0.f, 0.f, 0.f};
        EPI_ROWS_BEGIN
#pragma unroll
            for (int bj = 0; bj < 2; ++bj) *(u32x4*)(O + (size_t)row * ldo + colb + bj * 128) = pack8(acc[ai][bj][m][0] + bv[bj][0], acc[ai][bj][m][1] + bv[bj][1]);
        EPI_ROWS_END
    }
};
struct EpiGu {
    bf16_t* ACT; const float* b_gu;
    DI void operator()(const f32x4 (&acc)[2][2][4][2], const Unit& u, int wr, int wc, int fr, int fq) const {
        f32x4 bg[2], bu[2];
#pragma unroll
        for (int bj = 0; bj < 2; ++bj) { const int oc = u.pn * 128 + bj * 64 + wc * 16 + 4 * fq; bg[bj] = *(const f32x4*)(b_gu + (size_t)u.aux * 2048 + oc); bu[bj] = *(const f32x4*)(b_gu + (size_t)u.aux * 2048 + 1024 + oc); }
        EPI_ROWS_BEGIN
#pragma unroll
            for (int bj = 0; bj < 2; ++bj) { const int oc = u.pn * 128 + bj * 64 + wc * 16 + 4 * fq;
                const f32x4 g = acc[ai][bj][m][0] + bg[bj], up = acc[ai][bj][m][1] + bu[bj]; float a[4];
#pragma unroll
                for (int j = 0; j < 4; ++j) { const float gt = fminf(g[j], 7.0f), ut = fminf(fmaxf(up[j], -7.0f), 7.0f); a[j] = gt * sigmoidf_(1.702f * gt) * (ut + 1.0f); }
                *(u32x2*)(ACT + (size_t)row * 1024 + oc) = (u32x2){cvt_pk_bf16(a[0], a[1]), cvt_pk_bf16(a[2], a[3])}; }
        EPI_ROWS_END
    }
};

DI void phase_inproj(const Params& p, int layer, LAS unsigned char* lds) {
    SchedDense S; S.T.init(MT / 256, NPROJ / 256, lgdim(), lbid()); S.A = wsp<bf16_t>(p, WS_H); S.lda = 1024; S.Bt = wsp<bf16_t>(p, WS_WIN) + (size_t)layer * NPROJ * 1024; S.K = 1024;
    EpiInproj E{wsp<bf16_t>(p, WS_P), wsp<f32x2>(p, WS_ROPE)};
    pg8::gemm_phase(lds, 1024, S, E);
}
DI void phase_merge(const Params& p, int layer, LAS unsigned char* lds) {
    SchedMerge S; S.T.init(MT / 256, 4, lgdim(), lbid()); S.A = wsp<bf16_t>(p, WS_ABC); S.Bt = wsp<bf16_t>(p, WS_WBR) + (size_t)layer * 3 * 1024 * 512;
    EpiMerge E{wsp<bf16_t>(p, WS_MRG), wsp<bf16_t>(p, WS_P)};
    pg8::gemm_phase(lds, 512, S, E);
}
DI void phase_outproj(const Params& p, int layer, LAS unsigned char* lds) {
    SchedDense S; S.T.init(MT / 256, 4, lgdim(), lbid()); S.A = wsp<bf16_t>(p, WS_MRG); S.lda = 1024; S.Bt = wsp<bf16_t>(p, WS_WOUT) + (size_t)layer * 1024 * 1024; S.K = 1024;
    EpiStore E{wsp<bf16_t>(p, WS_Y), 1024, nullptr, 0};
    pg8::gemm_phase(lds, 1024, S, E);
}
DI void phase_moe_gu(const Params& p, int layer, LAS unsigned char* lds) {
    SchedMoe<8> S; S.init(wsp<int>(p, WS_BLKE), lgdim(), lbid()); S.A = wsp<bf16_t>(p, WS_XG); S.Bt = wsp<bf16_t>(p, WS_WGU) + (size_t)layer * 32 * 2048 * 1024; S.bstride = (size_t)2048 * 1024;
    EpiGu E{wsp<bf16_t>(p, WS_ACT), SMP(SM_BGU) + (size_t)layer * 32 * 2048};
    pg8::gemm_phase(lds, 1024, S, E);
}
DI void phase_moe_dn(const Params& p, int layer, LAS unsigned char* lds) {
    SchedMoe<4> S; S.init(wsp<int>(p, WS_BLKE), lgdim(), lbid()); S.A = wsp<bf16_t>(p, WS_ACT); S.Bt = wsp<bf16_t>(p, WS_WDN) + (size_t)layer * 32 * 1024 * 1024; S.bstride = (size_t)1024 * 1024;
    EpiStore E{wsp<bf16_t>(p, WS_YS), 1024, SMP(SM_BDN) + (size_t)layer * 32 * 1024, 1024};
    pg8::gemm_phase(lds, 1024, S, E);
}
DI int chain_tok(int dir, int b, int j, int tau) {
    if (dir == 0) return j < 4 ? ML + b * 256 + j * 64 + tau : b * 4096 + (j - 4) * 64 + tau;
    return j < 4 ? ML + b * 256 + (3 - j) * 64 + (63 - tau) : b * 4096 + (67 - j) * 64 + (63 - tau);
}
DI void phase_gates(const Params& p, int layer) {
    const int lane = ltid() & 63, gw = lbid() * 8 + (ltid() >> 6), nw = lgdim() * 8;
    const float* gb = SMP(SM_GBIAS) + layer * 16;
    for (int u = gw; u < NCHAIN * NSLOT; u += nw) {
        const int ch = u / NSLOT, j = u % NSLOT, dir = ch >> 5, b = (ch >> 2) & 7, h = ch & 3;
        const int tok = chain_tok(dir, b, j, lane);
        const float* g = wsp<float>(p, WS_GPRE) + (size_t)tok * 16;
        const float li = g[(dir * 2) * 4 + h] + gb[(dir * 2) * 4 + h];
        const float lf = log_sigmoid(g[(dir * 2 + 1) * 4 + h] + gb[(dir * 2 + 1) * 4 + h]);
        float bc = lf;
#pragma unroll
        for (int o = 1; o < 64; o <<= 1) { const float t = __shfl_up(bc, o); if (lane >= o) bc += t; }
        const float a = li - bc; float cm = a;
#pragma unroll
        for (int o = 1; o < 64; o <<= 1) { const float t = __shfl_up(cm, o); if (lane >= o) cm = fmaxf(cm, t); }
        const size_t o = (size_t)u * 64 + lane;
        wsp<float>(p, WS_GA)[o] = a; wsp<float>(p, WS_GCM)[o] = cm; wsp<float>(p, WS_GB)[o] = bc;
    }
}
DI float chain_m(const Params& p, int ch, int j) {
    const float* gcm = wsp<float>(p, WS_GCM) + (size_t)ch * NSLOT * 64 + 63; const float* gbb = wsp<float>(p, WS_GB) + (size_t)ch * NSLOT * 64 + 63;
    float m = 0.f; for (int i = 0; i < j; ++i) m = gbb[i * 64] + fmaxf(m, gcm[i * 64]); return m;
}
DI void mlstm_u_unit(const Params& p, int u, LAS unsigned char* lds) {
    const int tid = ltid(), ch = u / (NSLOT - 1), j = u % (NSLOT - 1), dir = ch >> 5, b = (ch >> 2) & 7, h = ch & 3;
    LAS float* Vs = (LAS float*)lds; LAS float* Ks = Vs + 64 * 128;
    const float mj = chain_m(p, ch, j);
    const float Mend = fmaxf(mj, wsp<float>(p, WS_GCM)[((size_t)ch * NSLOT + j) * 64 + 63]);
    const bf16_t* P = wsp<bf16_t>(p, WS_P);
    for (int i = tid; i < 64 * 128; i += 512) { const int tau = i >> 7, d = i & 127; const int tok = chain_tok(dir, b, j, tau);
        const float w = __expf(wsp<float>(p, WS_GA)[((size_t)ch * NSLOT + j) * 64 + tau] - Mend);
        Vs[i] = bf2f(P[(size_t)tok * NPROJ + PV + h * 128 + d]); Ks[i] = w * bf2f(P[(size_t)tok * NPROJ + PK + h * 128 + d]); }
    __syncthreads();
    { const int v = tid >> 2, d0 = (tid & 3) * 32; float acc[32];
#pragma unroll
      for (int i = 0; i < 32; ++i) acc[i] = 0.f;
      for (int tau = 0; tau < 64; ++tau) { const float vv = Vs[tau * 128 + v];
#pragma unroll
          for (int i = 0; i < 32; ++i) acc[i] += vv * Ks[tau * 128 + d0 + i]; }
      bf16_t* dst = wsp<bf16_t>(p, WS_UC) + (((size_t)ch * NSLOT + j) * 128 + v) * 128 + d0;
#pragma unroll
      for (int i = 0; i < 32; i += 2) *(unsigned*)(dst + i) = pk2(acc[i], acc[i + 1]); }
    if (tid < 128) { float s = 0.f; for (int tau = 0; tau < 64; ++tau) s += Ks[tau * 128 + tid]; wsp<float>(p, WS_UN)[((size_t)ch * NSLOT + j) * 128 + tid] = s; }
    __syncthreads();
}
DI void phase_scan(const Params& p) {
    const int gt = lbid() * 512 + ltid(), nthr = lgdim() * 512;
    for (int w = gt; w < NCHAIN * 2048; w += nthr) {
        const int ch = w >> 11, e8 = w & 2047;
        const float* gcm = wsp<float>(p, WS_GCM) + (size_t)ch * NSLOT * 64 + 63; const float* gbb = wsp<float>(p, WS_GB) + (size_t)ch * NSLOT * 64 + 63;
        u32x4* base = (u32x4*)(wsp<bf16_t>(p, WS_UC) + (size_t)ch * NSLOT * 16384) + e8;
        float* nb = wsp<float>(p, WS_UN) + (size_t)ch * NSLOT * 128 + e8;
        float c[8], nn = 0.f, m = 0.f;
#pragma unroll
        for (int i = 0; i < 8; ++i) c[i] = 0.f;
        for (int j = 0; j < NSLOT; ++j) {
            u32x4 uu = (u32x4){0u, 0u, 0u, 0u}; float un = 0.f;
            if (j < NSLOT - 1) { uu = base[(size_t)j * 2048]; if (e8 < 128) un = nb[j * 128]; }
            base[(size_t)j * 2048] = (u32x4){pk2(c[0], c[1]), pk2(c[2], c[3]), pk2(c[4], c[5]), pk2(c[6], c[7])};
            if (e8 < 128) nb[j * 128] = nn;
            const float cme = gcm[j * 64], be = gbb[j * 64]; const float Mend = fmaxf(m, cme); const float dec = __expf(m - Mend); m = be + Mend;
            c[0] = dec * c[0] + bflo(uu[0]); c[1] = dec * c[1] + bfhi(uu[0]); c[2] = dec * c[2] + bflo(uu[1]); c[3] = dec * c[3] + bfhi(uu[1]);
            c[4] = dec * c[4] + bflo(uu[2]); c[5] = dec * c[5] + bfhi(uu[2]); c[6] = dec * c[6] + bflo(uu[3]); c[7] = dec * c[7] + bfhi(uu[3]);
            nn = dec * nn + un;
        }
    }
}
DI void mlstm_h_unit(const Params& p, int layer, int u, LAS unsigned char* lds) {
    const int tid = ltid(), b = u / (4 * 68), h = (u / 68) & 3, cc = u % 68;
    const bool isctx = cc < 4; const int ck = isctx ? cc : cc - 4;
    const int tok0 = isctx ? ML + b * 256 + ck * 64 : b * 4096 + ck * 64;
    LAS float* Qs = (LAS float*)lds; LAS float* Ks = Qs + 64 * 129; LAS float* Vs = Ks + 64 * 129;
    LAS float* Ss = Vs + 64 * 129;
    LAS float* aux = Ss + 64 * 65;
    const bf16_t* P = wsp<bf16_t>(p, WS_P);
    for (int i = tid; i < 64 * 128; i += 512) { const int t = i >> 7, d = i & 127; const size_t o = (size_t)(tok0 + t) * NPROJ + h * 128 + d;
        Qs[t * 129 + d] = bf2f(P[o + PQ]); Ks[t * 129 + d] = bf2f(P[o + PK]); Vs[t * 129 + d] = bf2f(P[o + PV]); }
    __syncthreads();
    float hacc[16];
#pragma unroll
    for (int i = 0; i < 16; ++i) hacc[i] = 0.f;
    const int t = tid >> 3, sg = tid & 7, v0 = sg * 16;
    for (int dir = 0; dir < 2; ++dir) {
        const int ch = (dir * 8 + b) * 4 + h; const int j = dir == 0 ? (isctx ? ck : 4 + ck) : (isctx ? 3 - ck : 67 - ck);
        const float mprev = chain_m(p, ch, j);
        const float* ga = wsp<float>(p, WS_GA) + ((size_t)ch * NSLOT + j) * 64; const float* gcm = wsp<float>(p, WS_GCM) + ((size_t)ch * NSLOT + j) * 64; const float* gbv = wsp<float>(p, WS_GB) + ((size_t)ch * NSLOT + j) * 64;
        const bf16_t* C = wsp<bf16_t>(p, WS_UC) + ((size_t)ch * NSLOT + j) * 16384; const float* nvec = wsp<float>(p, WS_UN) + ((size_t)ch * NSLOT + j) * 128;
        { const int taut = dir ? 63 - t : t; const float Mt = fmaxf(mprev, gcm[taut]);
          for (int s = sg; s < 64; s += 8) { const int taus = dir ? 63 - s : s; float v = 0.f;
              if (taus <= taut) { float dsum = 0.f; for (int d = 0; d < 128; ++d) dsum += Qs[t * 129 + d] * Ks[s * 129 + d]; v = dsum * __expf(ga[taus] - Mt); }
              Ss[t * 65 + s] = v; }
          if (sg == 0) { float dn = 0.f; for (int d = 0; d < 128; ++d) dn += Qs[t * 129 + d] * nvec[d]; aux[t] = __expf(mprev - Mt); aux[64 + t] = dn; aux[128 + t] = __expf(-(gbv[taut] + Mt)); } }
        __syncthreads();
        { const float wi = aux[t];
          float den = wi * aux[64 + t]; for (int s = 0; s < 64; ++s) den += Ss[t * 65 + s];
          const float dd = fmaxf(fabsf(den), aux[128 + t]);
#pragma unroll 1
          for (int vv = 0; vv < 16; ++vv) { const int v = v0 + vv; float num = 0.f;
              for (int s = 0; s < 64; ++s) num += Ss[t * 65 + s] * Vs[s * 129 + v];
              float cq = 0.f; const u32x4* cr = (const u32x4*)(C + (size_t)v * 128);
              for (int d8 = 0; d8 < 16; ++d8) { const u32x4 w = cr[d8]; const LAS float* qq = Qs + t * 129 + d8 * 8;
                  cq += bflo(w[0]) * qq[0] + bfhi(w[0]) * qq[1] + bflo(w[1]) * qq[2] + bfhi(w[1]) * qq[3] + bflo(w[2]) * qq[4] + bfhi(w[2]) * qq[5] + bflo(w[3]) * qq[6] + bfhi(w[3]) * qq[7]; }
              const float val = (num + wi * cq) / dd;
#pragma unroll
              for (int k = 0; k < 16; ++k) if (k == vv) hacc[k] += val; } }
        __syncthreads();
    }
    { float s = 0.f;
#pragma unroll
      for (int i = 0; i < 16; ++i) s += hacc[i];
      s += __shfl_xor(s, 1); s += __shfl_xor(s, 2); s += __shfl_xor(s, 4);
      const float mean = s * (1.0f / 128.0f); float q = 0.f;
#pragma unroll
      for (int i = 0; i < 16; ++i) { const float d = hacc[i] - mean; q += d * d; }
      q += __shfl_xor(q, 1); q += __shfl_xor(q, 2); q += __shfl_xor(q, 4);
      const float rstd = 1.0f / sqrtf(q * (1.0f / 128.0f) + LN_EPS);
      const size_t tok = (size_t)(tok0 + t); const float* ng = SMP(SM_NORMG) + (size_t)layer * 512 + h * 128 + v0;
      const u32x4* op = (const u32x4*)(P + tok * NPROJ + PO + h * 128 + v0); const u32x4 o0 = op[0], o1 = op[1];
      const float og[16] = {bflo(o0[0]), bfhi(o0[0]), bflo(o0[1]), bfhi(o0[1]), bflo(o0[2]), bfhi(o0[2]), bflo(o0[3]), bfhi(o0[3]), bflo(o1[0]), bfhi(o1[0]), bflo(o1[1]), bfhi(o1[1]), bflo(o1[2]), bfhi(o1[2]), bflo(o1[3]), bfhi(o1[3])};
      float r[16];
#pragma unroll
      for (int i = 0; i < 16; ++i) r[i] = (hacc[i] - mean) * rstd * ng[i] * og[i];
      u32x4* dst = (u32x4*)(wsp<bf16_t>(p, WS_ABC) + tok * 1536 + h * 128 + v0);
      dst[0] = (u32x4){pk2(r[0], r[1]), pk2(r[2], r[3]), pk2(r[4], r[5]), pk2(r[6], r[7])}; dst[1] = (u32x4){pk2(r[8], r[9]), pk2(r[10], r[11]), pk2(r[12], r[13]), pk2(r[14], r[15])}; }
    __syncthreads();
}

DI void na_task(const Params& p, int layer, int task, LAS float* ws  ) {
    const int lane = ltid() & 63; const int row = task >> 3, hd = task & 7;
    const bf16_t* P = wsp<bf16_t>(p, WS_P);
    const bool latent = row < ML; const int b = latent ? row >> 12 : (row - ML) >> 8;
    ws[lane] = bf2f(P[(size_t)row * NPROJ + PNQ + hd * 64 + lane]);
    asm volatile("s_waitcnt lgkmcnt(0)" ::: "memory");
    int r = 0, qc = 0, rs = 0, cs = 0;
    if (latent) { const int t = row & 4095; r = t >> 6; qc = t & 63; rs = min(max(r - 4, 0), 56); cs = min(max(qc - 8, 0), 48); }
    const int nkeys = latent ? 384 : 256;
    float sc[6]; float mx = -3.0e38f;
#pragma unroll
    for (int i = 0; i < 6; ++i) { const int kk = lane + 64 * i; sc[i] = -3.0e38f;
        if (kk < nkeys) { int krow; float bias = 0.f;
            if (latent && kk < 128) { const int kr = rs + (kk >> 4), kc = cs + (kk & 15); krow = b * 4096 + kr * 64 + kc; bias = SMP(SM_RPB)[(((size_t)layer * 8 + hd) * 15 + (kr - r + 7)) * 31 + (kc - qc + 15)]; }
            else krow = ML + b * 256 + (latent ? kk - 128 : kk);
            const u32x4* kp = (const u32x4*)(P + (size_t)krow * NPROJ + PNK + hd * 64); float s = 0.f;
#pragma unroll
            for (int c8 = 0; c8 < 8; ++c8) { const u32x4 w = kp[c8];
#pragma unroll
                for (int e = 0; e < 4; ++e) s += bflo(w[e]) * ws[c8 * 8 + 2 * e] + bfhi(w[e]) * ws[c8 * 8 + 2 * e + 1]; }
            sc[i] = s + bias; mx = fmaxf(mx, sc[i]); } }
    mx = wave_max(mx); float sum = 0.f;
#pragma unroll
    for (int i = 0; i < 6; ++i) { const int kk = lane + 64 * i; if (kk < nkeys) { const float e = __expf(sc[i] - mx); sum += e; ws[64 + kk] = e; } }
    sum = wave_sum(sum);
    asm volatile("s_waitcnt lgkmcnt(0)" ::: "memory");
    float o = 0.f;
    for (int kk = 0; kk < nkeys; ++kk) { int krow;
        if (latent && kk < 128) krow = b * 4096 + (rs + (kk >> 4)) * 64 + cs + (kk & 15); else krow = ML + b * 256 + (latent ? kk - 128 : kk);
        o += ws[64 + kk] * bf2f(P[(size_t)krow * NPROJ + PNV + hd * 64 + lane]); }
    wsp<bf16_t>(p, WS_ABC)[(size_t)row * 1536 + 512 + hd * 64 + lane] = (bf16_t)f2bf(o / sum);
}

DI void sgu_unit(const Params& p, int layer, int u, LAS unsigned char* lds) {
    const int tid = ltid(), lane = tid & 63, wave = tid >> 6;
    const int g = u & 3, n = (u >> 2) % 34, b = (u >> 2) / 34;
    const int tok0 = n < 32 ? b * 4096 + n * 128 : ML + b * 256 + (n - 32) * 128;
    LAS float* vn = (LAS float*)lds;
    LAS float* wsm = vn + 128 * 128;
    LAS float* st = wsm + 128 * 129;
    const bf16_t* P = wsp<bf16_t>(p, WS_P);
    for (int i = 0; i < 16; ++i) { const int pp = wave * 16 + i; const u32x4 w = *(const u32x4*)(P + (size_t)(tok0 + pp) * NPROJ + PSV + lane * 8);
        const float x[8] = {bflo(w[0]), bfhi(w[0]), bflo(w[1]), bfhi(w[1]), bflo(w[2]), bfhi(w[2]), bflo(w[3]), bfhi(w[3])}; float s = 0.f;
#pragma unroll
        for (int e = 0; e < 8; ++e) s += x[e];
        const float mean = wave_sum(s) * (1.0f / 512.0f); float q = 0.f;
#pragma unroll
        for (int e = 0; e < 8; ++e) q += (x[e] - mean) * (x[e] - mean);
        const float rstd = 1.0f / sqrtf(wave_sum(q) * (1.0f / 512.0f) + LN_EPS);
        if (lane == 0) { st[pp * 2] = mean; st[pp * 2 + 1] = rstd; } }
    __syncthreads();
    const float* lg = SMP(SM_SGLNG) + (size_t)layer * 512 + g * 128; const float* lb = SMP(SM_SGLNB) + (size_t)layer * 512 + g * 128;
    for (int i = tid; i < 128 * 128; i += 512) { const int pp = i >> 7, c = i & 127;
        vn[i] = (bf2f(P[(size_t)(tok0 + pp) * NPROJ + PSV + g * 128 + c]) - st[pp * 2]) * st[pp * 2 + 1] * lg[c] + lb[c];
        wsm[pp * 129 + c] = SMP(SM_SGW)[(((size_t)layer * 4 + g) * 128 + pp) * 128 + c]; }
    __syncthreads();
    { const int q = tid >> 2, c0 = (tid & 3) * 32; float acc[32];
#pragma unroll
      for (int i = 0; i < 32; ++i) acc[i] = 0.f;
      for (int pp = 0; pp < 128; ++pp) { const float w = wsm[q * 129 + pp];
#pragma unroll
          for (int i = 0; i < 32; ++i) acc[i] += w * vn[pp * 128 + c0 + i]; }
      const float bs = SMP(SM_SGB)[((size_t)layer * 4 + g) * 128 + q];
      const size_t tok = (size_t)(tok0 + q);
#pragma unroll
      for (int i = 0; i < 32; i += 2) { const unsigned uu = *(const unsigned*)(P + tok * NPROJ + PSU + g * 128 + c0 + i);
          *(unsigned*)(wsp<bf16_t>(p, WS_ABC) + tok * 1536 + 1024 + g * 128 + c0 + i) = pk2(bflo(uu) * (acc[i] + bs), bfhi(uu) * (acc[i + 1] + bs)); } }
    __syncthreads();
}

DI void phase_mix1(const Params& p, int layer, LAS unsigned char* lds) {
    const int G = lgdim(), blk = lbid();
    for (int u = blk; u < NCHAIN * (NSLOT - 1); u += G) mlstm_u_unit(p, u, lds);
    for (int u = blk; u < NB * 34 * 4; u += G) sgu_unit(p, layer, u, lds);
    { const int wave = ltid() >> 6; LAS float* ws = (LAS float*)lds + wave * 512;
      for (int t = blk * 8 + wave; t < MT * 8; t += G * 8) na_task(p, layer, t, ws); }
}
DI void phase_mix3(const Params& p, int layer, LAS unsigned char* lds) {
    for (int u = lbid(); u < NB * 4 * 68; u += lgdim()) mlstm_h_unit(p, layer, u, lds);
}
constexpr int NPH = 2 + 11 * DEPTH;
__global__ void __launch_bounds__(512, 2) fwd(Params p) {
    extern __shared__ __attribute__((aligned(16))) unsigned char lds_raw[];
    LAS unsigned char* lds = (LAS unsigned char*)lds_raw;
    volatile LAS unsigned* misc = (volatile LAS unsigned*)(lds + LDS_MISC);
    if (threadIdx.x < 64) misc[threadIdx.x] = 0u;
    __syncthreads();
    XcdBarrier bar = xcd_barrier_post(wsp<unsigned>(p, WS_CTL) + CW_BAR + p.li * XCD_BAR_WORDS, misc);
    const int lo = p.ph_lo, hi = p.ph_hi;
#define IN(k) (lo <= (k) && (k) < hi)
#define LP ({ Params q_ = p; asm volatile("" : "+s"(q_.ws), "+s"(q_.out)); q_; })
#define SEAM(k) do { if (IN(k) && IN((k) + 1)) { XcdBarrier b2_ = bar; asm volatile("" : "+s"(b2_.bar), "+s"(b2_.x)); xcd_barrier(b2_); } } while (0)
    if (IN(0)) phase_prologue_a(LP, lds);
    SEAM(0);
    if (IN(1)) phase_init(LP, lds);
    SEAM(1);
    for (int L = 0; L < DEPTH; ++L) {
        const int b = 2 + 11 * L;
        if (IN(b + 0)) { phase_gates(LP, L); phase_inproj(LP, L, lds); }
        SEAM(b + 0);
        if (IN(b + 1)) phase_mix1(LP, L, lds);
        SEAM(b + 1);
        if (IN(b + 2)) phase_scan(LP);
        SEAM(b + 2);
        if (IN(b + 3)) phase_mix3(LP, L, lds);
        SEAM(b + 3);
        if (IN(b + 4)) phase_merge(LP, L, lds);
        SEAM(b + 4);
        if (IN(b + 5)) phase_outproj(LP, L, lds);
        SEAM(b + 5);
        if (IN(b + 6)) phase_ln1_router(LP, L, lds);
        SEAM(b + 6);
        if (IN(b + 7)) phase_scatter(LP, L, lds);
        SEAM(b + 7);
        if (IN(b + 8)) phase_moe_gu(LP, L, lds);
        SEAM(b + 8);
        if (IN(b + 9)) phase_moe_dn(LP, L, lds);
        SEAM(b + 9);
        if (IN(b + 10)) phase_ln2(LP, L, lds);
        SEAM(b + 10);
    }
#undef IN
#undef SEAM
}

#ifndef N_LAUNCH_MODE
#define N_LAUNCH_MODE 0
#endif
extern "C" void kernel_launch(void* const* d_in, const int* in_sizes, int n_in, void* d_out, int out_size, void* d_ws, size_t ws_size, hipStream_t stream) {
    static int grid = 0;
    if (grid == 0) {
        if (n_in != 26 || ws_size < WS_END) { fprintf(stderr, "kernel_launch: expected 26 inputs and >= %zu bytes of workspace (got %d, %zu)\n", (size_t)WS_END, n_in, ws_size); grid = -1; return; }
        int dev = 0, cus = 0, per_cu = 0;
        if (hipGetDevice(&dev) != hipSuccess || hipDeviceGetAttribute(&cus, hipDeviceAttributeMultiprocessorCount, dev) != hipSuccess) { grid = -1; return; }
        if (hipFuncSetAttribute((const void*)fwd, hipFuncAttributeMaxDynamicSharedMemorySize, LDS_BYTES) != hipSuccess) { fprintf(stderr, "kernel_launch: hipFuncSetAttribute failed\n"); grid = -1; return; }
        if (hipOccupancyMaxActiveBlocksPerMultiprocessor(&per_cu, (const void*)fwd, 512, LDS_BYTES) != hipSuccess || per_cu < 1) fprintf(stderr, "kernel_launch: occupancy query reports %d\n", per_cu);
        (void)hipGetLastError();
        grid = cus;
        if (grid != 256) fprintf(stderr, "kernel_launch: %d CUs; the row phases assume 256 workgroups\n", grid);
        grid = 256;
    }
    if (grid < 0) return;
    (void)hipMemsetAsync((char*)d_ws + WS_CTL, 0, CTL_BYTES, stream);
    Params p{};
    const float** pf = (const float**)&p;
    for (int i = 0; i < 26; ++i) pf[i] = (const float*)d_in[i];
    p.out = (float*)d_out; p.ws = (unsigned char*)d_ws;
#if N_LAUNCH_MODE == 1
    p.ph_lo = 0; p.ph_hi = NPH; p.li = 0; p.pad = 0;
    hipLaunchKernelGGL(fwd, dim3(grid), dim3(512), LDS_BYTES, stream, p);
#else
    for (int ph = 0; ph < NPH; ++ph) { p.ph_lo = ph; p.ph_hi = ph + 1; p.li = 0; p.pad = 0; hipLaunchKernelGGL(fwd, dim3(grid), dim3(512), LDS_BYTES, stream, p); }
#endif
    const hipError_t le = hipPeekAtLastError();
    if (le != hipSuccess) fprintf(stderr, "kernel_launch: launch failed: %s\n", hipGetErrorName(le));
}
```

```cpp
#include <hip/hip_runtime.h>
#include <cstdio>
#include <cstdint>

#define LAS __attribute__((address_space(3)))
typedef unsigned short bf16_t;
typedef short bf16x8 __attribute__((ext_vector_type(8)));
typedef short s16x4 __attribute__((ext_vector_type(4)));
typedef float f32x4 __attribute__((ext_vector_type(4)));
typedef float f32x2 __attribute__((ext_vector_type(2)));
typedef unsigned u32x4 __attribute__((ext_vector_type(4)));
typedef unsigned u32x2 __attribute__((ext_vector_type(2)));
#define DI __device__ __forceinline__

constexpr int D = 1024, NB = 8, SEQ = 4096, NCTX = 256, ML = NB * SEQ, MC = NB * NCTX, MT = ML + MC, DEPTH = 4;
constexpr int NPROJ = 7680, DIN = 7696, NEXP = 32, TOPK = 4;
constexpr int NROWS_MAX = (MT * TOPK / 256 + NEXP) * 256;
constexpr int NCHAIN = 2 * NB * 4, NSLOT = 68;
constexpr float LN_EPS = 1e-5f;
constexpr float DN_ALPHA = 1.6817928305074290f;
constexpr int PQ = 0, PK = 512, PV = 1024, PO = 1536, PNQ = 2048, PNK = 2560, PNV = 3072, PSU = 3584, PSV = 4096, PBG = 4608;

constexpr size_t al256(size_t x) { return (x + 255) & ~(size_t)255; }
constexpr size_t WS_CTL = 0, CTL_BYTES = 65536;
constexpr size_t WS_MOD = WS_CTL + CTL_BYTES;
constexpr size_t WS_ROPE = al256(WS_MOD + (size_t)4 * 9 * 6144 * 4);
constexpr size_t WS_WGATE = al256(WS_ROPE + 64 * 32 * 8);
constexpr size_t WS_WIN = al256(WS_WGATE + (size_t)4 * 16 * 1024 * 4);
constexpr size_t WS_WBR = al256(WS_WIN + (size_t)4 * NPROJ * 1024 * 2);
constexpr size_t WS_WOUT = al256(WS_WBR + (size_t)4 * 3 * 1024 * 512 * 2);
constexpr size_t WS_WGU = al256(WS_WOUT + (size_t)4 * 1024 * 1024 * 2);
constexpr size_t WS_WDN = al256(WS_WGU + (size_t)4 * 32 * 2048 * 1024 * 2);
constexpr size_t WS_X = al256(WS_WDN + (size_t)4 * 32 * 1024 * 1024 * 2);
constexpr size_t WS_H = al256(WS_X + (size_t)MT * D * 4);
constexpr size_t WS_H2 = al256(WS_H + (size_t)MT * D * 2);
constexpr size_t WS_P = al256(WS_H2 + (size_t)MT * D * 2);
constexpr size_t WS_GPRE = al256(WS_P + (size_t)MT * NPROJ * 2);
constexpr size_t WS_GA = al256(WS_GPRE + (size_t)MT * 16 * 4);
constexpr size_t WS_GCM = al256(WS_GA + (size_t)NCHAIN * NSLOT * 64 * 4);
constexpr size_t WS_GB = al256(WS_GCM + (size_t)NCHAIN * NSLOT * 64 * 4);
constexpr size_t WS_UC = al256(WS_GB + (size_t)NCHAIN * NSLOT * 64 * 4);
constexpr size_t WS_UN = al256(WS_UC + (size_t)NCHAIN * NSLOT * 128 * 128 * 2);
constexpr size_t WS_ABC = al256(WS_UN + (size_t)NCHAIN * NSLOT * 128 * 4);
constexpr size_t WS_MRG = al256(WS_ABC + (size_t)MT * 1536 * 2);
constexpr size_t WS_Y = al256(WS_MRG + (size_t)MT * D * 2);
constexpr size_t WS_TOPE = al256(WS_Y + (size_t)MT * D * 2);
constexpr size_t WS_TOPG = al256(WS_TOPE + (size_t)MT * 16);
constexpr size_t WS_TOPR = al256(WS_TOPG + (size_t)MT * 16);
constexpr size_t WS_DEST = al256(WS_TOPR + (size_t)MT * 16);
constexpr size_t WS_BASE = al256(WS_DEST + (size_t)MT * 16);
constexpr size_t WS_BLKE = al256(WS_BASE + 256 * 32 * 4);
constexpr size_t WS_XG = al256(WS_BLKE + 4096);
constexpr size_t WS_ACT = al256(WS_XG + (size_t)NROWS_MAX * D * 2);
constexpr size_t WS_YS = al256(WS_ACT + (size_t)NROWS_MAX * D * 2);
constexpr size_t SM_GBIAS = 0, SM_NORMG = SM_GBIAS + 64, SM_RPB = SM_NORMG + 2048, SM_SGLNG = SM_RPB + 14880, SM_SGLNB = SM_SGLNG + 2048, SM_SGW = SM_SGLNB + 2048, SM_SGB = SM_SGW + 262144,
                 SM_LN1G = SM_SGB + 2048, SM_LN1B = SM_LN1G + 4096, SM_RW = SM_LN1B + 4096, SM_RB = SM_RW + 131072, SM_BGU = SM_RB + 128, SM_BDN = SM_BGU + 262144, SM_LN2G = SM_BDN + 131072,
                 SM_LN2B = SM_LN2G + 4096, SM_END = SM_LN2B + 4096;
constexpr size_t WS_SM = al256(WS_YS + (size_t)NROWS_MAX * D * 2);
constexpr size_t WS_END = al256(WS_SM + SM_END * 4);
constexpr int CW_BAR = 0;
constexpr int CW_CNT = 16000;
static_assert((CW_CNT + 4 * 32) * 4 <= (int)CTL_BYTES, "ctl");

constexpr int LDS_BYTES = 147456;
constexpr int LDS_MISC = 147456 - 256;

DI unsigned f2bf(float f) { unsigned u = __builtin_bit_cast(unsigned, f); return (u + 0x7fffu + ((u >> 16) & 1u)) >> 16; }
DI unsigned pk2(float lo, float hi) { return f2bf(lo) | (f2bf(hi) << 16); }
DI float bf2f(unsigned b) { return __builtin_bit_cast(float, (b & 0xffffu) << 16); }
DI float bflo(unsigned w) { return __builtin_bit_cast(float, w << 16); }
DI float bfhi(unsigned w) { return __builtin_bit_cast(float, w & 0xffff0000u); }
DI unsigned cvt_pk_bf16(float lo, float hi) { unsigned r; asm volatile("v_cvt_pk_bf16_f32 %0, %1, %2" : "=v"(r) : "v"(lo), "v"(hi)); return r; }
DI float wave_sum(float v) { for (int o = 32; o >= 1; o >>= 1) v += __shfl_xor(v, o); return v; }
DI float wave_max(float v) { for (int o = 32; o >= 1; o >>= 1) v = fmaxf(v, __shfl_xor(v, o)); return v; }
DI float sigmoidf_(float x) { return 1.0f / (1.0f + __expf(-x)); }
DI float gelu_tanh(float x) { const float u = 0.7978845608028654f * (x + 0.044715f * x * x * x); const float e = __expf(2.0f * u); const float t = 1.0f - 2.0f / (e + 1.0f); return 0.5f * x * (1.0f + t); }
DI float log_sigmoid(float x) { return -(fmaxf(-x, 0.0f) + log1pf(expf(-fabsf(x)))); }
__host__ __device__ inline int rope_d(int p) { const int u = p >> 3, e = p & 7; return (u >> 3) * 64 + (e >> 2) * 32 + (u & 7) * 4 + (e & 3); }

DI int ltid() { int t = threadIdx.x; asm volatile("" : "+v"(t)); return t; }
DI int lbid() { int b = blockIdx.x; asm volatile("" : "+s"(b)); return b; }
DI int lgdim() { int g = gridDim.x; asm volatile("" : "+s"(g)); return g; }
template <int N> DI float bfly(float (&v)[N], int lane) {
    int off = 32;
#pragma unroll
    for (int n = N; n > 1; n >>= 1) {
        const unsigned mk = (lane & off) ? 0xffffffffu : 0u;
#pragma unroll
        for (int i = 0; i < n / 2; ++i) { const unsigned a = __builtin_bit_cast(unsigned, v[i]), b = __builtin_bit_cast(unsigned, v[i + n / 2]);
            const float keep = __builtin_bit_cast(float, (a & ~mk) | (b & mk)); const float send = __builtin_bit_cast(float, (b & ~mk) | (a & mk)); v[i] = keep + __shfl_xor(send, off); }
        off >>= 1;
    }
    for (; off >= 1; off >>= 1) v[0] += __shfl_xor(v[0], off);
    return v[0];
}

#define XB_TMO      128
#define XB_XCNT(j)  (256  + 64 * (j))
#define XB_XSUB(j)  (1280 + 64 * (j))
#define XB_XGEN(j)  (2304 + 64 * (j))
#define XB_TOP      3328
#define XB_TOPGEN   3392
#define XCD_BAR_WORDS 3456
#define XB_SPIN_CAP (1u << 22)
DI unsigned xb_ld(unsigned* p)              { return __hip_atomic_load(p, __ATOMIC_RELAXED, __HIP_MEMORY_SCOPE_AGENT); }
DI unsigned xb_add(unsigned* p, unsigned v) { return __hip_atomic_fetch_add(p, v, __ATOMIC_RELAXED, __HIP_MEMORY_SCOPE_AGENT); }
DI unsigned xb_xcc_id() { return (unsigned)__builtin_amdgcn_s_getreg((3 << 11) | 20) & 0xFu; }
#define XB_SPIN(cond, bar) do { unsigned _sp = 0; while (cond) { __builtin_amdgcn_s_sleep(1); \
    if ((++_sp & 255u) == 0u) { if (xb_ld(&(bar)[XB_TMO])) break; if (_sp > XB_SPIN_CAP) { atomicAdd(&(bar)[XB_TMO], 1u); break; } } } } while (0)
struct XcdBarrier { unsigned* bar; unsigned x; volatile LAS unsigned* st; };
DI XcdBarrier xcd_barrier_post(unsigned* bar, volatile LAS unsigned* st) {
    XcdBarrier b; b.bar = bar; b.x = xb_xcc_id(); b.st = st;
    if (threadIdx.x == 0) (void)xb_add(&bar[XB_XCNT(b.x)], 1u);
    return b;
}
DI void xcd_barrier_complete(unsigned* bar, unsigned x, unsigned& nloc, unsigned& nx) {
    const unsigned G = gridDim.x * gridDim.y * gridDim.z;
    unsigned sum, cnt, mine, sp = 0u;
    for (;;) {
        sum = 0u; cnt = 0u; mine = 0u;
#pragma unroll
        for (unsigned j = 0; j < 16; ++j) { const unsigned c = xb_ld(&bar[XB_XCNT(j)]); sum += c; cnt += (c > 0u) ? 1u : 0u; mine = (j == x) ? c : mine; }
        if (sum == G) break;
        __builtin_amdgcn_s_sleep(1);
        if ((++sp & 255u) == 0u) { if (xb_ld(&bar[XB_TMO])) break; if (sp > XB_SPIN_CAP) { atomicAdd(&bar[XB_TMO], 1u); break; } }
    }
    nloc = mine > 0u ? mine : 1u; nx = cnt > 0u ? cnt : 1u;
}
DI void xcd_barrier(const XcdBarrier& b) {
    asm volatile("s_waitcnt vmcnt(0)" ::: "memory");
    __syncthreads();
    if (threadIdx.x == 0) {
        unsigned* bar = b.bar;
        __builtin_amdgcn_s_waitcnt(0);
        unsigned nloc = b.st[0], nx = b.st[1];
        if (nloc == 0u) { xcd_barrier_complete(bar, b.x, nloc, nx); b.st[0] = nloc; b.st[1] = nx; }
        const unsigned old = xb_add(&bar[XB_XSUB(b.x)], 1u);
        const unsigned gen = old / nloc;
        if (old + 1u == (gen + 1u) * nloc) {
            __builtin_amdgcn_fence(__ATOMIC_RELEASE, "agent");
            asm volatile("s_waitcnt vmcnt(0)" ::: "memory");
            const unsigned og = xb_add(&bar[XB_TOP], 1u);
            const unsigned tg = og / nx;
            if (og + 1u == (tg + 1u) * nx) xb_add(&bar[XB_TOPGEN], 1u);
            else XB_SPIN(xb_ld(&bar[XB_TOPGEN]) == tg, bar);
            __builtin_amdgcn_fence(__ATOMIC_ACQUIRE, "agent");
            xb_add(&bar[XB_XGEN(b.x)], 1u);
            asm volatile("s_waitcnt vmcnt(0)" ::: "memory");
        } else {
            XB_SPIN(xb_ld(&bar[XB_XGEN(b.x)]) == gen, bar);
            __builtin_amdgcn_fence(__ATOMIC_ACQUIRE, "agent");
            asm volatile("s_waitcnt vmcnt(0)" ::: "memory");
        }
    }
    __syncthreads();
}
namespace pg8 {
constexpr int BM = 256, BK = 64, HALF = 128, HTB = HALF * BK * 2, STAGE_BYTES = 8 * HTB, NXCD = 8, WGM = 8;
__host__ __device__ __forceinline__ int lds_byte(int r, int c) { const int st = (r >> 4) * 2 + (c >> 5), rr = r & 15, cc = c & 31, ob = rr * 64 + cc * 2; return st * 1024 + (ob ^ (((ob >> 9) & 1) << 5)); }
__host__ __device__ __forceinline__ void stage_rc(int b, int& R, int& C) { const int st = b / 1024, sb = b % 1024, swz = sb ^ (((sb >> 9) & 1) << 5); R = (st >> 1) * 16 + swz / 64; C = (st & 1) * 32 + (swz % 64) / 2; }
__host__ __device__ __forceinline__ int perm32(int rho) { const int n = rho >> 4, i = rho & 15; return 8 * (i >> 2) + 4 * n + (i & 3); }

struct Unit { int pm, pn, aux; };

struct TileOrder {
    int nM, nN, nwg, G, c;
    __device__ void init(int nM_, int nN_, int G_, int c_) { nM = nM_; nN = nN_; nwg = nM * nN; G = G_; c = c_; }
    __device__ bool tile(int i, int& pm, int& pn) const {
        const long L = (long)i * G + c; if (L >= nwg) return false;
        int wgid = (int)L; { const int q = nwg / NXCD, r = nwg % NXCD, xcd = wgid % NXCD, off = wgid / NXCD; wgid = (xcd < r ? xcd * (q + 1) : r * (q + 1) + (xcd - r) * q) + off; }
        const int nig = WGM * nN, gid = wgid / nig, fm = gid * WGM, gsz = (nM - fm) < WGM ? (nM - fm) : WGM;
        pm = fm + ((wgid % nig) % gsz); pn = (wgid % nig) / gsz; return true;
    }
};

template <class Epi, class Sched>
__device__ __forceinline__ void gemm_phase(LAS unsigned char* lds, const int K, const Sched& S, const Epi& E) {
    const int tid = ltid(), wid = __builtin_amdgcn_readfirstlane(tid >> 6), lane = tid & 63, wr = wid >> 2, wc = wid & 3, fr = lane & 15, fq = lane >> 4;
    const int nt = K / BK;
    unsigned voffA[2], voffB[2]; const int lda = S.lda;
#pragma unroll
    for (int i = 0; i < 2; ++i) { int R, C; stage_rc(tid * 16 + i * 8192, R, C); const int Rb = (R & ~31) + perm32(R & 31); voffA[i] = (unsigned)(R * lda + C) * 2u; voffB[i] = (unsigned)(Rb * K + C) * 2u; }
    const size_t kstep = (size_t)(BK * 2);
    const size_t hstep = (size_t)HALF * K * 2;
    const size_t hstepA = (size_t)HALF * lda * 2;
    const unsigned ldsw = (unsigned)wid * 1024u;
    const int aoff = lds_byte(wr * 64 + fr, fq * 8), boff = lds_byte(wc * 32 + fr, fq * 8);
#define PG8_SA(b, h) (((b) * 2 + (h)) * HTB)
#define PG8_SB(b, h) ((4 + (b) * 2 + (h)) * HTB)
#define PG8_STAGE(bufoff, gbase, voff) do { _Pragma("unroll") for (int _i = 0; _i < 2; ++_i) \
        __builtin_amdgcn_global_load_lds((const unsigned*)((const char*)(gbase) + (voff)[_i]), (LAS unsigned*)(lds + (bufoff) + ldsw + _i * 8192), 16, 0, 0); } while (0)
#define PG8_LDA(dst, b, h) do { _Pragma("unroll") for (int m = 0; m < 4; ++m) _Pragma("unroll") for (int k = 0; k < 2; ++k) dst[m][k] = *(const LAS bf16x8*)(lds + PG8_SA(b, h) + aoff + m * 2048 + k * 1024); } while (0)
#define PG8_LDB(dst, b, h) do { _Pragma("unroll") for (int n = 0; n < 2; ++n) _Pragma("unroll") for (int k = 0; k < 2; ++k) dst[n][k] = *(const LAS bf16x8*)(lds + PG8_SB(b, h) + boff + n * 2048 + k * 1024); } while (0)
#define PG8_MMA(ai, bj, At, Bt) do { __builtin_amdgcn_s_setprio(1); _Pragma("unroll") for (int m = 0; m < 4; ++m) _Pragma("unroll") for (int n = 0; n < 2; ++n) _Pragma("unroll") for (int k = 0; k < 2; ++k) \
        acc[ai][bj][m][n] = __builtin_amdgcn_mfma_f32_16x16x32_bf16(Bt[n][k], At[m][k], acc[ai][bj][m][n], 0, 0, 0); __builtin_amdgcn_s_setprio(0); } while (0)
#define PG8_WAIT_V(n) asm volatile("s_waitcnt vmcnt(" #n ")" ::: "memory")
#define PG8_WAIT_L(n) asm volatile("s_waitcnt lgkmcnt(" #n ")" ::: "memory")
#define PG8_BAR __builtin_amdgcn_s_barrier()
#define PG8_SCHED __builtin_amdgcn_sched_barrier(0)
    Unit cur, nxt; int ui = 0;
    if (!S.next(0, cur)) return;
    f32x4 acc[2][2][4][2];
#pragma unroll
    for (int a = 0; a < 2; ++a)
#pragma unroll
        for (int b = 0; b < 2; ++b)
#pragma unroll
            for (int m = 0; m < 4; ++m)
#pragma unroll
                for (int n = 0; n < 2; ++n) acc[a][b][m][n] = (f32x4){0.f, 0.f, 0.f, 0.f};
    bf16x8 At[4][2], B0[2][2], B1[2][2];
    const char* cA = S.a_base(cur); const char* cB = S.b_base(cur);
    PG8_STAGE(PG8_SB(0, 0), cB, voffB); PG8_STAGE(PG8_SB(0, 1), cB + hstep, voffB); PG8_STAGE(PG8_SA(0, 0), cA, voffA); PG8_STAGE(PG8_SA(0, 1), cA + hstepA, voffA);
    if (wr == 1) PG8_BAR;
    PG8_WAIT_V(2); PG8_BAR;
    PG8_STAGE(PG8_SB(1, 0), cB + kstep, voffB); PG8_STAGE(PG8_SA(1, 0), cA + kstep, voffA); PG8_STAGE(PG8_SB(1, 1), cB + hstep + kstep, voffB);
    PG8_WAIT_V(6); PG8_BAR;
    for (;;) {
        const bool has_next = S.next(ui + 1, nxt);
        const char* nA = has_next ? S.a_base(nxt) : cA; const char* nB = has_next ? S.b_base(nxt) : cB;
        for (int t = 0; t < nt; t += 2) {
            const bool last = (t == nt - 2);
            const char* a1 = cA + (size_t)(t + 1) * kstep;
            const char* a2 = last ? nA : cA + (size_t)(t + 2) * kstep; const char* b2 = last ? nB : cB + (size_t)(t + 2) * kstep;
            const char* a3 = a2 + kstep; const char* b3 = b2 + kstep;
            PG8_LDB(B0, 0, 0); PG8_LDB(B1, 0, 1); PG8_SCHED; PG8_LDA(At, 0, 0); PG8_STAGE(PG8_SA(1, 1), a1 + hstepA, voffA);
            PG8_WAIT_V(8); PG8_WAIT_L(0); PG8_BAR; PG8_MMA(0, 0, At, B0); PG8_MMA(0, 1, At, B1); PG8_BAR; PG8_SCHED;
            PG8_LDA(At, 0, 1); PG8_STAGE(PG8_SB(0, 0), b2, voffB); PG8_STAGE(PG8_SB(0, 1), b2 + hstep, voffB); PG8_STAGE(PG8_SA(0, 0), a2, voffA);
            PG8_WAIT_V(8); PG8_WAIT_L(0); PG8_BAR; PG8_MMA(1, 0, At, B0); PG8_MMA(1, 1, At, B1); PG8_BAR; PG8_SCHED;
            PG8_LDB(B0, 1, 0); PG8_LDB(B1, 1, 1); PG8_SCHED; PG8_LDA(At, 1, 0); PG8_STAGE(PG8_SA(0, 1), a2 + hstepA, voffA);
            PG8_WAIT_V(8); PG8_WAIT_L(0); PG8_BAR; PG8_MMA(0, 0, At, B0); PG8_MMA(0, 1, At, B1); PG8_BAR; PG8_SCHED;
            PG8_LDA(At, 1, 1); PG8_STAGE(PG8_SB(1, 0), b3, voffB); PG8_STAGE(PG8_SB(1, 1), b3 + hstep, voffB); PG8_STAGE(PG8_SA(1, 0), a3, voffA);
            PG8_WAIT_V(8); PG8_WAIT_L(0); PG8_BAR; PG8_MMA(1, 0, At, B0); PG8_MMA(1, 1, At, B1); PG8_BAR; PG8_SCHED;
        }
        if (wr == 0) PG8_BAR;
        E(acc, cur, wr, wc, fr, fq);
        if (!has_next) break;
#pragma unroll
        for (int a = 0; a < 2; ++a)
#pragma unroll
            for (int b = 0; b < 2; ++b)
#pragma unroll
                for (int m = 0; m < 4; ++m)
#pragma unroll
                    for (int n = 0; n < 2; ++n) acc[a][b][m][n] = (f32x4){0.f, 0.f, 0.f, 0.f};
        cur = nxt; cA = nA; cB = nB; ++ui;
        if (wr == 1) PG8_BAR;
    }
    PG8_WAIT_V(0);
    PG8_BAR;
#undef PG8_SA
#undef PG8_SB
#undef PG8_STAGE
#undef PG8_LDA
#undef PG8_LDB
#undef PG8_MMA
#undef PG8_WAIT_V
#undef PG8_WAIT_L
#undef PG8_BAR
#undef PG8_SCHED
}
}
struct Params {
    const float *x, *c, *ctx, *c_ctx, *w_mod, *b_mod, *w_in, *gate_bias, *norm_g, *rpb, *sg_ln_g, *sg_ln_b, *sg_w, *sg_b, *w_branch, *w_out,
                *ln1_g, *ln1_b, *router_w, *router_b, *w_gu, *b_gu, *w_dn, *b_dn, *ln2_g, *ln2_b;
    float* out; unsigned char* ws;
    int ph_lo, ph_hi, li, pad;
};
template <class T> DI T* wsp(const Params& p, size_t off) { return (T*)(p.ws + off); }
#define SMP(o) (wsp<float>(p, WS_SM) + (o))

DI int row_of(int blk, int wave, int i) { return i < 16 ? blk * 128 + wave * 16 + i : ML + blk * 8 + wave; }
DI int bsel_of(int row) { return row < ML ? (row >> 12) : 8; }

template <int MAP> DI int cmap(int n) {
    if (MAP == 1) { if (n < 1024) return (n & ~127) + rope_d(n & 127); return n < 2048 ? n : n + 16; }
    if (MAP == 2) { const int u = n >> 3, e = n & 7; return e < 4 ? 4 * u + e : 1024 + 4 * u + (e - 4); }
    return n;
}
template <int MAP> DI void cvt_tile(const float* src, int ld, bf16_t* dst, int K, int k0, int n0, LAS float* tile) {
    const int tid = ltid();
    { const int kk = tid >> 7, n = tid & 127; const int sc = cmap<MAP>(n0 + n);
#pragma unroll 4
      for (int it = 0; it < 16; ++it) { const int k = it * 4 + kk; tile[k * 129 + n] = src[(size_t)(k0 + k) * ld + sc]; } }
    __syncthreads();
    { const int n = tid >> 2, kc = (tid & 3) * 16; unsigned w[8];
#pragma unroll
      for (int j = 0; j < 8; ++j) w[j] = pk2(tile[(kc + 2 * j) * 129 + n], tile[(kc + 2 * j + 1) * 129 + n]);
      bf16_t* d = dst + (size_t)(n0 + n) * K + k0 + kc;
      *(u32x4*)d = (u32x4){w[0], w[1], w[2], w[3]}; *(u32x4*)(d + 8) = (u32x4){w[4], w[5], w[6], w[7]}; }
    __syncthreads();
}
DI void phase_prologue_a(const Params& p, LAS unsigned char* lds) {
    const int tid = ltid(), G = lgdim(), blk = lbid();
    LAS float* tile = (LAS float*)lds;
    constexpr int T_IN = 4 * 16 * 60, T_BR = 12 * 8 * 8, T_OUT = 4 * 16 * 8, T_GU = 128 * 16 * 16, T_DN = 128 * 16 * 8;
    constexpr int T_ALL = T_IN + T_BR + T_OUT + T_GU + T_DN;
    for (int t = blk; t < T_ALL; t += G) {
        int u = t;
        if (u < T_IN) { const int l = u / 960, r = u % 960; cvt_tile<1>(p.w_in + (size_t)l * 1024 * DIN, DIN, wsp<bf16_t>(p, WS_WIN) + (size_t)l * NPROJ * 1024, 1024, (r / 60) * 64, (r % 60) * 128, tile); continue; }
        u -= T_IN;
        if (u < T_BR) { const int m = u / 64, r = u % 64; cvt_tile<0>(p.w_branch + (size_t)m * 512 * 1024, 1024, wsp<bf16_t>(p, WS_WBR) + (size_t)m * 1024 * 512, 512, (r / 8) * 64, (r % 8) * 128, tile); continue; }
        u -= T_BR;
        if (u < T_OUT) { const int l = u / 128, r = u % 128; cvt_tile<0>(p.w_out + (size_t)l * 1024 * 1024, 1024, wsp<bf16_t>(p, WS_WOUT) + (size_t)l * 1024 * 1024, 1024, (r / 8) * 64, (r % 8) * 128, tile); continue; }
        u -= T_OUT;
        if (u < T_GU) { const int m = u / 256, r = u % 256; cvt_tile<2>(p.w_gu + (size_t)m * 1024 * 2048, 2048, wsp<bf16_t>(p, WS_WGU) + (size_t)m * 2048 * 1024, 1024, (r / 16) * 64, (r % 16) * 128, tile); continue; }
        u -= T_GU;
        { const int m = u / 128, r = u % 128; cvt_tile<0>(p.w_dn + (size_t)m * 1024 * 1024, 1024, wsp<bf16_t>(p, WS_WDN) + (size_t)m * 1024 * 1024, 1024, (r / 8) * 64, (r % 8) * 128, tile); }
    }
    for (int i = blk * 512 + tid; i < 64 * 32; i += G * 512) { const int pos = i >> 5, f = i & 31; const float inv = powf(10000.0f, -(float)f / 32.0f); const float ang = (float)pos * inv;
        wsp<f32x2>(p, WS_ROPE)[i] = (f32x2){cosf(ang), sinf(ang)}; }
    for (int i = blk * 512 + tid; i < 4 * 16 * 1024; i += G * 512) { const int l = i >> 14, g = (i >> 10) & 15, k = i & 1023; wsp<float>(p, WS_WGATE)[i] = p.w_in[((size_t)l * 1024 + k) * DIN + 2048 + g]; }
    { const float* srcs[15] = {p.gate_bias, p.norm_g, p.rpb, p.sg_ln_g, p.sg_ln_b, p.sg_w, p.sg_b, p.ln1_g, p.ln1_b, p.router_w, p.router_b, p.b_gu, p.b_dn, p.ln2_g, p.ln2_b};
      const size_t offs[16] = {SM_GBIAS, SM_NORMG, SM_RPB, SM_SGLNG, SM_SGLNB, SM_SGW, SM_SGB, SM_LN1G, SM_LN1B, SM_RW, SM_RB, SM_BGU, SM_BDN, SM_LN2G, SM_LN2B, SM_END};
      float* dsm = wsp<float>(p, WS_SM);
#pragma unroll
      for (int a = 0; a < 15; ++a) { const int n = (int)(offs[a + 1] - offs[a]); const float* sp = srcs[a]; for (int i = blk * 512 + tid; i < n; i += G * 512) dsm[offs[a] + i] = sp[i]; } }
    LAS float* sl = (LAS float*)lds;
    LAS float* red = sl + 9 * 1024;
    for (int i = tid; i < 9 * 1024; i += 512) { const float v = i < 8192 ? p.c[i] : p.c_ctx[i - 8192]; sl[i] = v / (1.0f + __expf(-v)); }
    __syncthreads();
    for (int u = blk; u < 4 * 96; u += G) {
        const int l = u / 96, c0 = (u % 96) * 64, col = c0 + (tid & 63), kg = tid >> 6;
        float a[9];
#pragma unroll
        for (int b = 0; b < 9; ++b) a[b] = 0.f;
        const float* w = p.w_mod + ((size_t)l * 1024 + kg * 128) * 6144 + col;
#pragma unroll 4
        for (int k = 0; k < 128; ++k) { const float wv = w[(size_t)k * 6144];
#pragma unroll
            for (int b = 0; b < 9; ++b) a[b] += sl[b * 1024 + kg * 128 + k] * wv; }
#pragma unroll
        for (int b = 0; b < 9; ++b) red[(kg * 64 + (tid & 63)) * 9 + b] = a[b];
        __syncthreads();
        for (int i = tid; i < 64 * 9; i += 512) { const int cc = i / 9, b = i % 9; float s = 0.f;
#pragma unroll
            for (int g = 0; g < 8; ++g) s += red[(g * 64 + cc) * 9 + b];
            wsp<float>(p, WS_MOD)[((size_t)l * 9 + b) * 6144 + c0 + cc] = s + p.b_mod[(size_t)l * 6144 + c0 + cc]; }
        __syncthreads();
    }
}

DI void ld_row_f32(const float* p, float (&v)[16], int lane) {
#pragma unroll
    for (int j = 0; j < 4; ++j) { const f32x4 t = *(const f32x4*)(p + 256 * j + 4 * lane); v[4 * j] = t[0]; v[4 * j + 1] = t[1]; v[4 * j + 2] = t[2]; v[4 * j + 3] = t[3]; }
}
DI void st_row_f32(float* p, const float (&v)[16], int lane) {
#pragma unroll
    for (int j = 0; j < 4; ++j) *(f32x4*)(p + 256 * j + 4 * lane) = (f32x4){v[4 * j], v[4 * j + 1], v[4 * j + 2], v[4 * j + 3]};
}
DI void ld_row_bf16(const bf16_t* p, float (&v)[16], int lane) {
#pragma unroll
    for (int j = 0; j < 4; ++j) { const u32x2 t = *(const u32x2*)(p + 256 * j + 4 * lane); v[4 * j] = bflo(t[0]); v[4 * j + 1] = bfhi(t[0]); v[4 * j + 2] = bflo(t[1]); v[4 * j + 3] = bfhi(t[1]); }
}
DI void st_row_bf16(bf16_t* p, const float (&v)[16], int lane) {
#pragma unroll
    for (int j = 0; j < 4; ++j) *(u32x2*)(p + 256 * j + 4 * lane) = (u32x2){pk2(v[4 * j], v[4 * j + 1]), pk2(v[4 * j + 2], v[4 * j + 3])};
}
DI void ln_row(float (&v)[16], const float* g, const float* b, int lane) {
    float s = 0.f;
#pragma unroll
    for (int i = 0; i < 16; ++i) s += v[i];
    const float mean = wave_sum(s) * (1.0f / 1024.0f);
    float q = 0.f;
#pragma unroll
    for (int i = 0; i < 16; ++i) { const float d = v[i] - mean; q += d * d; }
    const float rstd = 1.0f / sqrtf(wave_sum(q) * (1.0f / 1024.0f) + LN_EPS);
    float gg[16], bb[16]; ld_row_f32(g, gg, lane); ld_row_f32(b, bb, lane);
#pragma unroll
    for (int i = 0; i < 16; ++i) v[i] = (v[i] - mean) * rstd * gg[i] + bb[i];
}
DI void modulate(const float (&v)[16], float (&h)[16], const float* sh, const float* sc, int lane) {
    float a[16], b[16]; ld_row_f32(sh, a, lane); ld_row_f32(sc, b, lane);
#pragma unroll
    for (int i = 0; i < 16; ++i) h[i] = v[i] * (1.0f + b[i]) + a[i];
}
template <int N> DI float row_dots(const float (&h)[16], const LAS float* wl, int lane) {
    float s[N];
#pragma unroll
    for (int e = 0; e < N; ++e) s[e] = 0.f;
#pragma unroll 1
    for (int eg = 0; eg < N / 4; ++eg) {
        float a[4];
#pragma unroll
        for (int i = 0; i < 4; ++i) { float t = 0.f;
#pragma unroll
            for (int j = 0; j < 4; ++j) { const f32x4 w = *(const LAS f32x4*)(wl + (eg * 4 + i) * 1024 + 256 * j + 4 * lane); t += h[4 * j] * w[0] + h[4 * j + 1] * w[1] + h[4 * j + 2] * w[2] + h[4 * j + 3] * w[3]; }
            a[i] = t; }
#pragma unroll
        for (int k = 0; k < N / 4; ++k) { const unsigned mk = (k == eg) ? 0xffffffffu : 0u;
#pragma unroll
            for (int i = 0; i < 4; ++i) s[4 * k + i] = __builtin_bit_cast(float, (__builtin_bit_cast(unsigned, s[4 * k + i]) & ~mk) | (__builtin_bit_cast(unsigned, a[i]) & mk)); }
    }
    return bfly<N>(s, lane);
}
DI void load_small_w(LAS float* wl, const float* src, int n  ) { for (int i = ltid(); i < n / 4; i += 512) *(LAS f32x4*)(wl + 4 * i) = *(const f32x4*)(src + 4 * i); __syncthreads(); }

DI void emit_h_and_gates(const Params& p, int layer, int row, const float (&x)[16], const LAS float* wg, int lane) {
    const float* mod = wsp<float>(p, WS_MOD) + ((size_t)layer * 9 + bsel_of(row)) * 6144;
    float h[16]; modulate(x, h, mod, mod + 1024, lane);
    st_row_bf16(wsp<bf16_t>(p, WS_H) + (size_t)row * D, h, lane);
    const float g = row_dots<16>(h, wg, lane);
    if ((lane & 3) == 0) wsp<float>(p, WS_GPRE)[(size_t)row * 16 + (lane >> 2)] = g;
}
DI void phase_init(const Params& p, LAS unsigned char* lds) {
    const int lane = ltid() & 63, wave = ltid() >> 6, blk = lbid();
    LAS float* wg = (LAS float*)lds; load_small_w(wg, wsp<float>(p, WS_WGATE), 16 * 1024);
#pragma unroll 1
    for (int i = 0; i < 17; ++i) { const int row = row_of(blk, wave, i);
        float x[16]; ld_row_f32(row < ML ? p.x + (size_t)row * D : p.ctx + (size_t)(row - ML) * D, x, lane);
        st_row_f32(wsp<float>(p, WS_X) + (size_t)row * D, x, lane);
        emit_h_and_gates(p, 0, row, x, wg, lane); }
}

DI void phase_ln1_router(const Params& p, int layer, LAS unsigned char* lds) {
    const int tid = ltid(), lane = tid & 63, wave = tid >> 6, blk = lbid();
    LAS float* rw = (LAS float*)lds;
    LAS int* cnt = (LAS int*)(lds + 32 * 1024 * 4);
    { const float* src = SMP(SM_RW) + (size_t)layer * 1024 * 32;
      for (int i = tid; i < 32 * 1024; i += 512) { const int k = i >> 5, e = i & 31; rw[e * 1024 + k] = src[i]; }
      if (tid < 32) cnt[tid] = 0; }
    __syncthreads();
    const bool last = (layer == DEPTH - 1);
#pragma unroll 1
    for (int i = 0; i < 17; ++i) { const int row = row_of(blk, wave, i);
        if (last && row >= ML) continue;
        const float* mod = wsp<float>(p, WS_MOD) + ((size_t)layer * 9 + bsel_of(row)) * 6144;
        float x[16], y[16], g1[16];
        ld_row_f32(wsp<float>(p, WS_X) + (size_t)row * D, x, lane); ld_row_bf16(wsp<bf16_t>(p, WS_Y) + (size_t)row * D, y, lane); ld_row_f32(mod + 2 * 1024, g1, lane);
#pragma unroll
        for (int j = 0; j < 16; ++j) x[j] = DN_ALPHA * x[j] + g1[j] * y[j];
        ln_row(x, SMP(SM_LN1G) + (size_t)layer * D, SMP(SM_LN1B) + (size_t)layer * D, lane);
        st_row_f32(wsp<float>(p, WS_X) + (size_t)row * D, x, lane);
        float h[16]; modulate(x, h, mod + 3 * 1024, mod + 4 * 1024, lane);
        st_row_bf16(wsp<bf16_t>(p, WS_H2) + (size_t)row * D, h, lane);
        float lg = row_dots<32>(h, rw, lane) + SMP(SM_RB)[layer * 32 + (lane >> 1)];
        int te[4]; float tv[4];
#pragma unroll
        for (int k = 0; k < 4; ++k) {
            float bv = lg; int be = lane >> 1;
#pragma unroll
            for (int o = 32; o >= 1; o >>= 1) { const float ov = __shfl_xor(bv, o); const int oe = __shfl_xor(be, o); if (ov > bv || (ov == bv && oe < be)) { bv = ov; be = oe; } }
            te[k] = be; tv[k] = bv; if ((lane >> 1) == be) lg = -3.0e38f;
        }
        const float e1 = __expf(tv[1] - tv[0]), e2 = __expf(tv[2] - tv[0]), e3 = __expf(tv[3] - tv[0]); const float inv = 1.0f / (1.0f + e1 + e2 + e3);
        if (lane < 4) { const int e = lane == 0 ? te[0] : lane == 1 ? te[1] : lane == 2 ? te[2] : te[3]; const float gk = (lane == 0 ? 1.0f : lane == 1 ? e1 : lane == 2 ? e2 : e3) * inv;
            const int r = atomicAdd((int*)&cnt[e], 1);
            wsp<int>(p, WS_TOPE)[(size_t)row * 4 + lane] = e; wsp<float>(p, WS_TOPG)[(size_t)row * 4 + lane] = gk; wsp<int>(p, WS_TOPR)[(size_t)row * 4 + lane] = r; }
    }
    __syncthreads();
    if (tid < 32) { const int c = cnt[tid]; int base = 0; if (c > 0) base = (int)atomicAdd(wsp<unsigned>(p, WS_CTL) + CW_CNT + layer * 32 + tid, (unsigned)c); wsp<int>(p, WS_BASE)[blk * 32 + tid] = base; }
}

DI void phase_scatter(const Params& p, int layer, LAS unsigned char* lds) {
    const int tid = ltid(), lane = tid & 63, wave = tid >> 6, blk = lbid();
    LAS int* pst = (LAS int*)lds;
    if (tid == 0) { int acc = 0; for (int e = 0; e < 32; ++e) { const int c = (int)__hip_atomic_load(wsp<unsigned>(p, WS_CTL) + CW_CNT + layer * 32 + e, __ATOMIC_RELAXED, __HIP_MEMORY_SCOPE_AGENT); pst[e] = acc; pst[32 + e] = c; acc += (c + 255) & ~255; } pst[64] = acc >> 8; }
    __syncthreads();
    if (blk == 0) { int* be = wsp<int>(p, WS_BLKE); if (tid == 0) be[0] = pst[64];
#pragma unroll 1
        for (int e = 0; e < 32; ++e) { const int b0 = pst[e] >> 8, nb = (pst[32 + e] + 255) >> 8; for (int j = tid; j < nb; j += 512) be[1 + b0 + j] = e; } }
    const bool last = (layer == DEPTH - 1);
#pragma unroll 1
    for (int i = 0; i < 17; ++i) { const int row = row_of(blk, wave, i);
        if (last && row >= ML) continue;
        const u32x4* src = (const u32x4*)(wsp<bf16_t>(p, WS_H2) + (size_t)row * D);
        const u32x4 v0 = src[lane], v1 = src[64 + lane];
#pragma unroll
        for (int k = 0; k < 4; ++k) { const int e = wsp<int>(p, WS_TOPE)[(size_t)row * 4 + k], r = wsp<int>(p, WS_TOPR)[(size_t)row * 4 + k];
            const int dest = pst[e] + wsp<int>(p, WS_BASE)[blk * 32 + e] + r;
            if (lane == 0) wsp<int>(p, WS_DEST)[(size_t)row * 4 + k] = dest;
            u32x4* d = (u32x4*)(wsp<bf16_t>(p, WS_XG) + (size_t)dest * D); d[lane] = v0; d[64 + lane] = v1; }
    }
}

DI void phase_ln2(const Params& p, int layer, LAS unsigned char* lds) {
    const int tid = ltid(), lane = tid & 63, wave = tid >> 6, blk = lbid();
    const bool last = (layer == DEPTH - 1);
    LAS float* wg = (LAS float*)lds;
    if (!last) load_small_w(wg, wsp<float>(p, WS_WGATE) + (size_t)(layer + 1) * 16 * 1024, 16 * 1024);
#pragma unroll 1
    for (int i = 0; i < 17; ++i) { const int row = row_of(blk, wave, i);
        if (last && row >= ML) continue;
        const float* mod = wsp<float>(p, WS_MOD) + ((size_t)layer * 9 + bsel_of(row)) * 6144;
        float x[16], f[16], g2[16];
#pragma unroll
        for (int j = 0; j < 16; ++j) f[j] = 0.f;
#pragma unroll
        for (int k = 0; k < 4; ++k) { const int dest = wsp<int>(p, WS_DEST)[(size_t)row * 4 + k]; const float gk = wsp<float>(p, WS_TOPG)[(size_t)row * 4 + k];
            float y[16]; ld_row_bf16(wsp<bf16_t>(p, WS_YS) + (size_t)dest * D, y, lane);
#pragma unroll
            for (int j = 0; j < 16; ++j) f[j] += gk * y[j]; }
        ld_row_f32(wsp<float>(p, WS_X) + (size_t)row * D, x, lane); ld_row_f32(mod + 5 * 1024, g2, lane);
#pragma unroll
        for (int j = 0; j < 16; ++j) x[j] = DN_ALPHA * x[j] + g2[j] * f[j];
        ln_row(x, SMP(SM_LN2G) + (size_t)layer * D, SMP(SM_LN2B) + (size_t)layer * D, lane);
        if (last) { st_row_f32(p.out + (size_t)row * D, x, lane); }
        else { st_row_f32(wsp<float>(p, WS_X) + (size_t)row * D, x, lane); emit_h_and_gates(p, layer + 1, row, x, wg, lane); }
    }
}
using pg8::Unit;
struct SchedDense {
    pg8::TileOrder T; const bf16_t* A; int lda; const bf16_t* Bt; int K;
    DI bool next(int i, Unit& u) const { u.aux = 0; return T.tile(i, u.pm, u.pn); }
    DI const char* a_base(const Unit& u) const { return (const char*)(A + (size_t)u.pm * 256 * lda); }
    DI const char* b_base(const Unit& u) const { return (const char*)(Bt + (size_t)u.pn * 256 * K); }
};
struct SchedMerge {
    pg8::TileOrder T; const bf16_t* A; const bf16_t* Bt; static constexpr int lda = 1536;
    DI bool next(int i, Unit& u) const { u.aux = i % 3; return T.tile(i / 3, u.pm, u.pn); }
    DI const char* a_base(const Unit& u) const { return (const char*)(A + (size_t)u.pm * 256 * 1536 + u.aux * 512); }
    DI const char* b_base(const Unit& u) const { return (const char*)(Bt + ((size_t)u.aux * 1024 + (size_t)u.pn * 256) * 512); }
};
template <int NT> struct SchedMoe {
    const int* blke; int nunits, G, c; const bf16_t* A; const bf16_t* Bt; size_t bstride; static constexpr int lda = 1024;
    DI void init(const int* blke_, int G_, int c_) { blke = blke_; nunits = blke_[0] * NT; G = G_; c = c_; }
    DI bool next(int i, Unit& u) const { const int L = i * G + c; if (L >= nunits) return false; u.pm = L / NT; u.pn = L % NT; u.aux = blke[1 + u.pm]; return true; }
    DI const char* a_base(const Unit& u) const { return (const char*)(A + (size_t)u.pm * 256 * 1024); }
    DI const char* b_base(const Unit& u) const { return (const char*)(Bt + (size_t)u.aux * bstride + (size_t)u.pn * 256 * 1024); }
};

#define EPI_ROWS_BEGIN _Pragma("unroll") for (int ai = 0; ai < 2; ++ai) _Pragma("unroll") for (int m = 0; m < 4; ++m) { const int row = u.pm * 256 + ai * 128 + wr * 64 + m * 16 + fr;
#define EPI_ROWS_END }
DI u32x4 pack8(const f32x4& a, const f32x4& b) { return (u32x4){cvt_pk_bf16(a[0], a[1]), cvt_pk_bf16(a[2], a[3]), cvt_pk_bf16(b[0], b[1]), cvt_pk_bf16(b[2], b[3])}; }

struct EpiInproj {
    bf16_t* P; const f32x2* rope;
    DI void operator()(const f32x4 (&acc)[2][2][4][2], const Unit& u, int wr, int wc, int fr, int fq) const {
        const int pn = u.pn; const int colb = pn * 256 + wc * 32 + 8 * fq;
        const int kind = pn < 2 ? 0 : pn < 4 ? 1 : pn < 6 ? 2 : pn < 8 ? 3 : pn < 10 ? 4 : pn < 14 ? 2 : pn < 18 ? 5 : 3;
        const bool latent = u.pm < 128;
        const int ra = wc >> 1, f0 = ((wc & 1) * 4 + fq) * 4;
        EPI_ROWS_BEGIN
            bf16_t* rowp = P + (size_t)row * NPROJ + colb;
            f32x4 cs[2]; if (kind <= 1 && latent) { const int t = row & 4095; const int pos = ra ? (t & 63) : (t >> 6); const f32x4* rp = (const f32x4*)(rope + pos * 32 + f0); cs[0] = rp[0]; cs[1] = rp[1]; }
#pragma unroll
            for (int bj = 0; bj < 2; ++bj) { f32x4 v0 = acc[ai][bj][m][0], v1 = acc[ai][bj][m][1];
                if (kind == 0) { v0 = v0 * 0.08838834764831845f; v1 = v1 * 0.08838834764831845f; }
                if (kind == 4) { v0 = v0 * 0.125f; v1 = v1 * 0.125f; }
                if (kind <= 1 && latent) {
                    const float c[4] = {cs[0][0], cs[0][2], cs[1][0], cs[1][2]}, s[4] = {cs[0][1], cs[0][3], cs[1][1], cs[1][3]};
#pragma unroll
                    for (int j = 0; j < 4; ++j) { const float x1 = v0[j], x2 = v1[j]; v0[j] = x1 * c[j] - x2 * s[j]; v1[j] = x2 * c[j] + x1 * s[j]; } }
                if (kind == 3) {
#pragma unroll
                    for (int j = 0; j < 4; ++j) { v0[j] = sigmoidf_(v0[j]); v1[j] = sigmoidf_(v1[j]); } }
                if (kind == 5) {
#pragma unroll
                    for (int j = 0; j < 4; ++j) { v0[j] = gelu_tanh(v0[j]); v1[j] = gelu_tanh(v1[j]); } }
                *(u32x4*)(rowp + bj * 128) = pack8(v0, v1); }
        EPI_ROWS_END
    }
};
struct EpiMerge {
    bf16_t* Mg; const bf16_t* P;
    DI void operator()(const f32x4 (&acc)[2][2][4][2], const Unit& u, int wr, int wc, int fr, int fq) const {
        const int colb = u.pn * 256 + wc * 32 + 8 * fq;
        EPI_ROWS_BEGIN
#pragma unroll
            for (int bj = 0; bj < 2; ++bj) { const int col = colb + bj * 128;
                const u32x4 g = *(const u32x4*)(P + (size_t)row * NPROJ + PBG + u.aux * 1024 + col);
                f32x4 v0 = acc[ai][bj][m][0], v1 = acc[ai][bj][m][1];
                v0 = v0 * (f32x4){bflo(g[0]), bfhi(g[0]), bflo(g[1]), bfhi(g[1])}; v1 = v1 * (f32x4){bflo(g[2]), bfhi(g[2]), bflo(g[3]), bfhi(g[3])};
                u32x4* dst = (u32x4*)(Mg + (size_t)row * D + col);
                if (u.aux > 0) { const u32x4 o = *dst; v0 = v0 + (f32x4){bflo(o[0]), bfhi(o[0]), bflo(o[1]), bfhi(o[1])}; v1 = v1 + (f32x4){bflo(o[2]), bfhi(o[2]), bflo(o[3]), bfhi(o[3])}; }
                *dst = pack8(v0, v1); }
        EPI_ROWS_END
    }
};
struct EpiStore {
    bf16_t* O; int ldo; const float* bias; int bias_stride;
    DI void operator()(const f32x4 (&acc)[2][2][4][2], const Unit& u, int wr, int wc, int fr, int fq) const {
        const int colb = u.pn * 256 + wc * 32 + 8 * fq;
        f32x4 bv[2][2];
#pragma unroll
        for (int bj = 0; bj < 2; ++bj)
#pragma unroll
            for (int n = 0; n < 2; ++n) bv[bj][n] = bias ? *(const f32x4*)(bias + (size_t)u.aux * bias_stride + colb + bj * 128 + 4 * n) : (f32x4){0.f, 0.f, 0.f, 0.f};
        EPI_ROWS_BEGIN
#pragma unroll
            for (int bj = 0; bj < 2; ++bj) *(u32x4*)(O + (size_t)row * ldo + colb + bj * 128) = pack8(acc[ai][bj][m][0] + bv[bj][0], acc[ai][bj][m][1] + bv[bj][1]);
        EPI_ROWS_END
    }
};
struct EpiGu {
    bf16_t* ACT; const float* b_gu;
    DI void operator()(const f32x4 (&acc)[2][2][4][2], const Unit& u, int wr, int wc, int fr, int fq) const {
        f32x4 bg[2], bu[2];
#pragma unroll
        for (int bj = 0; bj < 2; ++bj) { const int oc = u.pn * 128 + bj * 64 + wc * 16 + 4 * fq; bg[bj] = *(const f32x4*)(b_gu + (size_t)u.aux * 2048 + oc); bu[bj] = *(const f32x4*)(b_gu + (size_t)u.aux * 2048 + 1024 + oc); }
        EPI_ROWS_BEGIN
#pragma unroll
            for (int bj = 0; bj < 2; ++bj) { const int oc = u.pn * 128 + bj * 64 + wc * 16 + 4 * fq;
                const f32x4 g = acc[ai][bj][m][0] + bg[bj], up = acc[ai][bj][m][1] + bu[bj]; float a[4];
#pragma unroll
                for (int j = 0; j < 4; ++j) { const float gt = fminf(g[j], 7.0f), ut = fminf(fmaxf(up[j], -7.0f), 7.0f); a[j] = gt * sigmoidf_(1.702f * gt) * (ut + 1.0f); }
                *(u32x2*)(ACT + (size_t)row * 1024 + oc) = (u32x2){cvt_pk_bf16(a[0], a[1]), cvt_pk_bf16(a[2], a[3])}; }
        EPI_ROWS_END
    }
};

DI void phase_inproj(const Params& p, int layer, LAS unsigned char* lds) {
    SchedDense S; S.T.init(MT / 256, NPROJ / 256, lgdim(), lbid()); S.A = wsp<bf16_t>(p, WS_H); S.lda = 1024; S.Bt = wsp<bf16_t>(p, WS_WIN) + (size_t)layer * NPROJ * 1024; S.K = 1024;
    EpiInproj E{wsp<bf16_t>(p, WS_P), wsp<f32x2>(p, WS_ROPE)};
    pg8::gemm_phase(lds, 1024, S, E);
}
DI void phase_merge(const Params& p, int layer, LAS unsigned char* lds) {
    SchedMerge S; S.T.init(MT / 256, 4, lgdim(), lbid()); S.A = wsp<bf16_t>(p, WS_ABC); S.Bt = wsp<bf16_t>(p, WS_WBR) + (size_t)layer * 3 * 1024 * 512;
    EpiMerge E{wsp<bf16_t>(p, WS_MRG), wsp<bf16_t>(p, WS_P)};
    pg8::gemm_phase(lds, 512, S, E);
}
DI void phase_outproj(const Params& p, int layer, LAS unsigned char* lds) {
    SchedDense S; S.T.init(MT / 256, 4, lgdim(), lbid()); S.A = wsp<bf16_t>(p, WS_MRG); S.lda = 1024; S.Bt = wsp<bf16_t>(p, WS_WOUT) + (size_t)layer * 1024 * 1024; S.K = 1024;
    EpiStore E{wsp<bf16_t>(p, WS_Y), 1024, nullptr, 0};
    pg8::gemm_phase(lds, 1024, S, E);
}
DI void phase_moe_gu(const Params& p, int layer, LAS unsigned char* lds) {
    SchedMoe<8> S; S.init(wsp<int>(p, WS_BLKE), lgdim(), lbid()); S.A = wsp<bf16_t>(p, WS_XG); S.Bt = wsp<bf16_t>(p, WS_WGU) + (size_t)layer * 32 * 2048 * 1024; S.bstride = (size_t)2048 * 1024;
    EpiGu E{wsp<bf16_t>(p, WS_ACT), SMP(SM_BGU) + (size_t)layer * 32 * 2048};
    pg8::gemm_phase(lds, 1024, S, E);
}
DI void phase_moe_dn(const Params& p, int layer, LAS unsigned char* lds) {
    SchedMoe<4> S; S.init(wsp<int>(p, WS_BLKE), lgdim(), lbid()); S.A = wsp<bf16_t>(p, WS_ACT); S.Bt = wsp<bf16_t>(p, WS_WDN) + (size_t)layer * 32 * 1024 * 1024; S.bstride = (size_t)1024 * 1024;
    EpiStore E{wsp<bf16_t>(p, WS_YS), 1024, SMP(SM_BDN) + (size_t)layer * 32 * 1024, 1024};
    pg8::gemm_phase(lds, 1024, S, E);
}
DI int chain_tok(int dir, int b, int j, int tau) {
    if (dir == 0) return j < 4 ? ML + b * 256 + j * 64 + tau : b * 4096 + (j - 4) * 64 + tau;
    return j < 4 ? ML + b * 256 + (3 - j) * 64 + (63 - tau) : b * 4096 + (67 - j) * 64 + (63 - tau);
}
DI void phase_gates(const Params& p, int layer) {
    const int lane = ltid() & 63, gw = lbid() * 8 + (ltid() >> 6), nw = lgdim() * 8;
    const float* gb = SMP(SM_GBIAS) + layer * 16;
    for (int u = gw; u < NCHAIN * NSLOT; u += nw) {
        const int ch = u / NSLOT, j = u % NSLOT, dir = ch >> 5, b = (ch >> 2) & 7, h = ch & 3;
        const int tok = chain_tok(dir, b, j, lane);
        const float* g = wsp<float>(p, WS_GPRE) + (size_t)tok * 16;
        const float li = g[(dir * 2) * 4 + h] + gb[(dir * 2) * 4 + h];
        const float lf = log_sigmoid(g[(dir * 2 + 1) * 4 + h] + gb[(dir * 2 + 1) * 4 + h]);
        float bc = lf;
#pragma unroll
        for (int o = 1; o < 64; o <<= 1) { const float t = __shfl_up(bc, o); if (lane >= o) bc += t; }
        const float a = li - bc; float cm = a;
#pragma unroll
        for (int o = 1; o < 64; o <<= 1) { const float t = __shfl_up(cm, o); if (lane >= o) cm = fmaxf(cm, t); }
        const size_t o = (size_t)u * 64 + lane;
        wsp<float>(p, WS_GA)[o] = a; wsp<float>(p, WS_GCM)[o] = cm; wsp<float>(p, WS_GB)[o] = bc;
    }
}
DI float chain_m(const Params& p, int ch, int j) {
    const float* gcm = wsp<float>(p, WS_GCM) + (size_t)ch * NSLOT * 64 + 63; const float* gbb = wsp<float>(p, WS_GB) + (size_t)ch * NSLOT * 64 + 63;
    float m = 0.f; for (int i = 0; i < j; ++i) m = gbb[i * 64] + fmaxf(m, gcm[i * 64]); return m;
}
DI void mlstm_u_unit(const Params& p, int u, LAS unsigned char* lds) {
    const int tid = ltid(), ch = u / (NSLOT - 1), j = u % (NSLOT - 1), dir = ch >> 5, b = (ch >> 2) & 7, h = ch & 3;
    LAS float* Vs = (LAS float*)lds; LAS float* Ks = Vs + 64 * 128;
    const float mj = chain_m(p, ch, j);
    const float Mend = fmaxf(mj, wsp<float>(p, WS_GCM)[((size_t)ch * NSLOT + j) * 64 + 63]);
    const bf16_t* P = wsp<bf16_t>(p, WS_P);
    for (int i = tid; i < 64 * 128; i += 512) { const int tau = i >> 7, d = i & 127; const int tok = chain_tok(dir, b, j, tau);
        const float w = __expf(wsp<float>(p, WS_GA)[((size_t)ch * NSLOT + j) * 64 + tau] - Mend);
        Vs[i] = bf2f(P[(size_t)tok * NPROJ + PV + h * 128 + d]); Ks[i] = w * bf2f(P[(size_t)tok * NPROJ + PK + h * 128 + d]); }
    __syncthreads();
    { const int v = tid >> 2, d0 = (tid & 3) * 32; float acc[32];
#pragma unroll
      for (int i = 0; i < 32; ++i) acc[i] = 0.f;
      for (int tau = 0; tau < 64; ++tau) { const float vv = Vs[tau * 128 + v];
#pragma unroll
          for (int i = 0; i < 32; ++i) acc[i] += vv * Ks[tau * 128 + d0 + i]; }
      bf16_t* dst = wsp<bf16_t>(p, WS_UC) + (((size_t)ch * NSLOT + j) * 128 + v) * 128 + d0;
#pragma unroll
      for (int i = 0; i < 32; i += 2) *(unsigned*)(dst + i) = pk2(acc[i], acc[i + 1]); }
    if (tid < 128) { float s = 0.f; for (int tau = 0; tau < 64; ++tau) s += Ks[tau * 128 + tid]; wsp<float>(p, WS_UN)[((size_t)ch * NSLOT + j) * 128 + tid] = s; }
    __syncthreads();
}
DI void phase_scan(const Params& p) {
    const int gt = lbid() * 512 + ltid(), nthr = lgdim() * 512;
    for (int w = gt; w < NCHAIN * 2048; w += nthr) {
        const int ch = w >> 11, e8 = w & 2047;
        const float* gcm = wsp<float>(p, WS_GCM) + (size_t)ch * NSLOT * 64 + 63; const float* gbb = wsp<float>(p, WS_GB) + (size_t)ch * NSLOT * 64 + 63;
        u32x4* base = (u32x4*)(wsp<bf16_t>(p, WS_UC) + (size_t)ch * NSLOT * 16384) + e8;
        float* nb = wsp<float>(p, WS_UN) + (size_t)ch * NSLOT * 128 + e8;
        float c[8], nn = 0.f, m = 0.f;
#pragma unroll
        for (int i = 0; i < 8; ++i) c[i] = 0.f;
        for (int j = 0; j < NSLOT; ++j) {
            u32x4 uu = (u32x4){0u, 0u, 0u, 0u}; float un = 0.f;
            if (j < NSLOT - 1) { uu = base[(size_t)j * 2048]; if (e8 < 128) un = nb[j * 128]; }
            base[(size_t)j * 2048] = (u32x4){pk2(c[0], c[1]), pk2(c[2], c[3]), pk2(c[4], c[5]), pk2(c[6], c[7])};
            if (e8 < 128) nb[j * 128] = nn;
            const float cme = gcm[j * 64], be = gbb[j * 64]; const float Mend = fmaxf(m, cme); const float dec = __expf(m - Mend); m = be + Mend;
            c[0] = dec * c[0] + bflo(uu[0]); c[1] = dec * c[1] + bfhi(uu[0]); c[2] = dec * c[2] + bflo(uu[1]); c[3] = dec * c[3] + bfhi(uu[1]);
            c[4] = dec * c[4] + bflo(uu[2]); c[5] = dec * c[5] + bfhi(uu[2]); c[6] = dec * c[6] + bflo(uu[3]); c[7] = dec * c[7] + bfhi(uu[3]);
            nn = dec * nn + un;
        }
    }
}
DI void mlstm_h_unit(const Params& p, int layer, int u, LAS unsigned char* lds) {
    const int tid = ltid(), b = u / (4 * 68), h = (u / 68) & 3, cc = u % 68;
    const bool isctx = cc < 4; const int ck = isctx ? cc : cc - 4;
    const int tok0 = isctx ? ML + b * 256 + ck * 64 : b * 4096 + ck * 64;
    LAS float* Qs = (LAS float*)lds; LAS float* Ks = Qs + 64 * 129; LAS float* Vs = Ks + 64 * 129;
    LAS float* Ss = Vs + 64 * 129;
    LAS float* aux = Ss + 64 * 65;
    const bf16_t* P = wsp<bf16_t>(p, WS_P);
    for (int i = tid; i < 64 * 128; i += 512) { const int t = i >> 7, d = i & 127; const size_t o = (size_t)(tok0 + t) * NPROJ + h * 128 + d;
        Qs[t * 129 + d] = bf2f(P[o + PQ]); Ks[t * 129 + d] = bf2f(P[o + PK]); Vs[t * 129 + d] = bf2f(P[o + PV]); }
    __syncthreads();
    float hacc[16];
#pragma unroll
    for (int i = 0; i < 16; ++i) hacc[i] = 0.f;
    const int t = tid >> 3, sg = tid & 7, v0 = sg * 16;
    for (int dir = 0; dir < 2; ++dir) {
        const int ch = (dir * 8 + b) * 4 + h; const int j = dir == 0 ? (isctx ? ck : 4 + ck) : (isctx ? 3 - ck : 67 - ck);
        const float mprev = chain_m(p, ch, j);
        const float* ga = wsp<float>(p, WS_GA) + ((size_t)ch * NSLOT + j) * 64; const float* gcm = wsp<float>(p, WS_GCM) + ((size_t)ch * NSLOT + j) * 64; const float* gbv = wsp<float>(p, WS_GB) + ((size_t)ch * NSLOT + j) * 64;
        const bf16_t* C = wsp<bf16_t>(p, WS_UC) + ((size_t)ch * NSLOT + j) * 16384; const float* nvec = wsp<float>(p, WS_UN) + ((size_t)ch * NSLOT + j) * 128;
        { const int taut = dir ? 63 - t : t; const float Mt = fmaxf(mprev, gcm[taut]);
          for (int s = sg; s < 64; s += 8) { const int taus = dir ? 63 - s : s; float v = 0.f;
              if (taus <= taut) { float dsum = 0.f; for (int d = 0; d < 128; ++d) dsum += Qs[t * 129 + d] * Ks[s * 129 + d]; v = dsum * __expf(ga[taus] - Mt); }
              Ss[t * 65 + s] = v; }
          if (sg == 0) { float dn = 0.f; for (int d = 0; d < 128; ++d) dn += Qs[t * 129 + d] * nvec[d]; aux[t] = __expf(mprev - Mt); aux[64 + t] = dn; aux[128 + t] = __expf(-(gbv[taut] + Mt)); } }
        __syncthreads();
        { const float wi = aux[t];
          float den = wi * aux[64 + t]; for (int s = 0; s < 64; ++s) den += Ss[t * 65 + s];
          const float dd = fmaxf(fabsf(den), aux[128 + t]);
#pragma unroll 1
          for (int vv = 0; vv < 16; ++vv) { const int v = v0 + vv; float num = 0.f;
              for (int s = 0; s < 64; ++s) num += Ss[t * 65 + s] * Vs[s * 129 + v];
              float cq = 0.f; const u32x4* cr = (const u32x4*)(C + (size_t)v * 128);
              for (int d8 = 0; d8 < 16; ++d8) { const u32x4 w = cr[d8]; const LAS float* qq = Qs + t * 129 + d8 * 8;
                  cq += bflo(w[0]) * qq[0] + bfhi(w[0]) * qq[1] + bflo(w[1]) * qq[2] + bfhi(w[1]) * qq[3] + bflo(w[2]) * qq[4] + bfhi(w[2]) * qq[5] + bflo(w[3]) * qq[6] + bfhi(w[3]) * qq[7]; }
              const float val = (num + wi * cq) / dd;
#pragma unroll
              for (int k = 0; k < 16; ++k) if (k == vv) hacc[k] += val; } }
        __syncthreads();
    }
    { float s = 0.f;
#pragma unroll
      for (int i = 0; i < 16; ++i) s += hacc[i];
      s += __shfl_xor(s, 1); s += __shfl_xor(s, 2); s += __shfl_xor(s, 4);
      const float mean = s * (1.0f / 128.0f); float q = 0.f;
#pragma unroll
      for (int i = 0; i < 16; ++i) { const float d = hacc[i] - mean; q += d * d; }
      q += __shfl_xor(q, 1); q += __shfl_xor(q, 2); q += __shfl_xor(q, 4);
      const float rstd = 1.0f / sqrtf(q * (1.0f / 128.0f) + LN_EPS);
      const size_t tok = (size_t)(tok0 + t); const float* ng = SMP(SM_NORMG) + (size_t)layer * 512 + h * 128 + v0;
      const u32x4* op = (const u32x4*)(P + tok * NPROJ + PO + h * 128 + v0); const u32x4 o0 = op[0], o1 = op[1];
      const float og[16] = {bflo(o0[0]), bfhi(o0[0]), bflo(o0[1]), bfhi(o0[1]), bflo(o0[2]), bfhi(o0[2]), bflo(o0[3]), bfhi(o0[3]), bflo(o1[0]), bfhi(o1[0]), bflo(o1[1]), bfhi(o1[1]), bflo(o1[2]), bfhi(o1[2]), bflo(o1[3]), bfhi(o1[3])};
      float r[16];
#pragma unroll
      for (int i = 0; i < 16; ++i) r[i] = (hacc[i] - mean) * rstd * ng[i] * og[i];
      u32x4* dst = (u32x4*)(wsp<bf16_t>(p, WS_ABC) + tok * 1536 + h * 128 + v0);
      dst[0] = (u32x4){pk2(r[0], r[1]), pk2(r[2], r[3]), pk2(r[4], r[5]), pk2(r[6], r[7])}; dst[1] = (u32x4){pk2(r[8], r[9]), pk2(r[10], r[11]), pk2(r[12], r[13]), pk2(r[14], r[15])}; }
    __syncthreads();
}

DI void na_task(const Params& p, int layer, int task, LAS float* ws  ) {
    const int lane = ltid() & 63; const int row = task >> 3, hd = task & 7;
    const bf16_t* P = wsp<bf16_t>(p, WS_P);
    const bool latent = row < ML; const int b = latent ? row >> 12 : (row - ML) >> 8;
    ws[lane] = bf2f(P[(size_t)row * NPROJ + PNQ + hd * 64 + lane]);
    asm volatile("s_waitcnt lgkmcnt(0)" ::: "memory");
    int r = 0, qc = 0, rs = 0, cs = 0;
    if (latent) { const int t = row & 4095; r = t >> 6; qc = t & 63; rs = min(max(r - 4, 0), 56); cs = min(max(qc - 8, 0), 48); }
    const int nkeys = latent ? 384 : 256;
    float sc[6]; float mx = -3.0e38f;
#pragma unroll
    for (int i = 0; i < 6; ++i) { const int kk = lane + 64 * i; sc[i] = -3.0e38f;
        if (kk < nkeys) { int krow; float bias = 0.f;
            if (latent && kk < 128) { const int kr = rs + (kk >> 4), kc = cs + (kk & 15); krow = b * 4096 + kr * 64 + kc; bias = SMP(SM_RPB)[(((size_t)layer * 8 + hd) * 15 + (kr - r + 7)) * 31 + (kc - qc + 15)]; }
            else krow = ML + b * 256 + (latent ? kk - 128 : kk);
            const u32x4* kp = (const u32x4*)(P + (size_t)krow * NPROJ + PNK + hd * 64); float s = 0.f;
#pragma unroll
            for (int c8 = 0; c8 < 8; ++c8) { const u32x4 w = kp[c8];
#pragma unroll
                for (int e = 0; e < 4; ++e) s += bflo(w[e]) * ws[c8 * 8 + 2 * e] + bfhi(w[e]) * ws[c8 * 8 + 2 * e + 1]; }
            sc[i] = s + bias; mx = fmaxf(mx, sc[i]); } }
    mx = wave_max(mx); float sum = 0.f;
#pragma unroll
    for (int i = 0; i < 6; ++i) { const int kk = lane + 64 * i; if (kk < nkeys) { const float e = __expf(sc[i] - mx); sum += e; ws[64 + kk] = e; } }
    sum = wave_sum(sum);
    asm volatile("s_waitcnt lgkmcnt(0)" ::: "memory");
    float o = 0.f;
    for (int kk = 0; kk < nkeys; ++kk) { int krow;
        if (latent && kk < 128) krow = b * 4096 + (rs + (kk >> 4)) * 64 + cs + (kk & 15); else krow = ML + b * 256 + (latent ? kk - 128 : kk);
        o += ws[64 + kk] * bf2f(P[(size_t)krow * NPROJ + PNV + hd * 64 + lane]); }
    wsp<bf16_t>(p, WS_ABC)[(size_t)row * 1536 + 512 + hd * 64 + lane] = (bf16_t)f2bf(o / sum);
}

DI void sgu_unit(const Params& p, int layer, int u, LAS unsigned char* lds) {
    const int tid = ltid(), lane = tid & 63, wave = tid >> 6;
    const int g = u & 3, n = (u >> 2) % 34, b = (u >> 2) / 34;
    const int tok0 = n < 32 ? b * 4096 + n * 128 : ML + b * 256 + (n - 32) * 128;
    LAS float* vn = (LAS float*)lds;
    LAS float* wsm = vn + 128 * 128;
    LAS float* st = wsm + 128 * 129;
    const bf16_t* P = wsp<bf16_t>(p, WS_P);
    for (int i = 0; i < 16; ++i) { const int pp = wave * 16 + i; const u32x4 w = *(const u32x4*)(P + (size_t)(tok0 + pp) * NPROJ + PSV + lane * 8);
        const float x[8] = {bflo(w[0]), bfhi(w[0]), bflo(w[1]), bfhi(w[1]), bflo(w[2]), bfhi(w[2]), bflo(w[3]), bfhi(w[3])}; float s = 0.f;
#pragma unroll
        for (int e = 0; e < 8; ++e) s += x[e];
        const float mean = wave_sum(s) * (1.0f / 512.0f); float q = 0.f;
#pragma unroll
        for (int e = 0; e < 8; ++e) q += (x[e] - mean) * (x[e] - mean);
        const float rstd = 1.0f / sqrtf(wave_sum(q) * (1.0f / 512.0f) + LN_EPS);
        if (lane == 0) { st[pp * 2] = mean; st[pp * 2 + 1] = rstd; } }
    __syncthreads();
    const float* lg = SMP(SM_SGLNG) + (size_t)layer * 512 + g * 128; const float* lb = SMP(SM_SGLNB) + (size_t)layer * 512 + g * 128;
    for (int i = tid; i < 128 * 128; i += 512) { const int pp = i >> 7, c = i & 127;
        vn[i] = (bf2f(P[(size_t)(tok0 + pp) * NPROJ + PSV + g * 128 + c]) - st[pp * 2]) * st[pp * 2 + 1] * lg[c] + lb[c];
        wsm[pp * 129 + c] = SMP(SM_SGW)[(((size_t)layer * 4 + g) * 128 + pp) * 128 + c]; }
    __syncthreads();
    { const int q = tid >> 2, c0 = (tid & 3) * 32; float acc[32];
#pragma unroll
      for (int i = 0; i < 32; ++i) acc[i] = 0.f;
      for (int pp = 0; pp < 128; ++pp) { const float w = wsm[q * 129 + pp];
#pragma unroll
          for (int i = 0; i < 32; ++i) acc[i] += w * vn[pp * 128 + c0 + i]; }
      const float bs = SMP(SM_SGB)[((size_t)layer * 4 + g) * 128 + q];
      const size_t tok = (size_t)(tok0 + q);
#pragma unroll
      for (int i = 0; i < 32; i += 2) { const unsigned uu = *(const unsigned*)(P + tok * NPROJ + PSU + g * 128 + c0 + i);
          *(unsigned*)(wsp<bf16_t>(p, WS_ABC) + tok * 1536 + 1024 + g * 128 + c0 + i) = pk2(bflo(uu) * (acc[i] + bs), bfhi(uu) * (acc[i + 1] + bs)); } }
    __syncthreads();
}

DI void phase_mix1(const Params& p, int layer, LAS unsigned char* lds) {
    const int G = lgdim(), blk = lbid();
    for (int u = blk; u < NCHAIN * (NSLOT - 1); u += G) mlstm_u_unit(p, u, lds);
    for (int u = blk; u < NB * 34 * 4; u += G) sgu_unit(p, layer, u, lds);
    { const int wave = ltid() >> 6; LAS float* ws = (LAS float*)lds + wave * 512;
      for (int t = blk * 8 + wave; t < MT * 8; t += G * 8) na_task(p, layer, t, ws); }
}
DI void phase_mix3(const Params& p, int layer, LAS unsigned char* lds) {
    for (int u = lbid(); u < NB * 4 * 68; u += lgdim()) mlstm_h_unit(p, layer, u, lds);
}
constexpr int NPH = 2 + 11 * DEPTH;
__global__ void __launch_bounds__(512, 2) fwd(Params p) {
    extern __shared__ __attribute__((aligned(16))) unsigned char lds_raw[];
    LAS unsigned char* lds = (LAS unsigned char*)lds_raw;
    volatile LAS unsigned* misc = (volatile LAS unsigned*)(lds + LDS_MISC);
    if (threadIdx.x < 64) misc[threadIdx.x] = 0u;
    __syncthreads();
    XcdBarrier bar = xcd_barrier_post(wsp<unsigned>(p, WS_CTL) + CW_BAR + p.li * XCD_BAR_WORDS, misc);
    const int lo = p.ph_lo, hi = p.ph_hi;
#define IN(k) (lo <= (k) && (k) < hi)
#define LP ({ Params q_ = p; asm volatile("" : "+s"(q_.ws), "+s"(q_.out)); q_; })
#define SEAM(k) do { if (IN(k) && IN((k) + 1)) { XcdBarrier b2_ = bar; asm volatile("" : "+s"(b2_.bar), "+s"(b2_.x)); xcd_barrier(b2_); } } while (0)
    if (IN(0)) phase_prologue_a(LP, lds);
    SEAM(0);
    if (IN(1)) phase_init(LP, lds);
    SEAM(1);
    for (int L = 0; L < DEPTH; ++L) {
        const int b = 2 + 11 * L;
        if (IN(b + 0)) { phase_gates(LP, L); phase_inproj(LP, L, lds); }
        SEAM(b + 0);
        if (IN(b + 1)) phase_mix1(LP, L, lds);
        SEAM(b + 1);
        if (IN(b + 2)) phase_scan(LP);
        SEAM(b + 2);
        if (IN(b + 3)) phase_mix3(LP, L, lds);
        SEAM(b + 3);
        if (IN(b + 4)) phase_merge(LP, L, lds);
        SEAM(b + 4);
        if (IN(b + 5)) phase_outproj(LP, L, lds);
        SEAM(b + 5);
        if (IN(b + 6)) phase_ln1_router(LP, L, lds);
        SEAM(b + 6);
        if (IN(b + 7)) phase_scatter(LP, L, lds);
        SEAM(b + 7);
        if (IN(b + 8)) phase_moe_gu(LP, L, lds);
        SEAM(b + 8);
        if (IN(b + 9)) phase_moe_dn(LP, L, lds);
        SEAM(b + 9);
        if (IN(b + 10)) phase_ln2(LP, L, lds);
        SEAM(b + 10);
    }
#undef IN
#undef SEAM
}

#ifndef N_LAUNCH_MODE
#define N_LAUNCH_MODE 1
#endif
extern "C" void kernel_launch(void* const* d_in, const int* in_sizes, int n_in, void* d_out, int out_size, void* d_ws, size_t ws_size, hipStream_t stream) {
    static int grid = 0;
    if (grid == 0) {
        if (n_in != 26 || ws_size < WS_END) { fprintf(stderr, "kernel_launch: expected 26 inputs and >= %zu bytes of workspace (got %d, %zu)\n", (size_t)WS_END, n_in, ws_size); grid = -1; return; }
        int dev = 0, cus = 0, per_cu = 0;
        if (hipGetDevice(&dev) != hipSuccess || hipDeviceGetAttribute(&cus, hipDeviceAttributeMultiprocessorCount, dev) != hipSuccess) { grid = -1; return; }
        if (hipFuncSetAttribute((const void*)fwd, hipFuncAttributeMaxDynamicSharedMemorySize, LDS_BYTES) != hipSuccess) { fprintf(stderr, "kernel_launch: hipFuncSetAttribute failed\n"); grid = -1; return; }
        if (hipOccupancyMaxActiveBlocksPerMultiprocessor(&per_cu, (const void*)fwd, 512, LDS_BYTES) != hipSuccess || per_cu < 1) fprintf(stderr, "kernel_launch: occupancy query reports %d\n", per_cu);
        (void)hipGetLastError();
        grid = cus;
        if (grid != 256) fprintf(stderr, "kernel_launch: %d CUs; the row phases assume 256 workgroups\n", grid);
        grid = 256;
    }
    if (grid < 0) return;
    (void)hipMemsetAsync((char*)d_ws + WS_CTL, 0, CTL_BYTES, stream);
    Params p{};
    const float** pf = (const float**)&p;
    for (int i = 0; i < 26; ++i) pf[i] = (const float*)d_in[i];
    p.out = (float*)d_out; p.ws = (unsigned char*)d_ws;
#if N_LAUNCH_MODE == 1
    p.ph_lo = 0; p.ph_hi = NPH; p.li = 0; p.pad = 0;
    hipLaunchKernelGGL(fwd, dim3(grid), dim3(512), LDS_BYTES, stream, p);
#else
    for (int ph = 0; ph < NPH; ++ph) { p.ph_lo = ph; p.ph_hi = ph + 1; p.li = 0; p.pad = 0; hipLaunchKernelGGL(fwd, dim3(grid), dim3(512), LDS_BYTES, stream, p); }
#endif
    const hipError_t le = hipPeekAtLastError();
    if (le != hipSuccess) fprintf(stderr, "kernel_launch: launch failed: %s\n", hipGetErrorName(le));
}
```

```cpp
#include <hip/hip_runtime.h>
#include <cstdio>
#include <cstdint>

#define LAS __attribute__((address_space(3)))
typedef unsigned short bf16_t;
typedef short bf16x8 __attribute__((ext_vector_type(8)));
typedef short s16x4 __attribute__((ext_vector_type(4)));
typedef float f32x4 __attribute__((ext_vector_type(4)));
typedef float f32x2 __attribute__((ext_vector_type(2)));
typedef unsigned u32x4 __attribute__((ext_vector_type(4)));
typedef unsigned u32x2 __attribute__((ext_vector_type(2)));
#define DI __device__ __forceinline__

constexpr int D = 1024, NB = 8, SEQ = 4096, NCTX = 256, ML = NB * SEQ, MC = NB * NCTX, MT = ML + MC, DEPTH = 4;
constexpr int NPROJ = 7680, DIN = 7696, NEXP = 32, TOPK = 4;
constexpr int NROWS_MAX = (MT * TOPK / 256 + NEXP) * 256;
constexpr int NCHAIN = 2 * NB * 4, NSLOT = 68;
constexpr float LN_EPS = 1e-5f;
constexpr float DN_ALPHA = 1.6817928305074290f;
constexpr int PQ = 0, PK = 512, PV = 1024, PO = 1536, PNQ = 2048, PNK = 2560, PNV = 3072, PSU = 3584, PSV = 4096, PBG = 4608;

constexpr size_t al256(size_t x) { return (x + 255) & ~(size_t)255; }
constexpr size_t WS_CTL = 0, CTL_BYTES = 65536;
constexpr size_t WS_MOD = WS_CTL + CTL_BYTES;
constexpr size_t WS_ROPE = al256(WS_MOD + (size_t)4 * 9 * 6144 * 4);
constexpr size_t WS_WGATE = al256(WS_ROPE + 64 * 32 * 8);
constexpr size_t WS_WIN = al256(WS_WGATE + (size_t)4 * 16 * 1024 * 4);
constexpr size_t WS_WBR = al256(WS_WIN + (size_t)4 * NPROJ * 1024 * 2);
constexpr size_t WS_WOUT = al256(WS_WBR + (size_t)4 * 3 * 1024 * 512 * 2);
constexpr size_t WS_WGU = al256(WS_WOUT + (size_t)4 * 1024 * 1024 * 2);
constexpr size_t WS_WDN = al256(WS_WGU + (size_t)4 * 32 * 2048 * 1024 * 2);
constexpr size_t WS_X = al256(WS_WDN + (size_t)4 * 32 * 1024 * 1024 * 2);
constexpr size_t WS_H = al256(WS_X + (size_t)MT * D * 4);
constexpr size_t WS_H2 = al256(WS_H + (size_t)MT * D * 2);
constexpr size_t WS_P = al256(WS_H2 + (size_t)MT * D * 2);
constexpr size_t WS_GPRE = al256(WS_P + (size_t)MT * NPROJ * 2);
constexpr size_t WS_GA = al256(WS_GPRE + (size_t)MT * 16 * 4);
constexpr size_t WS_GCM = al256(WS_GA + (size_t)NCHAIN * NSLOT * 64 * 4);
constexpr size_t WS_GB = al256(WS_GCM + (size_t)NCHAIN * NSLOT * 64 * 4);
constexpr size_t WS_UC = al256(WS_GB + (size_t)NCHAIN * NSLOT * 64 * 4);
constexpr size_t WS_UN = al256(WS_UC + (size_t)NCHAIN * NSLOT * 128 * 128 * 2);
constexpr size_t WS_ABC = al256(WS_UN + (size_t)NCHAIN * NSLOT * 128 * 4);
constexpr size_t WS_MRG = al256(WS_ABC + (size_t)MT * 1536 * 2);
constexpr size_t WS_Y = al256(WS_MRG + (size_t)MT * D * 2);
constexpr size_t WS_TOPE = al256(WS_Y + (size_t)MT * D * 2);
constexpr size_t WS_TOPG = al256(WS_TOPE + (size_t)MT * 16);
constexpr size_t WS_TOPR = al256(WS_TOPG + (size_t)MT * 16);
constexpr size_t WS_DEST = al256(WS_TOPR + (size_t)MT * 16);
constexpr size_t WS_BASE = al256(WS_DEST + (size_t)MT * 16);
constexpr size_t WS_BLKE = al256(WS_BASE + 256 * 32 * 4);
constexpr size_t WS_XG = al256(WS_BLKE + 4096);
constexpr size_t WS_ACT = al256(WS_XG + (size_t)NROWS_MAX * D * 2);
constexpr size_t WS_YS = al256(WS_ACT + (size_t)NROWS_MAX * D * 2);
constexpr size_t SM_GBIAS = 0, SM_NORMG = SM_GBIAS + 64, SM_RPB = SM_NORMG + 2048, SM_SGLNG = SM_RPB + 14880, SM_SGLNB = SM_SGLNG + 2048, SM_SGW = SM_SGLNB + 2048, SM_SGB = SM_SGW + 262144,
                 SM_LN1G = SM_SGB + 2048, SM_LN1B = SM_LN1G + 4096, SM_RW = SM_LN1B + 4096, SM_RB = SM_RW + 131072, SM_BGU = SM_RB + 128, SM_BDN = SM_BGU + 262144, SM_LN2G = SM_BDN + 131072,
                 SM_LN2B = SM_LN2G + 4096, SM_END = SM_LN2B + 4096;
constexpr size_t WS_SM = al256(WS_YS + (size_t)NROWS_MAX * D * 2);
constexpr size_t WS_END = al256(WS_SM + SM_END * 4);
constexpr int CW_BAR = 0;
constexpr int CW_CNT = 16000;
static_assert((CW_CNT + 4 * 32) * 4 <= (int)CTL_BYTES, "ctl");

constexpr int LDS_BYTES = 147456;
constexpr int LDS_MISC = 147456 - 256;

DI unsigned f2bf(float f) { unsigned u = __builtin_bit_cast(unsigned, f); return (u + 0x7fffu + ((u >> 16) & 1u)) >> 16; }
DI float bf2f(unsigned b) { return __builtin_bit_cast(float, (b & 0xffffu) << 16); }
DI float bflo(unsigned w) { return __builtin_bit_cast(float, w << 16); }
DI float bfhi(unsigned w) { return __builtin_bit_cast(float, w & 0xffff0000u); }
typedef __bf16 bf16x2_t __attribute__((ext_vector_type(2)));
DI unsigned cvt_pk_bf16(float lo, float hi) { const f32x2 v = (f32x2){lo, hi}; return __builtin_bit_cast(unsigned, __builtin_convertvector(v, bf16x2_t)); }
DI unsigned pk2(float lo, float hi) { return cvt_pk_bf16(lo, hi); }
DI float wave_sum(float v) { for (int o = 32; o >= 1; o >>= 1) v += __shfl_xor(v, o); return v; }
DI float wave_max(float v) { for (int o = 32; o >= 1; o >>= 1) v = fmaxf(v, __shfl_xor(v, o)); return v; }
DI float sigmoidf_(float x) { return 1.0f / (1.0f + __expf(-x)); }
DI float gelu_tanh(float x) { const float u = 0.7978845608028654f * (x + 0.044715f * x * x * x); const float e = __expf(2.0f * u); const float t = 1.0f - 2.0f / (e + 1.0f); return 0.5f * x * (1.0f + t); }
DI float log_sigmoid(float x) { return -(fmaxf(-x, 0.0f) + log1pf(expf(-fabsf(x)))); }
__host__ __device__ inline int rope_d(int p) { const int u = p >> 3, e = p & 7; return (u >> 3) * 64 + (e >> 2) * 32 + (u & 7) * 4 + (e & 3); }

DI int ltid() { int t = threadIdx.x; asm volatile("" : "+v"(t)); return t; }
DI int lbid() { int b = blockIdx.x; asm volatile("" : "+s"(b)); return b; }
DI int lgdim() { int g = gridDim.x; asm volatile("" : "+s"(g)); return g; }
template <int N> DI float bfly(float (&v)[N], int lane) {
    int off = 32;
#pragma unroll
    for (int n = N; n > 1; n >>= 1) {
        const unsigned mk = (lane & off) ? 0xffffffffu : 0u;
#pragma unroll
        for (int i = 0; i < n / 2; ++i) { const unsigned a = __builtin_bit_cast(unsigned, v[i]), b = __builtin_bit_cast(unsigned, v[i + n / 2]);
            const float keep = __builtin_bit_cast(float, (a & ~mk) | (b & mk)); const float send = __builtin_bit_cast(float, (b & ~mk) | (a & mk)); v[i] = keep + __shfl_xor(send, off); }
        off >>= 1;
    }
    for (; off >= 1; off >>= 1) v[0] += __shfl_xor(v[0], off);
    return v[0];
}

#define XB_TMO      128
#define XB_XCNT(j)  (256  + 64 * (j))
#define XB_XSUB(j)  (1280 + 64 * (j))
#define XB_XGEN(j)  (2304 + 64 * (j))
#define XB_TOP      3328
#define XB_TOPGEN   3392
#define XCD_BAR_WORDS 3456
#define XB_SPIN_CAP (1u << 22)
DI unsigned xb_ld(unsigned* p)              { return __hip_atomic_load(p, __ATOMIC_RELAXED, __HIP_MEMORY_SCOPE_AGENT); }
DI unsigned xb_add(unsigned* p, unsigned v) { return __hip_atomic_fetch_add(p, v, __ATOMIC_RELAXED, __HIP_MEMORY_SCOPE_AGENT); }
DI unsigned xb_xcc_id() { return (unsigned)__builtin_amdgcn_s_getreg((3 << 11) | 20) & 0xFu; }
#define XB_SPIN(cond, bar) do { unsigned _sp = 0; while (cond) { __builtin_amdgcn_s_sleep(1); \
    if ((++_sp & 255u) == 0u) { if (xb_ld(&(bar)[XB_TMO])) break; if (_sp > XB_SPIN_CAP) { atomicAdd(&(bar)[XB_TMO], 1u); break; } } } } while (0)
struct XcdBarrier { unsigned* bar; unsigned x; volatile LAS unsigned* st; };
DI XcdBarrier xcd_barrier_post(unsigned* bar, volatile LAS unsigned* st) {
    XcdBarrier b; b.bar = bar; b.x = xb_xcc_id(); b.st = st;
    if (threadIdx.x == 0) (void)xb_add(&bar[XB_XCNT(b.x)], 1u);
    return b;
}
DI void xcd_barrier_complete(unsigned* bar, unsigned x, unsigned& nloc, unsigned& nx) {
    const unsigned G = gridDim.x * gridDim.y * gridDim.z;
    unsigned sum, cnt, mine, sp = 0u;
    for (;;) {
        sum = 0u; cnt = 0u; mine = 0u;
#pragma unroll
        for (unsigned j = 0; j < 16; ++j) { const unsigned c = xb_ld(&bar[XB_XCNT(j)]); sum += c; cnt += (c > 0u) ? 1u : 0u; mine = (j == x) ? c : mine; }
        if (sum == G) break;
        __builtin_amdgcn_s_sleep(1);
        if ((++sp & 255u) == 0u) { if (xb_ld(&bar[XB_TMO])) break; if (sp > XB_SPIN_CAP) { atomicAdd(&bar[XB_TMO], 1u); break; } }
    }
    nloc = mine > 0u ? mine : 1u; nx = cnt > 0u ? cnt : 1u;
}
DI void xcd_barrier(const XcdBarrier& b) {
    asm volatile("s_waitcnt vmcnt(0)" ::: "memory");
    __syncthreads();
    if (threadIdx.x == 0) {
        unsigned* bar = b.bar;
        __builtin_amdgcn_s_waitcnt(0);
        unsigned nloc = b.st[0], nx = b.st[1];
        if (nloc == 0u) { xcd_barrier_complete(bar, b.x, nloc, nx); b.st[0] = nloc; b.st[1] = nx; }
        const unsigned old = xb_add(&bar[XB_XSUB(b.x)], 1u);
        const unsigned gen = old / nloc;
        if (old + 1u == (gen + 1u) * nloc) {
            __builtin_amdgcn_fence(__ATOMIC_RELEASE, "agent");
            asm volatile("s_waitcnt vmcnt(0)" ::: "memory");
            const unsigned og = xb_add(&bar[XB_TOP], 1u);
            const unsigned tg = og / nx;
            if (og + 1u == (tg + 1u) * nx) xb_add(&bar[XB_TOPGEN], 1u);
            else XB_SPIN(xb_ld(&bar[XB_TOPGEN]) == tg, bar);
            __builtin_amdgcn_fence(__ATOMIC_ACQUIRE, "agent");
            xb_add(&bar[XB_XGEN(b.x)], 1u);
            asm volatile("s_waitcnt vmcnt(0)" ::: "memory");
        } else {
            XB_SPIN(xb_ld(&bar[XB_XGEN(b.x)]) == gen, bar);
            __builtin_amdgcn_fence(__ATOMIC_ACQUIRE, "agent");
            asm volatile("s_waitcnt vmcnt(0)" ::: "memory");
        }
    }
    __syncthreads();
}
namespace pg8 {
constexpr int BM = 256, BK = 64, HALF = 128, HTB = HALF * BK * 2, STAGE_BYTES = 8 * HTB, NXCD = 8, WGM = 8;
__host__ __device__ __forceinline__ int lds_byte(int r, int c) { const int st = (r >> 4) * 2 + (c >> 5), rr = r & 15, cc = c & 31, ob = rr * 64 + cc * 2; return st * 1024 + (ob ^ (((ob >> 9) & 1) << 5)); }
__host__ __device__ __forceinline__ void stage_rc(int b, int& R, int& C) { const int st = b / 1024, sb = b % 1024, swz = sb ^ (((sb >> 9) & 1) << 5); R = (st >> 1) * 16 + swz / 64; C = (st & 1) * 32 + (swz % 64) / 2; }
__host__ __device__ __forceinline__ int perm32(int rho) { const int n = rho >> 4, i = rho & 15; return 8 * (i >> 2) + 4 * n + (i & 3); }

struct Unit { int pm, pn, aux; };

struct TileOrder {
    int nM, nN, nwg, G, c;
    __device__ void init(int nM_, int nN_, int G_, int c_) { nM = nM_; nN = nN_; nwg = nM * nN; G = G_; c = c_; }
    __device__ bool tile(int i, int& pm, int& pn) const {
        const long L = (long)i * G + c; if (L >= nwg) return false;
        int wgid = (int)L; { const int q = nwg / NXCD, r = nwg % NXCD, xcd = wgid % NXCD, off = wgid / NXCD; wgid = (xcd < r ? xcd * (q + 1) : r * (q + 1) + (xcd - r) * q) + off; }
        const int nig = WGM * nN, gid = wgid / nig, fm = gid * WGM, gsz = (nM - fm) < WGM ? (nM - fm) : WGM;
        pm = fm + ((wgid % nig) % gsz); pn = (wgid % nig) / gsz; return true;
    }
};

template <class Epi, class Sched>
__device__ __forceinline__ void gemm_phase(LAS unsigned char* lds, const int K, const Sched& S, const Epi& E) {
    const int tid = ltid(), wid = __builtin_amdgcn_readfirstlane(tid >> 6), lane = tid & 63, wr = wid >> 2, wc = wid & 3, fr = lane & 15, fq = lane >> 4;
    const int nt = K / BK;
    unsigned voffA[2], voffB[2]; const int lda = S.lda;
#pragma unroll
    for (int i = 0; i < 2; ++i) { int R, C; stage_rc(tid * 16 + i * 8192, R, C); const int Rb = (R & ~31) + perm32(R & 31); voffA[i] = (unsigned)(R * lda + C) * 2u; voffB[i] = (unsigned)(Rb * K + C) * 2u; }
    const size_t kstep = (size_t)(BK * 2);
    const size_t hstep = (size_t)HALF * K * 2;
    const size_t hstepA = (size_t)HALF * lda * 2;
    const unsigned ldsw = (unsigned)wid * 1024u;
    const int aoff = lds_byte(wr * 64 + fr, fq * 8), boff = lds_byte(wc * 32 + fr, fq * 8);
#define PG8_SA(b, h) (((b) * 2 + (h)) * HTB)
#define PG8_SB(b, h) ((4 + (b) * 2 + (h)) * HTB)
#define PG8_STAGE(bufoff, gbase, voff) do { _Pragma("unroll") for (int _i = 0; _i < 2; ++_i) \
        __builtin_amdgcn_global_load_lds((const unsigned*)((const char*)(gbase) + (voff)[_i]), (LAS unsigned*)(lds + (bufoff) + ldsw + _i * 8192), 16, 0, 0); } while (0)
#define PG8_LDA(dst, b, h) do { _Pragma("unroll") for (int m = 0; m < 4; ++m) _Pragma("unroll") for (int k = 0; k < 2; ++k) dst[m][k] = *(const LAS bf16x8*)(lds + PG8_SA(b, h) + aoff + m * 2048 + k * 1024); } while (0)
#define PG8_LDB(dst, b, h) do { _Pragma("unroll") for (int n = 0; n < 2; ++n) _Pragma("unroll") for (int k = 0; k < 2; ++k) dst[n][k] = *(const LAS bf16x8*)(lds + PG8_SB(b, h) + boff + n * 2048 + k * 1024); } while (0)
#define PG8_MMA(ai, bj, At, Bt) do { __builtin_amdgcn_s_setprio(1); _Pragma("unroll") for (int m = 0; m < 4; ++m) _Pragma("unroll") for (int n = 0; n < 2; ++n) _Pragma("unroll") for (int k = 0; k < 2; ++k) \
        acc[ai][bj][m][n] = __builtin_amdgcn_mfma_f32_16x16x32_bf16(Bt[n][k], At[m][k], acc[ai][bj][m][n], 0, 0, 0); __builtin_amdgcn_s_setprio(0); } while (0)
#define PG8_WAIT_V(n) asm volatile("s_waitcnt vmcnt(" #n ")" ::: "memory")
#define PG8_WAIT_L(n) asm volatile("s_waitcnt lgkmcnt(" #n ")" ::: "memory")
#define PG8_BAR __builtin_amdgcn_s_barrier()
#define PG8_SCHED __builtin_amdgcn_sched_barrier(0)
    Unit cur, nxt; int ui = 0;
    if (!S.next(0, cur)) return;
    f32x4 acc[2][2][4][2];
#pragma unroll
    for (int a = 0; a < 2; ++a)
#pragma unroll
        for (int b = 0; b < 2; ++b)
#pragma unroll
            for (int m = 0; m < 4; ++m)
#pragma unroll
                for (int n = 0; n < 2; ++n) acc[a][b][m][n] = (f32x4){0.f, 0.f, 0.f, 0.f};
    bf16x8 At[4][2], B0[2][2], B1[2][2];
    const char* cA = S.a_base(cur); const char* cB = S.b_base(cur);
    PG8_STAGE(PG8_SB(0, 0), cB, voffB); PG8_STAGE(PG8_SB(0, 1), cB + hstep, voffB); PG8_STAGE(PG8_SA(0, 0), cA, voffA); PG8_STAGE(PG8_SA(0, 1), cA + hstepA, voffA);
    if (wr == 1) PG8_BAR;
    PG8_WAIT_V(2); PG8_BAR;
    PG8_STAGE(PG8_SB(1, 0), cB + kstep, voffB); PG8_STAGE(PG8_SA(1, 0), cA + kstep, voffA); PG8_STAGE(PG8_SB(1, 1), cB + hstep + kstep, voffB);
    PG8_WAIT_V(6); PG8_BAR;
    for (;;) {
        const bool has_next = S.next(ui + 1, nxt);
        const char* nA = has_next ? S.a_base(nxt) : cA; const char* nB = has_next ? S.b_base(nxt) : cB;
        for (int t = 0; t < nt; t += 2) {
            const bool last = (t == nt - 2);
            const char* a1 = cA + (size_t)(t + 1) * kstep;
            const char* a2 = last ? nA : cA + (size_t)(t + 2) * kstep; const char* b2 = last ? nB : cB + (size_t)(t + 2) * kstep;
            const char* a3 = a2 + kstep; const char* b3 = b2 + kstep;
            PG8_LDB(B0, 0, 0); PG8_LDB(B1, 0, 1); PG8_SCHED; PG8_LDA(At, 0, 0); PG8_STAGE(PG8_SA(1, 1), a1 + hstepA, voffA);
            PG8_WAIT_V(8); PG8_WAIT_L(0); PG8_BAR; PG8_MMA(0, 0, At, B0); PG8_MMA(0, 1, At, B1); PG8_BAR; PG8_SCHED;
            PG8_LDA(At, 0, 1); PG8_STAGE(PG8_SB(0, 0), b2, voffB); PG8_STAGE(PG8_SB(0, 1), b2 + hstep, voffB); PG8_STAGE(PG8_SA(0, 0), a2, voffA);
            PG8_WAIT_V(8); PG8_WAIT_L(0); PG8_BAR; PG8_MMA(1, 0, At, B0); PG8_MMA(1, 1, At, B1); PG8_BAR; PG8_SCHED;
            PG8_LDB(B0, 1, 0); PG8_LDB(B1, 1, 1); PG8_SCHED; PG8_LDA(At, 1, 0); PG8_STAGE(PG8_SA(0, 1), a2 + hstepA, voffA);
            PG8_WAIT_V(8); PG8_WAIT_L(0); PG8_BAR; PG8_MMA(0, 0, At, B0); PG8_MMA(0, 1, At, B1); PG8_BAR; PG8_SCHED;
            PG8_LDA(At, 1, 1); PG8_STAGE(PG8_SB(1, 0), b3, voffB); PG8_STAGE(PG8_SB(1, 1), b3 + hstep, voffB); PG8_STAGE(PG8_SA(1, 0), a3, voffA);
            PG8_WAIT_V(8); PG8_WAIT_L(0); PG8_BAR; PG8_MMA(1, 0, At, B0); PG8_MMA(1, 1, At, B1); PG8_BAR; PG8_SCHED;
        }
        if (wr == 0) PG8_BAR;
        E(acc, cur, wr, wc, fr, fq);
        if (!has_next) break;
#pragma unroll
        for (int a = 0; a < 2; ++a)
#pragma unroll
            for (int b = 0; b < 2; ++b)
#pragma unroll
                for (int m = 0; m < 4; ++m)
#pragma unroll
                    for (int n = 0; n < 2; ++n) acc[a][b][m][n] = (f32x4){0.f, 0.f, 0.f, 0.f};
        cur = nxt; cA = nA; cB = nB; ++ui;
        if (wr == 1) PG8_BAR;
    }
    PG8_WAIT_V(0);
    PG8_BAR;
#undef PG8_SA
#undef PG8_SB
#undef PG8_STAGE
#undef PG8_LDA
#undef PG8_LDB
#undef PG8_MMA
#undef PG8_WAIT_V
#undef PG8_WAIT_L
#undef PG8_BAR
#undef PG8_SCHED
}
}
struct Params {
    const float *x, *c, *ctx, *c_ctx, *w_mod, *b_mod, *w_in, *gate_bias, *norm_g, *rpb, *sg_ln_g, *sg_ln_b, *sg_w, *sg_b, *w_branch, *w_out,
                *ln1_g, *ln1_b, *router_w, *router_b, *w_gu, *b_gu, *w_dn, *b_dn, *ln2_g, *ln2_b;
    float* out; unsigned char* ws;
    int ph_lo, ph_hi, li, pad;
};
template <class T> DI T* wsp(const Params& p, size_t off) { return (T*)(p.ws + off); }
#define SMP(o) (wsp<float>(p, WS_SM) + (o))

DI int row_of(int blk, int wave, int i) { return i < 16 ? blk * 128 + wave * 16 + i : ML + blk * 8 + wave; }
DI int bsel_of(int row) { return row < ML ? (row >> 12) : 8; }

template <int MAP> DI int cmap(int n) {
    if (MAP == 1) { if (n < 1024) return (n & ~127) + rope_d(n & 127); return n < 2048 ? n : n + 16; }
    if (MAP == 2) { const int u = n >> 3, e = n & 7; return e < 4 ? 4 * u + e : 1024 + 4 * u + (e - 4); }
    return n;
}
template <int MAP> DI void cvt_tile(const float* src, int ld, bf16_t* dst, int K, int k0, int n0, LAS float* tile) {
    const int tid = ltid();
    { const int kk = tid >> 7, n = tid & 127; const int sc = cmap<MAP>(n0 + n);
#pragma unroll 4
      for (int it = 0; it < 16; ++it) { const int k = it * 4 + kk; tile[k * 129 + n] = src[(size_t)(k0 + k) * ld + sc]; } }
    __syncthreads();
    { const int n = tid >> 2, kc = (tid & 3) * 16; unsigned w[8];
#pragma unroll
      for (int j = 0; j < 8; ++j) w[j] = pk2(tile[(kc + 2 * j) * 129 + n], tile[(kc + 2 * j + 1) * 129 + n]);
      bf16_t* d = dst + (size_t)(n0 + n) * K + k0 + kc;
      *(u32x4*)d = (u32x4){w[0], w[1], w[2], w[3]}; *(u32x4*)(d + 8) = (u32x4){w[4], w[5], w[6], w[7]}; }
    __syncthreads();
}
DI void phase_prologue_a(const Params& p, LAS unsigned char* lds) {
    const int tid = ltid(), G = lgdim(), blk = lbid();
    LAS float* tile = (LAS float*)lds;
    constexpr int T_IN = 4 * 16 * 60, T_BR = 12 * 8 * 8, T_OUT = 4 * 16 * 8, T_GU = 128 * 16 * 16, T_DN = 128 * 16 * 8;
    constexpr int T_ALL = T_IN + T_BR + T_OUT + T_GU + T_DN;
    for (int t = blk; t < T_ALL; t += G) {
        int u = t;
        if (u < T_IN) { const int l = u / 960, r = u % 960; cvt_tile<1>(p.w_in + (size_t)l * 1024 * DIN, DIN, wsp<bf16_t>(p, WS_WIN) + (size_t)l * NPROJ * 1024, 1024, (r / 60) * 64, (r % 60) * 128, tile); continue; }
        u -= T_IN;
        if (u < T_BR) { const int m = u / 64, r = u % 64; cvt_tile<0>(p.w_branch + (size_t)m * 512 * 1024, 1024, wsp<bf16_t>(p, WS_WBR) + (size_t)m * 1024 * 512, 512, (r / 8) * 64, (r % 8) * 128, tile); continue; }
        u -= T_BR;
        if (u < T_OUT) { const int l = u / 128, r = u % 128; cvt_tile<0>(p.w_out + (size_t)l * 1024 * 1024, 1024, wsp<bf16_t>(p, WS_WOUT) + (size_t)l * 1024 * 1024, 1024, (r / 8) * 64, (r % 8) * 128, tile); continue; }
        u -= T_OUT;
        if (u < T_GU) { const int m = u / 256, r = u % 256; cvt_tile<2>(p.w_gu + (size_t)m * 1024 * 2048, 2048, wsp<bf16_t>(p, WS_WGU) + (size_t)m * 2048 * 1024, 1024, (r / 16) * 64, (r % 16) * 128, tile); continue; }
        u -= T_GU;
        { const int m = u / 128, r = u % 128; cvt_tile<0>(p.w_dn + (size_t)m * 1024 * 1024, 1024, wsp<bf16_t>(p, WS_WDN) + (size_t)m * 1024 * 1024, 1024, (r / 8) * 64, (r % 8) * 128, tile); }
    }
    for (int i = blk * 512 + tid; i < 64 * 32; i += G * 512) { const int pos = i >> 5, f = i & 31; const float inv = powf(10000.0f, -(float)f / 32.0f); const float ang = (float)pos * inv;
        wsp<f32x2>(p, WS_ROPE)[i] = (f32x2){cosf(ang), sinf(ang)}; }
    for (int i = blk * 512 + tid; i < 4 * 16 * 1024; i += G * 512) { const int l = i >> 14, g = (i >> 10) & 15, k = i & 1023; wsp<float>(p, WS_WGATE)[i] = p.w_in[((size_t)l * 1024 + k) * DIN + 2048 + g]; }
    { const float* srcs[15] = {p.gate_bias, p.norm_g, p.rpb, p.sg_ln_g, p.sg_ln_b, p.sg_w, p.sg_b, p.ln1_g, p.ln1_b, p.router_w, p.router_b, p.b_gu, p.b_dn, p.ln2_g, p.ln2_b};
      const size_t offs[16] = {SM_GBIAS, SM_NORMG, SM_RPB, SM_SGLNG, SM_SGLNB, SM_SGW, SM_SGB, SM_LN1G, SM_LN1B, SM_RW, SM_RB, SM_BGU, SM_BDN, SM_LN2G, SM_LN2B, SM_END};
      float* dsm = wsp<float>(p, WS_SM);
#pragma unroll
      for (int a = 0; a < 15; ++a) { const int n = (int)(offs[a + 1] - offs[a]); const float* sp = srcs[a]; for (int i = blk * 512 + tid; i < n; i += G * 512) dsm[offs[a] + i] = sp[i]; } }
    LAS float* sl = (LAS float*)lds;
    LAS float* red = sl + 9 * 1024;
    for (int i = tid; i < 9 * 1024; i += 512) { const float v = i < 8192 ? p.c[i] : p.c_ctx[i - 8192]; sl[i] = v / (1.0f + __expf(-v)); }
    __syncthreads();
    for (int u = blk; u < 4 * 96; u += G) {
        const int l = u / 96, c0 = (u % 96) * 64, col = c0 + (tid & 63), kg = tid >> 6;
        float a[9];
#pragma unroll
        for (int b = 0; b < 9; ++b) a[b] = 0.f;
        const float* w = p.w_mod + ((size_t)l * 1024 + kg * 128) * 6144 + col;
#pragma unroll 4
        for (int k = 0; k < 128; ++k) { const float wv = w[(size_t)k * 6144];
#pragma unroll
            for (int b = 0; b < 9; ++b) a[b] += sl[b * 1024 + kg * 128 + k] * wv; }
#pragma unroll
        for (int b = 0; b < 9; ++b) red[(kg * 64 + (tid & 63)) * 9 + b] = a[b];
        __syncthreads();
        for (int i = tid; i < 64 * 9; i += 512) { const int cc = i / 9, b = i % 9; float s = 0.f;
#pragma unroll
            for (int g = 0; g < 8; ++g) s += red[(g * 64 + cc) * 9 + b];
            wsp<float>(p, WS_MOD)[((size_t)l * 9 + b) * 6144 + c0 + cc] = s + p.b_mod[(size_t)l * 6144 + c0 + cc]; }
        __syncthreads();
    }
}

DI void ld_row_f32(const float* p, float (&v)[16], int lane) {
#pragma unroll
    for (int j = 0; j < 4; ++j) { const f32x4 t = *(const f32x4*)(p + 256 * j + 4 * lane); v[4 * j] = t[0]; v[4 * j + 1] = t[1]; v[4 * j + 2] = t[2]; v[4 * j + 3] = t[3]; }
}
DI void st_row_f32(float* p, const float (&v)[16], int lane) {
#pragma unroll
    for (int j = 0; j < 4; ++j) *(f32x4*)(p + 256 * j + 4 * lane) = (f32x4){v[4 * j], v[4 * j + 1], v[4 * j + 2], v[4 * j + 3]};
}
DI void ld_row_bf16(const bf16_t* p, float (&v)[16], int lane) {
#pragma unroll
    for (int j = 0; j < 4; ++j) { const u32x2 t = *(const u32x2*)(p + 256 * j + 4 * lane); v[4 * j] = bflo(t[0]); v[4 * j + 1] = bfhi(t[0]); v[4 * j + 2] = bflo(t[1]); v[4 * j + 3] = bfhi(t[1]); }
}
DI void st_row_bf16(bf16_t* p, const float (&v)[16], int lane) {
#pragma unroll
    for (int j = 0; j < 4; ++j) *(u32x2*)(p + 256 * j + 4 * lane) = (u32x2){pk2(v[4 * j], v[4 * j + 1]), pk2(v[4 * j + 2], v[4 * j + 3])};
}
DI void ln_row(float (&v)[16], const float* g, const float* b, int lane) {
    float s = 0.f;
#pragma unroll
    for (int i = 0; i < 16; ++i) s += v[i];
    const float mean = wave_sum(s) * (1.0f / 1024.0f);
    float q = 0.f;
#pragma unroll
    for (int i = 0; i < 16; ++i) { const float d = v[i] - mean; q += d * d; }
    const float rstd = 1.0f / sqrtf(wave_sum(q) * (1.0f / 1024.0f) + LN_EPS);
    float gg[16], bb[16]; ld_row_f32(g, gg, lane); ld_row_f32(b, bb, lane);
#pragma unroll
    for (int i = 0; i < 16; ++i) v[i] = (v[i] - mean) * rstd * gg[i] + bb[i];
}
DI void modulate(const float (&v)[16], float (&h)[16], const float* sh, const float* sc, int lane) {
    float a[16], b[16]; ld_row_f32(sh, a, lane); ld_row_f32(sc, b, lane);
#pragma unroll
    for (int i = 0; i < 16; ++i) h[i] = v[i] * (1.0f + b[i]) + a[i];
}
template <int N> DI float row_dots(const float (&h)[16], const LAS float* wl, int lane) {
    float s[N];
#pragma unroll
    for (int e = 0; e < N; ++e) s[e] = 0.f;
#pragma unroll 1
    for (int eg = 0; eg < N / 4; ++eg) {
        float a[4];
#pragma unroll
        for (int i = 0; i < 4; ++i) { float t = 0.f;
#pragma unroll
            for (int j = 0; j < 4; ++j) { const f32x4 w = *(const LAS f32x4*)(wl + (eg * 4 + i) * 1024 + 256 * j + 4 * lane); t += h[4 * j] * w[0] + h[4 * j + 1] * w[1] + h[4 * j + 2] * w[2] + h[4 * j + 3] * w[3]; }
            a[i] = t; }
#pragma unroll
        for (int k = 0; k < N / 4; ++k) { const unsigned mk = (k == eg) ? 0xffffffffu : 0u;
#pragma unroll
            for (int i = 0; i < 4; ++i) s[4 * k + i] = __builtin_bit_cast(float, (__builtin_bit_cast(unsigned, s[4 * k + i]) & ~mk) | (__builtin_bit_cast(unsigned, a[i]) & mk)); }
    }
    return bfly<N>(s, lane);
}
DI void load_small_w(LAS float* wl, const float* src, int n  ) { for (int i = ltid(); i < n / 4; i += 512) *(LAS f32x4*)(wl + 4 * i) = *(const f32x4*)(src + 4 * i); __syncthreads(); }

DI void emit_h_and_gates(const Params& p, int layer, int row, const float (&x)[16], const LAS float* wg, int lane) {
    const float* mod = wsp<float>(p, WS_MOD) + ((size_t)layer * 9 + bsel_of(row)) * 6144;
    float h[16]; modulate(x, h, mod, mod + 1024, lane);
    st_row_bf16(wsp<bf16_t>(p, WS_H) + (size_t)row * D, h, lane);
    const float g = row_dots<16>(h, wg, lane);
    if ((lane & 3) == 0) wsp<float>(p, WS_GPRE)[(size_t)row * 16 + (lane >> 2)] = g;
}
DI void phase_init(const Params& p, LAS unsigned char* lds) {
    const int lane = ltid() & 63, wave = ltid() >> 6, blk = lbid();
    LAS float* wg = (LAS float*)lds; load_small_w(wg, wsp<float>(p, WS_WGATE), 16 * 1024);
#pragma unroll 1
    for (int i = 0; i < 17; ++i) { const int row = row_of(blk, wave, i);
        float x[16]; ld_row_f32(row < ML ? p.x + (size_t)row * D : p.ctx + (size_t)(row - ML) * D, x, lane);
        st_row_f32(wsp<float>(p, WS_X) + (size_t)row * D, x, lane);
        emit_h_and_gates(p, 0, row, x, wg, lane); }
}

DI void phase_ln1_router(const Params& p, int layer, LAS unsigned char* lds) {
    const int tid = ltid(), lane = tid & 63, wave = tid >> 6, blk = lbid();
    LAS float* rw = (LAS float*)lds;
    LAS int* cnt = (LAS int*)(lds + 32 * 1024 * 4);
    { const float* src = SMP(SM_RW) + (size_t)layer * 1024 * 32;
      for (int i = tid; i < 32 * 1024; i += 512) { const int k = i >> 5, e = i & 31; rw[e * 1024 + k] = src[i]; }
      if (tid < 32) cnt[tid] = 0; }
    __syncthreads();
    const bool last = (layer == DEPTH - 1);
#pragma unroll 1
    for (int i = 0; i < 17; ++i) { const int row = row_of(blk, wave, i);
        if (last && row >= ML) continue;
        const float* mod = wsp<float>(p, WS_MOD) + ((size_t)layer * 9 + bsel_of(row)) * 6144;
        float x[16], y[16], g1[16];
        ld_row_f32(wsp<float>(p, WS_X) + (size_t)row * D, x, lane); ld_row_bf16(wsp<bf16_t>(p, WS_Y) + (size_t)row * D, y, lane); ld_row_f32(mod + 2 * 1024, g1, lane);
#pragma unroll
        for (int j = 0; j < 16; ++j) x[j] = DN_ALPHA * x[j] + g1[j] * y[j];
        ln_row(x, SMP(SM_LN1G) + (size_t)layer * D, SMP(SM_LN1B) + (size_t)layer * D, lane);
        st_row_f32(wsp<float>(p, WS_X) + (size_t)row * D, x, lane);
        float h[16]; modulate(x, h, mod + 3 * 1024, mod + 4 * 1024, lane);
        st_row_bf16(wsp<bf16_t>(p, WS_H2) + (size_t)row * D, h, lane);
        float lg = row_dots<32>(h, rw, lane) + SMP(SM_RB)[layer * 32 + (lane >> 1)];
        int te[4]; float tv[4];
#pragma unroll
        for (int k = 0; k < 4; ++k) {
            float bv = lg; int be = lane >> 1;
#pragma unroll
            for (int o = 32; o >= 1; o >>= 1) { const float ov = __shfl_xor(bv, o); const int oe = __shfl_xor(be, o); if (ov > bv || (ov == bv && oe < be)) { bv = ov; be = oe; } }
            te[k] = be; tv[k] = bv; if ((lane >> 1) == be) lg = -3.0e38f;
        }
        const float e1 = __expf(tv[1] - tv[0]), e2 = __expf(tv[2] - tv[0]), e3 = __expf(tv[3] - tv[0]); const float inv = 1.0f / (1.0f + e1 + e2 + e3);
        if (lane < 4) { const int e = lane == 0 ? te[0] : lane == 1 ? te[1] : lane == 2 ? te[2] : te[3]; const float gk = (lane == 0 ? 1.0f : lane == 1 ? e1 : lane == 2 ? e2 : e3) * inv;
            const int r = atomicAdd((int*)&cnt[e], 1);
            wsp<int>(p, WS_TOPE)[(size_t)row * 4 + lane] = e; wsp<float>(p, WS_TOPG)[(size_t)row * 4 + lane] = gk; wsp<int>(p, WS_TOPR)[(size_t)row * 4 + lane] = r; }
    }
    __syncthreads();
    if (tid < 32) { const int c = cnt[tid]; int base = 0; if (c > 0) base = (int)atomicAdd(wsp<unsigned>(p, WS_CTL) + CW_CNT + layer * 32 + tid, (unsigned)c); wsp<int>(p, WS_BASE)[blk * 32 + tid] = base; }
}

DI void phase_scatter(const Params& p, int layer, LAS unsigned char* lds) {
    const int tid = ltid(), lane = tid & 63, wave = tid >> 6, blk = lbid();
    LAS int* pst = (LAS int*)lds;
    if (tid == 0) { int acc = 0; for (int e = 0; e < 32; ++e) { const int c = (int)__hip_atomic_load(wsp<unsigned>(p, WS_CTL) + CW_CNT + layer * 32 + e, __ATOMIC_RELAXED, __HIP_MEMORY_SCOPE_AGENT); pst[e] = acc; pst[32 + e] = c; acc += (c + 255) & ~255; } pst[64] = acc >> 8; }
    __syncthreads();
    if (blk == 0) { int* be = wsp<int>(p, WS_BLKE); if (tid == 0) be[0] = pst[64];
#pragma unroll 1
        for (int e = 0; e < 32; ++e) { const int b0 = pst[e] >> 8, nb = (pst[32 + e] + 255) >> 8; for (int j = tid; j < nb; j += 512) be[1 + b0 + j] = e; } }
    const bool last = (layer == DEPTH - 1);
#pragma unroll 1
    for (int i = 0; i < 17; ++i) { const int row = row_of(blk, wave, i);
        if (last && row >= ML) continue;
        const u32x4* src = (const u32x4*)(wsp<bf16_t>(p, WS_H2) + (size_t)row * D);
        const u32x4 v0 = src[lane], v1 = src[64 + lane];
#pragma unroll
        for (int k = 0; k < 4; ++k) { const int e = wsp<int>(p, WS_TOPE)[(size_t)row * 4 + k], r = wsp<int>(p, WS_TOPR)[(size_t)row * 4 + k];
            const int dest = pst[e] + wsp<int>(p, WS_BASE)[blk * 32 + e] + r;
            if (lane == 0) wsp<int>(p, WS_DEST)[(size_t)row * 4 + k] = dest;
            u32x4* d = (u32x4*)(wsp<bf16_t>(p, WS_XG) + (size_t)dest * D); d[lane] = v0; d[64 + lane] = v1; }
    }
}

DI void phase_ln2(const Params& p, int layer, LAS unsigned char* lds) {
    const int tid = ltid(), lane = tid & 63, wave = tid >> 6, blk = lbid();
    const bool last = (layer == DEPTH - 1);
    LAS float* wg = (LAS float*)lds;
    if (!last) load_small_w(wg, wsp<float>(p, WS_WGATE) + (size_t)(layer + 1) * 16 * 1024, 16 * 1024);
#pragma unroll 1
    for (int i = 0; i < 17; ++i) { const int row = row_of(blk, wave, i);
        if (last && row >= ML) continue;
        const float* mod = wsp<float>(p, WS_MOD) + ((size_t)layer * 9 + bsel_of(row)) * 6144;
        float x[16], f[16], g2[16];
#pragma unroll
        for (int j = 0; j < 16; ++j) f[j] = 0.f;
#pragma unroll
        for (int k = 0; k < 4; ++k) { const int dest = wsp<int>(p, WS_DEST)[(size_t)row * 4 + k]; const float gk = wsp<float>(p, WS_TOPG)[(size_t)row * 4 + k];
            float y[16]; ld_row_bf16(wsp<bf16_t>(p, WS_YS) + (size_t)dest * D, y, lane);
#pragma unroll
            for (int j = 0; j < 16; ++j) f[j] += gk * y[j]; }
        ld_row_f32(wsp<float>(p, WS_X) + (size_t)row * D, x, lane); ld_row_f32(mod + 5 * 1024, g2, lane);
#pragma unroll
        for (int j = 0; j < 16; ++j) x[j] = DN_ALPHA * x[j] + g2[j] * f[j];
        ln_row(x, SMP(SM_LN2G) + (size_t)layer * D, SMP(SM_LN2B) + (size_t)layer * D, lane);
        if (last) { st_row_f32(p.out + (size_t)row * D, x, lane); }
        else { st_row_f32(wsp<float>(p, WS_X) + (size_t)row * D, x, lane); emit_h_and_gates(p, layer + 1, row, x, wg, lane); }
    }
}
using pg8::Unit;
struct SchedDense {
    pg8::TileOrder T; const bf16_t* A; int lda; const bf16_t* Bt; int K;
    DI bool next(int i, Unit& u) const { u.aux = 0; return T.tile(i, u.pm, u.pn); }
    DI const char* a_base(const Unit& u) const { return (const char*)(A + (size_t)u.pm * 256 * lda); }
    DI const char* b_base(const Unit& u) const { return (const char*)(Bt + (size_t)u.pn * 256 * K); }
};
struct SchedMerge {
    pg8::TileOrder T; const bf16_t* A; const bf16_t* Bt; static constexpr int lda = 1536;
    DI bool next(int i, Unit& u) const { u.aux = i % 3; return T.tile(i / 3, u.pm, u.pn); }
    DI const char* a_base(const Unit& u) const { return (const char*)(A + (size_t)u.pm * 256 * 1536 + u.aux * 512); }
    DI const char* b_base(const Unit& u) const { return (const char*)(Bt + ((size_t)u.aux * 1024 + (size_t)u.pn * 256) * 512); }
};
template <int NT> struct SchedMoe {
    const int* blke; int nunits, G, c; const bf16_t* A; const bf16_t* Bt; size_t bstride; static constexpr int lda = 1024;
    DI void init(const int* blke_, int G_, int c_) { blke = blke_; nunits = blke_[0] * NT; G = G_; c = c_; }
    DI bool next(int i, Unit& u) const { const int L = i * G + c; if (L >= nunits) return false; u.pm = L / NT; u.pn = L % NT; u.aux = blke[1 + u.pm]; return true; }
    DI const char* a_base(const Unit& u) const { return (const char*)(A + (size_t)u.pm * 256 * 1024); }
    DI const char* b_base(const Unit& u) const { return (const char*)(Bt + (size_t)u.aux * bstride + (size_t)u.pn * 256 * 1024); }
};

#define EPI_ROWS_BEGIN _Pragma("unroll") for (int ai = 0; ai < 2; ++ai) _Pragma("unroll") for (int m = 0; m < 4; ++m) { const int row = u.pm * 256 + ai * 128 + wr * 64 + m * 16 + fr;
#define EPI_ROWS_END }
DI u32x4 pack8(const f32x4& a, const f32x4& b) { return (u32x4){cvt_pk_bf16(a[0], a[1]), cvt_pk_bf16(a[2], a[3]), cvt_pk_bf16(b[0], b[1]), cvt_pk_bf16(b[2], b[3])}; }

struct EpiInproj {
    bf16_t* P; const f32x2* rope;
    DI void operator()(const f32x4 (&acc)[2][2][4][2], const Unit& u, int wr, int wc, int fr, int fq) const {
        const int pn = u.pn; const int colb = pn * 256 + wc * 32 + 8 * fq;
        const int kind = pn < 2 ? 0 : pn < 4 ? 1 : pn < 6 ? 2 : pn < 8 ? 3 : pn < 10 ? 4 : pn < 14 ? 2 : pn < 18 ? 5 : 3;
        const bool latent = u.pm < 128;
        const int ra = wc >> 1, f0 = ((wc & 1) * 4 + fq) * 4;
        EPI_ROWS_BEGIN
            bf16_t* rowp = P + (size_t)row * NPROJ + colb;
            f32x4 cs[2]; if (kind <= 1 && latent) { const int t = row & 4095; const int pos = ra ? (t & 63) : (t >> 6); const f32x4* rp = (const f32x4*)(rope + pos * 32 + f0); cs[0] = rp[0]; cs[1] = rp[1]; }
#pragma unroll
            for (int bj = 0; bj < 2; ++bj) { f32x4 v0 = acc[ai][bj][m][0], v1 = acc[ai][bj][m][1];
                if (kind == 0) { v0 = v0 * 0.08838834764831845f; v1 = v1 * 0.08838834764831845f; }
                if (kind == 4) { v0 = v0 * 0.125f; v1 = v1 * 0.125f; }
                if (kind <= 1 && latent) {
                    const float c[4] = {cs[0][0], cs[0][2], cs[1][0], cs[1][2]}, s[4] = {cs[0][1], cs[0][3], cs[1][1], cs[1][3]};
#pragma unroll
                    for (int j = 0; j < 4; ++j) { const float x1 = v0[j], x2 = v1[j]; v0[j] = x1 * c[j] - x2 * s[j]; v1[j] = x2 * c[j] + x1 * s[j]; } }
                if (kind == 3) {
#pragma unroll
                    for (int j = 0; j < 4; ++j) { v0[j] = sigmoidf_(v0[j]); v1[j] = sigmoidf_(v1[j]); } }
                if (kind == 5) {
#pragma unroll
                    for (int j = 0; j < 4; ++j) { v0[j] = gelu_tanh(v0[j]); v1[j] = gelu_tanh(v1[j]); } }
                *(u32x4*)(rowp + bj * 128) = pack8(v0, v1); }
        EPI_ROWS_END
    }
};
struct EpiMerge {
    bf16_t* Mg; const bf16_t* P;
    DI void operator()(const f32x4 (&acc)[2][2][4][2], const Unit& u, int wr, int wc, int fr, int fq) const {
        const int colb = u.pn * 256 + wc * 32 + 8 * fq;
        EPI_ROWS_BEGIN
#pragma unroll
            for (int bj = 0; bj < 2; ++bj) { const int col = colb + bj * 128;
                const u32x4 g = *(const u32x4*)(P + (size_t)row * NPROJ + PBG + u.aux * 1024 + col);
                f32x4 v0 = acc[ai][bj][m][0], v1 = acc[ai][bj][m][1];
                v0 = v0 * (f32x4){bflo(g[0]), bfhi(g[0]), bflo(g[1]), bfhi(g[1])}; v1 = v1 * (f32x4){bflo(g[2]), bfhi(g[2]), bflo(g[3]), bfhi(g[3])};
                u32x4* dst = (u32x4*)(Mg + (size_t)row * D + col);
                if (u.aux > 0) { const u32x4 o = *dst; v0 = v0 + (f32x4){bflo(o[0]), bfhi(o[0]), bflo(o[1]), bfhi(o[1])}; v1 = v1 + (f32x4){bflo(o[2]), bfhi(o[2]), bflo(o[3]), bfhi(o[3])}; }
                *dst = pack8(v0, v1); }
        EPI_ROWS_END
    }
};
struct EpiStore {
    bf16_t* O; int ldo; const float* bias; int bias_stride;
    DI void operator()(const f32x4 (&acc)[2][2][4][2], const Unit& u, int wr, int wc, int fr, int fq) const {
        const int colb = u.pn * 256 + wc * 32 + 8 * fq;
        f32x4 bv[2][2];
#pragma unroll
        for (int bj = 0; bj < 2; ++bj)
#pragma unroll
            for (int n = 0; n < 2; ++n) bv[bj][n] = bias ? *(const f32x4*)(bias + (size_t)u.aux * bias_stride + colb + bj * 128 + 4 * n) : (f32x4){0.f, 0.f, 0.f, 0.f};
        EPI_ROWS_BEGIN
#pragma unroll
            for (int bj = 0; bj < 2; ++bj) *(u32x4*)(O + (size_t)row * ldo + colb + bj * 128) = pack8(acc[ai][bj][m][0] + bv[bj][0], acc[ai][bj][m][1] + bv[bj][1]);
        EPI_ROWS_END
    }
};
struct EpiGu {
    bf16_t* ACT; const float* b_gu;
    DI void operator()(const f32x4 (&acc)[2][2][4][2], const Unit& u, int wr, int wc, int fr, int fq) const {
        f32x4 bg[2], bu[2];
#pragma unroll
        for (int bj = 0; bj < 2; ++bj) { const int oc = u.pn * 128 + bj * 64 + wc * 16 + 4 * fq; bg[bj] = *(const f32x4*)(b_gu + (size_t)u.aux * 2048 + oc); bu[bj] = *(const f32x4*)(b_gu + (size_t)u.aux * 2048 + 1024 + oc); }
        EPI_ROWS_BEGIN
#pragma unroll
            for (int bj = 0; bj < 2; ++bj) { const int oc = u.pn * 128 + bj * 64 + wc * 16 + 4 * fq;
                const f32x4 g = acc[ai][bj][m][0] + bg[bj], up = acc[ai][bj][m][1] + bu[bj]; float a[4];
#pragma unroll
                for (int j = 0; j < 4; ++j) { const float gt = fminf(g[j], 7.0f), ut = fminf(fmaxf(up[j], -7.0f), 7.0f); a[j] = gt * sigmoidf_(1.702f * gt) * (ut + 1.0f); }
                *(u32x2*)(ACT + (size_t)row * 1024 + oc) = (u32x2){cvt_pk_bf16(a[0], a[1]), cvt_pk_bf16(a[2], a[3])}; }
        EPI_ROWS_END
    }
};

DI void phase_inproj(const Params& p, int layer, LAS unsigned char* lds) {
    SchedDense S; S.T.init(MT / 256, NPROJ / 256, lgdim(), lbid()); S.A = wsp<bf16_t>(p, WS_H); S.lda = 1024; S.Bt = wsp<bf16_t>(p, WS_WIN) + (size_t)layer * NPROJ * 1024; S.K = 1024;
    EpiInproj E{wsp<bf16_t>(p, WS_P), wsp<f32x2>(p, WS_ROPE)};
    pg8::gemm_phase(lds, 1024, S, E);
}
DI void phase_merge(const Params& p, int layer, LAS unsigned char* lds) {
    SchedMerge S; S.T.init(MT / 256, 4, lgdim(), lbid()); S.A = wsp<bf16_t>(p, WS_ABC); S.Bt = wsp<bf16_t>(p, WS_WBR) + (size_t)layer * 3 * 1024 * 512;
    EpiMerge E{wsp<bf16_t>(p, WS_MRG), wsp<bf16_t>(p, WS_P)};
    pg8::gemm_phase(lds, 512, S, E);
}
DI void phase_outproj(const Params& p, int layer, LAS unsigned char* lds) {
    SchedDense S; S.T.init(MT / 256, 4, lgdim(), lbid()); S.A = wsp<bf16_t>(p, WS_MRG); S.lda = 1024; S.Bt = wsp<bf16_t>(p, WS_WOUT) + (size_t)layer * 1024 * 1024; S.K = 1024;
    EpiStore E{wsp<bf16_t>(p, WS_Y), 1024, nullptr, 0};
    pg8::gemm_phase(lds, 1024, S, E);
}
DI void phase_moe_gu(const Params& p, int layer, LAS unsigned char* lds) {
    SchedMoe<8> S; S.init(wsp<int>(p, WS_BLKE), lgdim(), lbid()); S.A = wsp<bf16_t>(p, WS_XG); S.Bt = wsp<bf16_t>(p, WS_WGU) + (size_t)layer * 32 * 2048 * 1024; S.bstride = (size_t)2048 * 1024;
    EpiGu E{wsp<bf16_t>(p, WS_ACT), SMP(SM_BGU) + (size_t)layer * 32 * 2048};
    pg8::gemm_phase(lds, 1024, S, E);
}
DI void phase_moe_dn(const Params& p, int layer, LAS unsigned char* lds) {
    SchedMoe<4> S; S.init(wsp<int>(p, WS_BLKE), lgdim(), lbid()); S.A = wsp<bf16_t>(p, WS_ACT); S.Bt = wsp<bf16_t>(p, WS_WDN) + (size_t)layer * 32 * 1024 * 1024; S.bstride = (size_t)1024 * 1024;
    EpiStore E{wsp<bf16_t>(p, WS_YS), 1024, SMP(SM_BDN) + (size_t)layer * 32 * 1024, 1024};
    pg8::gemm_phase(lds, 1024, S, E);
}
DI int chain_tok(int dir, int b, int j, int tau) {
    if (dir == 0) return j < 4 ? ML + b * 256 + j * 64 + tau : b * 4096 + (j - 4) * 64 + tau;
    return j < 4 ? ML + b * 256 + (3 - j) * 64 + (63 - tau) : b * 4096 + (67 - j) * 64 + (63 - tau);
}
DI void phase_gates(const Params& p, int layer) {
    const int lane = ltid() & 63, gw = lbid() * 8 + (ltid() >> 6), nw = lgdim() * 8;
    const float* gb = SMP(SM_GBIAS) + layer * 16;
    for (int u = gw; u < NCHAIN * NSLOT; u += nw) {
        const int ch = u / NSLOT, j = u % NSLOT, dir = ch >> 5, b = (ch >> 2) & 7, h = ch & 3;
        const int tok = chain_tok(dir, b, j, lane);
        const float* g = wsp<float>(p, WS_GPRE) + (size_t)tok * 16;
        const float li = g[(dir * 2) * 4 + h] + gb[(dir * 2) * 4 + h];
        const float lf = log_sigmoid(g[(dir * 2 + 1) * 4 + h] + gb[(dir * 2 + 1) * 4 + h]);
        float bc = lf;
#pragma unroll
        for (int o = 1; o < 64; o <<= 1) { const float t = __shfl_up(bc, o); if (lane >= o) bc += t; }
        const float a = li - bc; float cm = a;
#pragma unroll
        for (int o = 1; o < 64; o <<= 1) { const float t = __shfl_up(cm, o); if (lane >= o) cm = fmaxf(cm, t); }
        const size_t o = (size_t)u * 64 + lane;
        wsp<float>(p, WS_GA)[o] = a; wsp<float>(p, WS_GCM)[o] = cm; wsp<float>(p, WS_GB)[o] = bc;
    }
}
DI float chain_m(const Params& p, int ch, int j) {
    const float* gcm = wsp<float>(p, WS_GCM) + (size_t)ch * NSLOT * 64 + 63; const float* gbb = wsp<float>(p, WS_GB) + (size_t)ch * NSLOT * 64 + 63;
    float m = 0.f; for (int i = 0; i < j; ++i) m = gbb[i * 64] + fmaxf(m, gcm[i * 64]); return m;
}

#define MFMA16(a, b, c) __builtin_amdgcn_mfma_f32_16x16x32_bf16((a), (b), (c), 0, 0, 0)
DI bf16x8 tr_frag(LAS unsigned char* base, int off0, int off1) {
    const s16x4 lo = __builtin_amdgcn_ds_read_tr16_b64_v4i16((LAS s16x4*)(base + off0)); const s16x4 hi = __builtin_amdgcn_ds_read_tr16_b64_v4i16((LAS s16x4*)(base + off1));
    return __builtin_shufflevector(lo, hi, 0, 1, 2, 3, 4, 5, 6, 7);
}
DI bf16x8 pack_frag(const float (&a)[4], const float (&b)[4]) { const u32x4 w = (u32x4){cvt_pk_bf16(a[0], a[1]), cvt_pk_bf16(a[2], a[3]), cvt_pk_bf16(b[0], b[1]), cvt_pk_bf16(b[2], b[3])}; return __builtin_bit_cast(bf16x8, w); }

DI void mlstm_u_unit(const Params& p, int u, LAS unsigned char* lds) {
    const int tid = ltid(), lane = tid & 63, wave = __builtin_amdgcn_readfirstlane(tid >> 6), g = lane >> 4, c = lane & 15;
    const int ch = u / (NSLOT - 1), j = u % (NSLOT - 1), dir = ch >> 5, b = (ch >> 2) & 7, h = ch & 3;
    const int tokb = dir == 0 ? (j < 4 ? ML + b * 256 + j * 64 : b * 4096 + (j - 4) * 64) : (j < 4 ? ML + b * 256 + (3 - j) * 64 : b * 4096 + (67 - j) * 64);
    constexpr int VS = 304, KS = 272;
    LAS unsigned char* Vs = lds; LAS unsigned char* Kw = lds + 64 * VS; LAS float* wl = (LAS float*)(lds + 64 * VS + 64 * KS);
    const size_t slot = (size_t)ch * NSLOT + j;
    if (tid < 64) { const int tau = dir ? 63 - tid : tid; const float mj = chain_m(p, ch, j); const float Mend = fmaxf(mj, wsp<float>(p, WS_GCM)[slot * 64 + 63]); wl[tid] = __expf(wsp<float>(p, WS_GA)[slot * 64 + tau] - Mend); }
    __syncthreads();
    { const int s = tid >> 3, pc = tid & 7; const bf16_t* row = wsp<bf16_t>(p, WS_P) + (size_t)(tokb + s) * NPROJ + h * 128 + pc * 16;
      const u32x4 v0 = *(const u32x4*)(row + PV), v1 = *(const u32x4*)(row + PV + 8); *(LAS u32x4*)(Vs + s * VS + pc * 32) = v0; *(LAS u32x4*)(Vs + s * VS + pc * 32 + 16) = v1;
      const u32x4 k0 = *(const u32x4*)(row + PK), k1 = *(const u32x4*)(row + PK + 8); const float w = wl[s]; u32x4 o0, o1;
#pragma unroll
      for (int e = 0; e < 4; ++e) { o0[e] = cvt_pk_bf16(w * bflo(k0[e]), w * bfhi(k0[e])); o1[e] = cvt_pk_bf16(w * bflo(k1[e]), w * bfhi(k1[e])); }
      *(LAS u32x4*)(Kw + s * KS + pc * 32) = o0; *(LAS u32x4*)(Kw + s * KS + pc * 32 + 16) = o1;
      *(LAS unsigned*)(Vs + s * VS + 256 + pc * 4) = pc == 0 ? 0x3F80u : 0u; }
    __syncthreads();
    bf16x8 kf[2];
#pragma unroll
    for (int kk = 0; kk < 2; ++kk) { const int o = (32 * kk + 8 * g + (c >> 2)) * KS + (16 * wave + 4 * (c & 3)) * 2; kf[kk] = tr_frag(Kw, o, o + 4 * KS); }
    bf16_t* uc = wsp<bf16_t>(p, WS_UC) + slot * 16384; float* un = wsp<float>(p, WS_UN) + slot * 128;
#pragma unroll
    for (int vb = 0; vb < 9; ++vb) { f32x4 acc = (f32x4){0.f, 0.f, 0.f, 0.f};
#pragma unroll
        for (int kk = 0; kk < 2; ++kk) { const int o = (32 * kk + 8 * g + (c >> 2)) * VS + (16 * vb + 4 * (c & 3)) * 2; acc = MFMA16(kf[kk], tr_frag(Vs, o, o + 4 * VS), acc); }
        if (vb < 8) *(u32x2*)(uc + (16 * vb + c) * 128 + 16 * wave + 4 * g) = (u32x2){cvt_pk_bf16(acc[0], acc[1]), cvt_pk_bf16(acc[2], acc[3])};
        else if (c == 0) *(f32x4*)(un + 16 * wave + 4 * g) = acc; }
    __syncthreads();
}
DI void phase_scan(const Params& p) {
    const int gt = lbid() * 512 + ltid(), nthr = lgdim() * 512;
    for (int w = gt; w < NCHAIN * 2048; w += nthr) {
        const int ch = w >> 11, e8 = w & 2047;
        const float* gcm = wsp<float>(p, WS_GCM) + (size_t)ch * NSLOT * 64 + 63; const float* gbb = wsp<float>(p, WS_GB) + (size_t)ch * NSLOT * 64 + 63;
        u32x4* base = (u32x4*)(wsp<bf16_t>(p, WS_UC) + (size_t)ch * NSLOT * 16384) + e8;
        float* nb = wsp<float>(p, WS_UN) + (size_t)ch * NSLOT * 128 + e8;
        float c[8], nn = 0.f, m = 0.f;
#pragma unroll
        for (int i = 0; i < 8; ++i) c[i] = 0.f;
        for (int j = 0; j < NSLOT; ++j) {
            u32x4 uu = (u32x4){0u, 0u, 0u, 0u}; float un = 0.f;
            if (j < NSLOT - 1) { uu = base[(size_t)j * 2048]; if (e8 < 128) un = nb[j * 128]; }
            base[(size_t)j * 2048] = (u32x4){pk2(c[0], c[1]), pk2(c[2], c[3]), pk2(c[4], c[5]), pk2(c[6], c[7])};
            if (e8 < 128) nb[j * 128] = nn;
            const float cme = gcm[j * 64], be = gbb[j * 64]; const float Mend = fmaxf(m, cme); const float dec = __expf(m - Mend); m = be + Mend;
            c[0] = dec * c[0] + bflo(uu[0]); c[1] = dec * c[1] + bfhi(uu[0]); c[2] = dec * c[2] + bflo(uu[1]); c[3] = dec * c[3] + bfhi(uu[1]);
            c[4] = dec * c[4] + bflo(uu[2]); c[5] = dec * c[5] + bfhi(uu[2]); c[6] = dec * c[6] + bflo(uu[3]); c[7] = dec * c[7] + bfhi(uu[3]);
            nn = dec * nn + un;
        }
    }
}
DI void mlstm_h_unit(const Params& p, int layer, int u, LAS unsigned char* lds) {
    const int tid = ltid(), lane = tid & 63, wave = __builtin_amdgcn_readfirstlane(tid >> 6), g = lane >> 4, c = lane & 15;
    const int b = u / (4 * 68), h = (u / 68) & 3, cc = u % 68; const bool isctx = cc < 4; const int ck = isctx ? cc : cc - 4;
    const int tok0 = isctx ? ML + b * 256 + ck * 64 : b * 4096 + ck * 64;
    constexpr int QS = 272, VS = 304, CS = 272;
    LAS unsigned char* Qs = lds; LAS unsigned char* Ks = lds + 64 * QS; LAS unsigned char* Vs = lds + 128 * QS; LAS unsigned char* Cs = Vs + 64 * VS;
    LAS float* G = (LAS float*)(Cs + 2 * 144 * CS);
    const bf16_t* P = wsp<bf16_t>(p, WS_P);
    { const int t = tid >> 3, pc = tid & 7; const bf16_t* row = P + (size_t)(tok0 + t) * NPROJ + h * 128 + pc * 16;
      *(LAS u32x4*)(Qs + t * QS + pc * 32) = *(const u32x4*)(row + PQ); *(LAS u32x4*)(Qs + t * QS + pc * 32 + 16) = *(const u32x4*)(row + PQ + 8);
      *(LAS u32x4*)(Ks + t * QS + pc * 32) = *(const u32x4*)(row + PK); *(LAS u32x4*)(Ks + t * QS + pc * 32 + 16) = *(const u32x4*)(row + PK + 8);
      *(LAS u32x4*)(Vs + t * VS + pc * 32) = *(const u32x4*)(row + PV); *(LAS u32x4*)(Vs + t * VS + pc * 32 + 16) = *(const u32x4*)(row + PV + 8);
      *(LAS unsigned*)(Vs + t * VS + 256 + pc * 4) = pc == 0 ? 0x3F80u : 0u; }
#pragma unroll
    for (int dir = 0; dir < 2; ++dir) {
        const int ch = (dir * 8 + b) * 4 + h; const int j = dir == 0 ? (isctx ? ck : 4 + ck) : (isctx ? 3 - ck : 67 - ck); const size_t slot = (size_t)ch * NSLOT + j;
        const u32x4* src = (const u32x4*)(wsp<bf16_t>(p, WS_UC) + slot * 16384); LAS unsigned char* Cd = Cs + dir * 144 * CS;
#pragma unroll
        for (int k = 0; k < 4; ++k) { const int idx = tid + 512 * k; *(LAS u32x4*)(Cd + (idx >> 4) * CS + (idx & 15) * 16) = src[idx]; }
        if (tid < 64) { const float* nv = wsp<float>(p, WS_UN) + slot * 128 + 2 * tid; *(LAS unsigned*)(Cd + 128 * CS + tid * 4) = pk2(nv[0], nv[1]); }
        for (int idx = tid; idx < 960; idx += 512) *(LAS unsigned*)(Cd + (129 + (idx >> 6)) * CS + (idx & 63) * 4) = 0u;
        if (tid >= 256 && tid < 320) { const int s = tid - 256, tau = dir ? 63 - s : s; const float mprev = chain_m(p, ch, j);
            const float a = wsp<float>(p, WS_GA)[slot * 64 + tau], cm = wsp<float>(p, WS_GCM)[slot * 64 + tau], bb = wsp<float>(p, WS_GB)[slot * 64 + tau]; const float Mt = fmaxf(mprev, cm);
            LAS float* Gd = G + dir * 256; Gd[s] = a; Gd[64 + s] = Mt; Gd[128 + s] = __expf(mprev - Mt); Gd[192 + s] = __expf(-(bb + Mt)); }
    }
    __syncthreads();
    const int dir = wave >> 2, tb = wave & 3, t = 16 * tb + c;
    const LAS float* Gd = G + dir * 256; const float Mt = Gd[64 + t], wi = Gd[128 + t], fl = Gd[192 + t];
    bf16x8 qf[4];
#pragma unroll
    for (int kk = 0; kk < 4; ++kk) qf[kk] = *(const LAS bf16x8*)(Qs + t * QS + (kk * 32 + g * 8) * 2);
    f32x4 acc[9];
    { const LAS unsigned char* Cd = Cs + dir * 144 * CS;
#pragma unroll
      for (int vb = 0; vb < 9; ++vb) { f32x4 a = (f32x4){0.f, 0.f, 0.f, 0.f};
#pragma unroll
          for (int kk = 0; kk < 4; ++kk) a = MFMA16(*(const LAS bf16x8*)(Cd + (16 * vb + c) * CS + (kk * 32 + g * 8) * 2), qf[kk], a);
          acc[vb] = a * wi; } }
#pragma unroll
    for (int pr = 0; pr < 2; ++pr) {
        const bool needed = dir == 0 ? (2 * pr <= tb) : (2 * pr + 1 >= tb);
        if (needed) {
            f32x4 sA = (f32x4){0.f, 0.f, 0.f, 0.f}, sB = sA;
#pragma unroll
            for (int kk = 0; kk < 4; ++kk) { sA = MFMA16(*(const LAS bf16x8*)(Ks + (32 * pr + c) * QS + (kk * 32 + g * 8) * 2), qf[kk], sA); sB = MFMA16(*(const LAS bf16x8*)(Ks + (32 * pr + 16 + c) * QS + (kk * 32 + g * 8) * 2), qf[kk], sB); }
            float pA[4], pB[4];
#pragma unroll
            for (int i = 0; i < 4; ++i) { const int sa = 32 * pr + 4 * g + i, sb = sa + 16;
                const bool vA = dir == 0 ? (sa <= t) : (sa >= t), vB = dir == 0 ? (sb <= t) : (sb >= t);
                pA[i] = vA ? sA[i] * __expf(Gd[sa] - Mt) : 0.f; pB[i] = vB ? sB[i] * __expf(Gd[sb] - Mt) : 0.f; }
            const bf16x8 pf = pack_frag(pA, pB);
#pragma unroll
            for (int vb = 0; vb < 9; ++vb) { const int o = (32 * pr + 4 * g + (c >> 2)) * VS + (16 * vb + 4 * (c & 3)) * 2; acc[vb] = MFMA16(tr_frag(Vs, o, o + 16 * VS), pf, acc[vb]); }
        }
    }
    { const float den = __shfl(acc[8][0], c); const float inv = 1.0f / fmaxf(fabsf(den), fl);
#pragma unroll
      for (int vb = 0; vb < 8; ++vb) acc[vb] = acc[vb] * inv; }
    __syncthreads();
    LAS float* Hx = (LAS float*)lds;
    if (dir == 1) {
#pragma unroll
        for (int vb = 0; vb < 8; ++vb) *(LAS f32x4*)(Hx + t * 132 + 16 * vb + 4 * g) = acc[vb]; }
    __syncthreads();
    if (dir == 0) {
        float s = 0.f;
#pragma unroll
        for (int vb = 0; vb < 8; ++vb) { acc[vb] = acc[vb] + *(const LAS f32x4*)(Hx + t * 132 + 16 * vb + 4 * g); s += (acc[vb][0] + acc[vb][1]) + (acc[vb][2] + acc[vb][3]); }
        s += __shfl_xor(s, 16); s += __shfl_xor(s, 32); const float mean = s * (1.0f / 128.0f); float q = 0.f;
#pragma unroll
        for (int vb = 0; vb < 8; ++vb) { const f32x4 d = acc[vb] - mean; q += (d[0] * d[0] + d[1] * d[1]) + (d[2] * d[2] + d[3] * d[3]); }
        q += __shfl_xor(q, 16); q += __shfl_xor(q, 32); const float rstd = 1.0f / sqrtf(q * (1.0f / 128.0f) + LN_EPS);
        const size_t tok = (size_t)(tok0 + t); const float* ng = SMP(SM_NORMG) + (size_t)layer * 512 + h * 128;
#pragma unroll
        for (int vb = 0; vb < 8; ++vb) { const int v0 = 16 * vb + 4 * g; const f32x4 gg = *(const f32x4*)(ng + v0); const u32x2 ow = *(const u32x2*)(P + tok * NPROJ + PO + h * 128 + v0);
            const f32x4 r = (acc[vb] - mean) * rstd * gg * (f32x4){bflo(ow[0]), bfhi(ow[0]), bflo(ow[1]), bfhi(ow[1])};
            *(u32x2*)(wsp<bf16_t>(p, WS_ABC) + tok * 1536 + h * 128 + v0) = (u32x2){cvt_pk_bf16(r[0], r[1]), cvt_pk_bf16(r[2], r[3])}; }
    }
    __syncthreads();
}

DI int na_koff(int key, int chunk) { return key * 128 + ((chunk ^ (key & 7)) << 4); }
DI void na_unit(const Params& p, int layer, int u, LAS unsigned char* lds) {
    const int tid = ltid(), lane = tid & 63, wave = __builtin_amdgcn_readfirstlane(tid >> 6), g = lane >> 4, c = lane & 15;
    const bool lat = u < 4096; int b, h, r = 0, qb = 0;
    if (lat) { b = u >> 9; h = (u >> 6) & 7; r = u & 63; } else { const int v = u - 4096; b = v >> 5; h = (v >> 2) & 7; qb = v & 3; }
    const int ct = wave & 3, half = wave >> 2;
    const int tokq = lat ? b * 4096 + r * 64 + 16 * ct + c : ML + b * 256 + qb * 64 + 16 * ct + c;
    const bf16_t* P = wsp<bf16_t>(p, WS_P);
    LAS unsigned char* KL = lds; LAS unsigned char* VL = lds + 65536; LAS float* rpbl = (LAS float*)(lds + 131072);
    bf16x8 qf[2];
#pragma unroll
    for (int kk = 0; kk < 2; ++kk) qf[kk] = *(const bf16x8*)(P + (size_t)tokq * NPROJ + PNQ + h * 64 + kk * 32 + g * 8);
    { const int key = tid >> 1, hf = tid & 1; const bf16_t* row = P + (size_t)(ML + b * 256 + key) * NPROJ + h * 64 + hf * 32;
#pragma unroll
      for (int q = 0; q < 4; ++q) { *(LAS u32x4*)(KL + na_koff(key, hf * 4 + q)) = *(const u32x4*)(row + PNK + q * 8); *(LAS u32x4*)(VL + na_koff(key, hf * 4 + q)) = *(const u32x4*)(row + PNV + q * 8); }
      if (lat && tid < 465) rpbl[tid] = SMP(SM_RPB)[((size_t)layer * 8 + h) * 465 + tid]; }
    __syncthreads();
    float m = -1.0e30f, l = 0.f; f32x4 acc[4];
#pragma unroll
    for (int db = 0; db < 4; ++db) acc[db] = (f32x4){0.f, 0.f, 0.f, 0.f};
#define NA_STEP(KEYA, KEYB, MASKED) do { \
        f32x4 sA = (f32x4){0.f, 0.f, 0.f, 0.f}, sB = sA; \
        _Pragma("unroll") for (int kk = 0; kk < 2; ++kk) { sA = MFMA16(*(const LAS bf16x8*)(KL + na_koff((KEYA) + c, kk * 4 + g)), qf[kk], sA); sB = MFMA16(*(const LAS bf16x8*)(KL + na_koff((KEYB) + c, kk * 4 + g)), qf[kk], sB); } \
        float xa[4], xb[4]; float mx = -1.0e30f; \
        _Pragma("unroll") for (int i = 0; i < 4; ++i) { xa[i] = sA[i]; xb[i] = sB[i]; if (MASKED) { const int kcA = c0 + 4 * g + i, kcB = kcA + 16; \
            xa[i] = (kcA >= cs && kcA < cs + 16) ? xa[i] + rpbl[brow + (kcA - qc + 15)] : -1.0e30f; xb[i] = (kcB >= cs && kcB < cs + 16) ? xb[i] + rpbl[brow + (kcB - qc + 15)] : -1.0e30f; } \
            mx = fmaxf(mx, fmaxf(xa[i], xb[i])); } \
        mx = fmaxf(mx, __shfl_xor(mx, 16)); mx = fmaxf(mx, __shfl_xor(mx, 32)); \
        const float mn = fmaxf(m, mx), al = __expf(m - mn); m = mn; float ps = 0.f; \
        _Pragma("unroll") for (int i = 0; i < 4; ++i) { xa[i] = __expf(xa[i] - mn); xb[i] = __expf(xb[i] - mn); ps += xa[i] + xb[i]; } \
        l = l * al + ps; const bf16x8 pf = pack_frag(xa, xb); \
        _Pragma("unroll") for (int db = 0; db < 4; ++db) { const int ka = (KEYA) + 4 * g + (c >> 2), kb2 = (KEYB) + 4 * g + (c >> 2), chk = 2 * db + ((c & 3) >> 1), by = 8 * (c & 1); \
            acc[db] = MFMA16(tr_frag(VL, na_koff(ka, chk) + by, na_koff(kb2, chk) + by), pf, acc[db] * al); } \
    } while (0)
    { const int c0 = 0, cs = 0, qc = 0, brow = 0; (void)c0; (void)cs; (void)qc; (void)brow;
#pragma unroll 1
      for (int st = 0; st < 4; ++st) { const int k0 = 128 * half + 32 * st; NA_STEP(k0, k0 + 16, false); } }
    __syncthreads();
    if (lat) {
        const int rs = min(max(r - 4, 0), 56);
        { const int key = tid; const bf16_t* row = P + (size_t)(b * 4096 + (rs + (key >> 6)) * 64 + (key & 63)) * NPROJ + h * 64;
#pragma unroll
          for (int q = 0; q < 8; ++q) { *(LAS u32x4*)(KL + na_koff(key, q)) = *(const u32x4*)(row + PNK + q * 8); *(LAS u32x4*)(VL + na_koff(key, q)) = *(const u32x4*)(row + PNV + q * 8); } }
        __syncthreads();
        const int c0 = ct == 0 ? 0 : ct == 1 ? 8 : ct == 2 ? 24 : 32, qc = 16 * ct + c, cs = min(max(qc - 8, 0), 48);
#pragma unroll 1
        for (int st = 0; st < 4; ++st) { const int rr = 4 * half + st; const int brow = (rs + rr - r + 7) * 31; const int k0 = rr * 64 + c0; NA_STEP(k0, k0 + 16, true); }
        __syncthreads();
    }
#undef NA_STEP
    l += __shfl_xor(l, 16); l += __shfl_xor(l, 32);
    LAS float* X = (LAS float*)lds + (ct * 64 + lane) * 20;
    if (half == 1) { X[0] = m; X[1] = l;
#pragma unroll
        for (int db = 0; db < 4; ++db) *(LAS f32x4*)(X + 4 + 4 * db) = acc[db]; }
    __syncthreads();
    if (half == 0) { const float m1 = X[0], l1 = X[1]; const float mn = fmaxf(m, m1), e0 = __expf(m - mn), e1 = __expf(m1 - mn); const float inv = 1.0f / (l * e0 + l1 * e1);
#pragma unroll
        for (int db = 0; db < 4; ++db) { const f32x4 o = (acc[db] * e0 + *(const LAS f32x4*)(X + 4 + 4 * db) * e1) * inv;
            *(u32x2*)(wsp<bf16_t>(p, WS_ABC) + (size_t)tokq * 1536 + 512 + h * 64 + 16 * db + 4 * g) = (u32x2){cvt_pk_bf16(o[0], o[1]), cvt_pk_bf16(o[2], o[3])}; } }
    __syncthreads();
}

DI void sgu_unit(const Params& p, int layer, int u, LAS unsigned char* lds) {
    const int tid = ltid(), lane = tid & 63, wave = __builtin_amdgcn_readfirstlane(tid >> 6), g = lane >> 4, c = lane & 15;
    const int g4 = u & 3, n = (u >> 2) % 34, b = (u >> 2) / 34;
    const int tok0 = n < 32 ? b * 4096 + n * 128 : ML + b * 256 + (n - 32) * 128;
    constexpr int RS = 272;
    LAS unsigned char* vn = lds; LAS unsigned char* Wl = lds + 128 * RS; LAS float* st = (LAS float*)(lds + 256 * RS);
    const bf16_t* P = wsp<bf16_t>(p, WS_P);
#pragma unroll 1
    for (int i = 0; i < 16; ++i) { const int pp = wave * 16 + i; const u32x4 w = *(const u32x4*)(P + (size_t)(tok0 + pp) * NPROJ + PSV + lane * 8);
        const float x[8] = {bflo(w[0]), bfhi(w[0]), bflo(w[1]), bfhi(w[1]), bflo(w[2]), bfhi(w[2]), bflo(w[3]), bfhi(w[3])}; float s = 0.f;
#pragma unroll
        for (int e = 0; e < 8; ++e) s += x[e];
        const float mean = wave_sum(s) * (1.0f / 512.0f); float q = 0.f;
#pragma unroll
        for (int e = 0; e < 8; ++e) q += (x[e] - mean) * (x[e] - mean);
        const float rstd = 1.0f / sqrtf(wave_sum(q) * (1.0f / 512.0f) + LN_EPS);
        if (lane == 0) { st[pp * 2] = mean; st[pp * 2 + 1] = rstd; } }
    __syncthreads();
    { const int pp = tid >> 2, pc = tid & 3; const float mean = st[pp * 2], rstd = st[pp * 2 + 1];
      const float* lg = SMP(SM_SGLNG) + (size_t)layer * 512 + g4 * 128 + pc * 32; const float* lb = SMP(SM_SGLNB) + (size_t)layer * 512 + g4 * 128 + pc * 32;
      const bf16_t* src = P + (size_t)(tok0 + pp) * NPROJ + PSV + g4 * 128 + pc * 32;
      const float* wsrc = SMP(SM_SGW) + (((size_t)layer * 4 + g4) * 128 + pp) * 128 + pc * 32;
#pragma unroll
      for (int q = 0; q < 4; ++q) { const u32x4 w = *(const u32x4*)(src + q * 8); const f32x4 g0 = *(const f32x4*)(lg + q * 8), g1 = *(const f32x4*)(lg + q * 8 + 4), b0 = *(const f32x4*)(lb + q * 8), b1 = *(const f32x4*)(lb + q * 8 + 4);
          const f32x4 x0 = ((f32x4){bflo(w[0]), bfhi(w[0]), bflo(w[1]), bfhi(w[1])} - mean) * rstd * g0 + b0, x1 = ((f32x4){bflo(w[2]), bfhi(w[2]), bflo(w[3]), bfhi(w[3])} - mean) * rstd * g1 + b1;
          *(LAS u32x4*)(vn + pp * RS + pc * 64 + q * 16) = pack8(x0, x1);
          const f32x4 w0 = *(const f32x4*)(wsrc + q * 8), w1 = *(const f32x4*)(wsrc + q * 8 + 4); *(LAS u32x4*)(Wl + pp * RS + pc * 64 + q * 16) = pack8(w0, w1); } }
    __syncthreads();
    bf16x8 wf[4];
#pragma unroll
    for (int kk = 0; kk < 4; ++kk) wf[kk] = *(const LAS bf16x8*)(Wl + (16 * wave + c) * RS + (kk * 32 + g * 8) * 2);
    const size_t tok = (size_t)(tok0 + 16 * wave + c); const float bs = SMP(SM_SGB)[((size_t)layer * 4 + g4) * 128 + 16 * wave + c];
#pragma unroll
    for (int cb = 0; cb < 8; ++cb) { f32x4 acc = (f32x4){0.f, 0.f, 0.f, 0.f};
#pragma unroll
        for (int kk = 0; kk < 4; ++kk) { const int o = (32 * kk + 8 * g + (c >> 2)) * RS + (16 * cb + 4 * (c & 3)) * 2; acc = MFMA16(tr_frag(vn, o, o + 4 * RS), wf[kk], acc); }
        const u32x2 uw = *(const u32x2*)(P + tok * NPROJ + PSU + g4 * 128 + 16 * cb + 4 * g);
        const f32x4 o = (f32x4){bflo(uw[0]), bfhi(uw[0]), bflo(uw[1]), bfhi(uw[1])} * (acc + bs);
        *(u32x2*)(wsp<bf16_t>(p, WS_ABC) + tok * 1536 + 1024 + g4 * 128 + 16 * cb + 4 * g) = (u32x2){cvt_pk_bf16(o[0], o[1]), cvt_pk_bf16(o[2], o[3])}; }
    __syncthreads();
}

DI void mlstm_u_unit_naive(const Params& p, int u, LAS unsigned char* lds) {
    const int tid = ltid(), ch = u / (NSLOT - 1), j = u % (NSLOT - 1), dir = ch >> 5, b = (ch >> 2) & 7, h = ch & 3;
    LAS float* Vs = (LAS float*)lds; LAS float* Ks = Vs + 64 * 128;
    const float mj = chain_m(p, ch, j);
    const float Mend = fmaxf(mj, wsp<float>(p, WS_GCM)[((size_t)ch * NSLOT + j) * 64 + 63]);
    const bf16_t* P = wsp<bf16_t>(p, WS_P);
    for (int i = tid; i < 64 * 128; i += 512) { const int tau = i >> 7, d = i & 127; const int tok = chain_tok(dir, b, j, tau);
        const float w = __expf(wsp<float>(p, WS_GA)[((size_t)ch * NSLOT + j) * 64 + tau] - Mend);
        Vs[i] = bf2f(P[(size_t)tok * NPROJ + PV + h * 128 + d]); Ks[i] = w * bf2f(P[(size_t)tok * NPROJ + PK + h * 128 + d]); }
    __syncthreads();
    { const int v = tid >> 2, d0 = (tid & 3) * 32; float acc[32];
#pragma unroll
      for (int i = 0; i < 32; ++i) acc[i] = 0.f;
      for (int tau = 0; tau < 64; ++tau) { const float vv = Vs[tau * 128 + v];
#pragma unroll
          for (int i = 0; i < 32; ++i) acc[i] += vv * Ks[tau * 128 + d0 + i]; }
      bf16_t* dst = wsp<bf16_t>(p, WS_UC) + (((size_t)ch * NSLOT + j) * 128 + v) * 128 + d0;
#pragma unroll
      for (int i = 0; i < 32; i += 2) *(unsigned*)(dst + i) = pk2(acc[i], acc[i + 1]); }
    if (tid < 128) { float s = 0.f; for (int tau = 0; tau < 64; ++tau) s += Ks[tau * 128 + tid]; wsp<float>(p, WS_UN)[((size_t)ch * NSLOT + j) * 128 + tid] = s; }
    __syncthreads();
}
DI void mlstm_h_unit_naive(const Params& p, int layer, int u, LAS unsigned char* lds) {
    const int tid = ltid(), b = u / (4 * 68), h = (u / 68) & 3, cc = u % 68;
    const bool isctx = cc < 4; const int ck = isctx ? cc : cc - 4;
    const int tok0 = isctx ? ML + b * 256 + ck * 64 : b * 4096 + ck * 64;
    LAS float* Qs = (LAS float*)lds; LAS float* Ks = Qs + 64 * 129; LAS float* Vs = Ks + 64 * 129;
    LAS float* Ss = Vs + 64 * 129;
    LAS float* aux = Ss + 64 * 65;
    const bf16_t* P = wsp<bf16_t>(p, WS_P);
    for (int i = tid; i < 64 * 128; i += 512) { const int t = i >> 7, d = i & 127; const size_t o = (size_t)(tok0 + t) * NPROJ + h * 128 + d;
        Qs[t * 129 + d] = bf2f(P[o + PQ]); Ks[t * 129 + d] = bf2f(P[o + PK]); Vs[t * 129 + d] = bf2f(P[o + PV]); }
    __syncthreads();
    float hacc[16];
#pragma unroll
    for (int i = 0; i < 16; ++i) hacc[i] = 0.f;
    const int t = tid >> 3, sg = tid & 7, v0 = sg * 16;
    for (int dir = 0; dir < 2; ++dir) {
        const int ch = (dir * 8 + b) * 4 + h; const int j = dir == 0 ? (isctx ? ck : 4 + ck) : (isctx ? 3 - ck : 67 - ck);
        const float mprev = chain_m(p, ch, j);
        const float* ga = wsp<float>(p, WS_GA) + ((size_t)ch * NSLOT + j) * 64; const float* gcm = wsp<float>(p, WS_GCM) + ((size_t)ch * NSLOT + j) * 64; const float* gbv = wsp<float>(p, WS_GB) + ((size_t)ch * NSLOT + j) * 64;
        const bf16_t* C = wsp<bf16_t>(p, WS_UC) + ((size_t)ch * NSLOT + j) * 16384; const float* nvec = wsp<float>(p, WS_UN) + ((size_t)ch * NSLOT + j) * 128;
        { const int taut = dir ? 63 - t : t; const float Mt = fmaxf(mprev, gcm[taut]);
          for (int s = sg; s < 64; s += 8) { const int taus = dir ? 63 - s : s; float v = 0.f;
              if (taus <= taut) { float dsum = 0.f; for (int d = 0; d < 128; ++d) dsum += Qs[t * 129 + d] * Ks[s * 129 + d]; v = dsum * __expf(ga[taus] - Mt); }
              Ss[t * 65 + s] = v; }
          if (sg == 0) { float dn = 0.f; for (int d = 0; d < 128; ++d) dn += Qs[t * 129 + d] * nvec[d]; aux[t] = __expf(mprev - Mt); aux[64 + t] = dn; aux[128 + t] = __expf(-(gbv[taut] + Mt)); } }
        __syncthreads();
        { const float wi = aux[t];
          float den = wi * aux[64 + t]; for (int s = 0; s < 64; ++s) den += Ss[t * 65 + s];
          const float dd = fmaxf(fabsf(den), aux[128 + t]);
#pragma unroll 1
          for (int vv = 0; vv < 16; ++vv) { const int v = v0 + vv; float num = 0.f;
              for (int s = 0; s < 64; ++s) num += Ss[t * 65 + s] * Vs[s * 129 + v];
              float cq = 0.f; const u32x4* cr = (const u32x4*)(C + (size_t)v * 128);
              for (int d8 = 0; d8 < 16; ++d8) { const u32x4 w = cr[d8]; const LAS float* qq = Qs + t * 129 + d8 * 8;
                  cq += bflo(w[0]) * qq[0] + bfhi(w[0]) * qq[1] + bflo(w[1]) * qq[2] + bfhi(w[1]) * qq[3] + bflo(w[2]) * qq[4] + bfhi(w[2]) * qq[5] + bflo(w[3]) * qq[6] + bfhi(w[3]) * qq[7]; }
              const float val = (num + wi * cq) / dd;
#pragma unroll
              for (int k = 0; k < 16; ++k) if (k == vv) hacc[k] += val; } }
        __syncthreads();
    }
    { float s = 0.f;
#pragma unroll
      for (int i = 0; i < 16; ++i) s += hacc[i];
      s += __shfl_xor(s, 1); s += __shfl_xor(s, 2); s += __shfl_xor(s, 4);
      const float mean = s * (1.0f / 128.0f); float q = 0.f;
#pragma unroll
      for (int i = 0; i < 16; ++i) { const float d = hacc[i] - mean; q += d * d; }
      q += __shfl_xor(q, 1); q += __shfl_xor(q, 2); q += __shfl_xor(q, 4);
      const float rstd = 1.0f / sqrtf(q * (1.0f / 128.0f) + LN_EPS);
      const size_t tok = (size_t)(tok0 + t); const float* ng = SMP(SM_NORMG) + (size_t)layer * 512 + h * 128 + v0;
      const u32x4* op = (const u32x4*)(P + tok * NPROJ + PO + h * 128 + v0); const u32x4 o0 = op[0], o1 = op[1];
      const float og[16] = {bflo(o0[0]), bfhi(o0[0]), bflo(o0[1]), bfhi(o0[1]), bflo(o0[2]), bfhi(o0[2]), bflo(o0[3]), bfhi(o0[3]), bflo(o1[0]), bfhi(o1[0]), bflo(o1[1]), bfhi(o1[1]), bflo(o1[2]), bfhi(o1[2]), bflo(o1[3]), bfhi(o1[3])};
      float r[16];
#pragma unroll
      for (int i = 0; i < 16; ++i) r[i] = (hacc[i] - mean) * rstd * ng[i] * og[i];
      u32x4* dst = (u32x4*)(wsp<bf16_t>(p, WS_ABC) + tok * 1536 + h * 128 + v0);
      dst[0] = (u32x4){pk2(r[0], r[1]), pk2(r[2], r[3]), pk2(r[4], r[5]), pk2(r[6], r[7])}; dst[1] = (u32x4){pk2(r[8], r[9]), pk2(r[10], r[11]), pk2(r[12], r[13]), pk2(r[14], r[15])}; }
    __syncthreads();
}

DI void na_task(const Params& p, int layer, int task, LAS float* ws  ) {
    const int lane = ltid() & 63; const int row = task >> 3, hd = task & 7;
    const bf16_t* P = wsp<bf16_t>(p, WS_P);
    const bool latent = row < ML; const int b = latent ? row >> 12 : (row - ML) >> 8;
    ws[lane] = bf2f(P[(size_t)row * NPROJ + PNQ + hd * 64 + lane]);
    asm volatile("s_waitcnt lgkmcnt(0)" ::: "memory");
    int r = 0, qc = 0, rs = 0, cs = 0;
    if (latent) { const int t = row & 4095; r = t >> 6; qc = t & 63; rs = min(max(r - 4, 0), 56); cs = min(max(qc - 8, 0), 48); }
    const int nkeys = latent ? 384 : 256;
    float sc[6]; float mx = -3.0e38f;
#pragma unroll
    for (int i = 0; i < 6; ++i) { const int kk = lane + 64 * i; sc[i] = -3.0e38f;
        if (kk < nkeys) { int krow; float bias = 0.f;
            if (latent && kk < 128) { const int kr = rs + (kk >> 4), kc = cs + (kk & 15); krow = b * 4096 + kr * 64 + kc; bias = SMP(SM_RPB)[(((size_t)layer * 8 + hd) * 15 + (kr - r + 7)) * 31 + (kc - qc + 15)]; }
            else krow = ML + b * 256 + (latent ? kk - 128 : kk);
            const u32x4* kp = (const u32x4*)(P + (size_t)krow * NPROJ + PNK + hd * 64); float s = 0.f;
#pragma unroll
            for (int c8 = 0; c8 < 8; ++c8) { const u32x4 w = kp[c8];
#pragma unroll
                for (int e = 0; e < 4; ++e) s += bflo(w[e]) * ws[c8 * 8 + 2 * e] + bfhi(w[e]) * ws[c8 * 8 + 2 * e + 1]; }
            sc[i] = s + bias; mx = fmaxf(mx, sc[i]); } }
    mx = wave_max(mx); float sum = 0.f;
#pragma unroll
    for (int i = 0; i < 6; ++i) { const int kk = lane + 64 * i; if (kk < nkeys) { const float e = __expf(sc[i] - mx); sum += e; ws[64 + kk] = e; } }
    sum = wave_sum(sum);
    asm volatile("s_waitcnt lgkmcnt(0)" ::: "memory");
    float o = 0.f;
    for (int kk = 0; kk < nkeys; ++kk) { int krow;
        if (latent && kk < 128) krow = b * 4096 + (rs + (kk >> 4)) * 64 + cs + (kk & 15); else krow = ML + b * 256 + (latent ? kk - 128 : kk);
        o += ws[64 + kk] * bf2f(P[(size_t)krow * NPROJ + PNV + hd * 64 + lane]); }
    wsp<bf16_t>(p, WS_ABC)[(size_t)row * 1536 + 512 + hd * 64 + lane] = (bf16_t)f2bf(o / sum);
}

DI void sgu_unit_naive(const Params& p, int layer, int u, LAS unsigned char* lds) {
    const int tid = ltid(), lane = tid & 63, wave = tid >> 6;
    const int g = u & 3, n = (u >> 2) % 34, b = (u >> 2) / 34;
    const int tok0 = n < 32 ? b * 4096 + n * 128 : ML + b * 256 + (n - 32) * 128;
    LAS float* vn = (LAS float*)lds;
    LAS float* wsm = vn + 128 * 128;
    LAS float* st = wsm + 128 * 129;
    const bf16_t* P = wsp<bf16_t>(p, WS_P);
    for (int i = 0; i < 16; ++i) { const int pp = wave * 16 + i; const u32x4 w = *(const u32x4*)(P + (size_t)(tok0 + pp) * NPROJ + PSV + lane * 8);
        const float x[8] = {bflo(w[0]), bfhi(w[0]), bflo(w[1]), bfhi(w[1]), bflo(w[2]), bfhi(w[2]), bflo(w[3]), bfhi(w[3])}; float s = 0.f;
#pragma unroll
        for (int e = 0; e < 8; ++e) s += x[e];
        const float mean = wave_sum(s) * (1.0f / 512.0f); float q = 0.f;
#pragma unroll
        for (int e = 0; e < 8; ++e) q += (x[e] - mean) * (x[e] - mean);
        const float rstd = 1.0f / sqrtf(wave_sum(q) * (1.0f / 512.0f) + LN_EPS);
        if (lane == 0) { st[pp * 2] = mean; st[pp * 2 + 1] = rstd; } }
    __syncthreads();
    const float* lg = SMP(SM_SGLNG) + (size_t)layer * 512 + g * 128; const float* lb = SMP(SM_SGLNB) + (size_t)layer * 512 + g * 128;
    for (int i = tid; i < 128 * 128; i += 512) { const int pp = i >> 7, c = i & 127;
        vn[i] = (bf2f(P[(size_t)(tok0 + pp) * NPROJ + PSV + g * 128 + c]) - st[pp * 2]) * st[pp * 2 + 1] * lg[c] + lb[c];
        wsm[pp * 129 + c] = SMP(SM_SGW)[(((size_t)layer * 4 + g) * 128 + pp) * 128 + c]; }
    __syncthreads();
    { const int q = tid >> 2, c0 = (tid & 3) * 32; float acc[32];
#pragma unroll
      for (int i = 0; i < 32; ++i) acc[i] = 0.f;
      for (int pp = 0; pp < 128; ++pp) { const float w = wsm[q * 129 + pp];
#pragma unroll
          for (int i = 0; i < 32; ++i) acc[i] += w * vn[pp * 128 + c0 + i]; }
      const float bs = SMP(SM_SGB)[((size_t)layer * 4 + g) * 128 + q];
      const size_t tok = (size_t)(tok0 + q);
#pragma unroll
      for (int i = 0; i < 32; i += 2) { const unsigned uu = *(const unsigned*)(P + tok * NPROJ + PSU + g * 128 + c0 + i);
          *(unsigned*)(wsp<bf16_t>(p, WS_ABC) + tok * 1536 + 1024 + g * 128 + c0 + i) = pk2(bflo(uu) * (acc[i] + bs), bfhi(uu) * (acc[i + 1] + bs)); } }
    __syncthreads();
}


#ifndef MF_U
#define MF_U 1
#endif
#ifndef MF_H
#define MF_H 1
#endif
#ifndef MF_NA
#define MF_NA 1
#endif
#ifndef MF_SGU
#define MF_SGU 1
#endif
DI void phase_mix1(const Params& p, int layer, LAS unsigned char* lds) {
    const int G = lgdim(), blk = lbid();
#pragma unroll 1
    for (int u = blk; u < NCHAIN * (NSLOT - 1); u += G) { if (MF_U) mlstm_u_unit(p, u, lds); else mlstm_u_unit_naive(p, u, lds); }
#pragma unroll 1
    for (int u = blk; u < NB * 34 * 4; u += G) { if (MF_SGU) sgu_unit(p, layer, u, lds); else sgu_unit_naive(p, layer, u, lds); }
    if (MF_NA) {
        const int nna = layer == DEPTH - 1 ? 4096 : 4352;
#pragma unroll 1
        for (int u = blk; u < nna; u += G) na_unit(p, layer, u, lds);
    } else { const int wave = ltid() >> 6; LAS float* ws = (LAS float*)lds + wave * 512;
#pragma unroll 1
        for (int t = blk * 8 + wave; t < MT * 8; t += G * 8) na_task(p, layer, t, ws); }
}
DI void phase_mix3(const Params& p, int layer, LAS unsigned char* lds) {
#pragma unroll 1
    for (int u = lbid(); u < NB * 4 * 68; u += lgdim()) { if (MF_H) mlstm_h_unit(p, layer, u, lds); else mlstm_h_unit_naive(p, layer, u, lds); }
}
constexpr int NPH = 2 + 11 * DEPTH;
#ifndef REP_PRO
#define REP_PRO 1
#endif
#ifndef REP_GEMM
#define REP_GEMM 1
#endif
#ifndef REP_MIX1
#define REP_MIX1 1
#endif
#ifndef REP_MIX3
#define REP_MIX3 1
#endif
#define RUN(rep, call) do { _Pragma("unroll 1") for (int r_ = 0; r_ < (rep); ++r_) { call; } } while (0)
__global__ void __launch_bounds__(512, 2) fwd(Params p) {
    extern __shared__ __attribute__((aligned(16))) unsigned char lds_raw[];
    LAS unsigned char* lds = (LAS unsigned char*)lds_raw;
    volatile LAS unsigned* misc = (volatile LAS unsigned*)(lds + LDS_MISC);
    if (threadIdx.x < 64) misc[threadIdx.x] = 0u;
    __syncthreads();
    XcdBarrier bar = xcd_barrier_post(wsp<unsigned>(p, WS_CTL) + CW_BAR + p.li * XCD_BAR_WORDS, misc);
    const int lo = p.ph_lo, hi = p.ph_hi;
#define IN(k) (lo <= (k) && (k) < hi)
#define LP ({ Params q_ = p; asm volatile("" : "+s"(q_.ws), "+s"(q_.out)); q_; })
#define SEAM(k) do { if (IN(k) && IN((k) + 1)) { XcdBarrier b2_ = bar; asm volatile("" : "+s"(b2_.bar), "+s"(b2_.x)); xcd_barrier(b2_); } } while (0)
    if (IN(0)) RUN(REP_PRO, phase_prologue_a(LP, lds));
    SEAM(0);
    if (IN(1)) phase_init(LP, lds);
    SEAM(1);
    for (int L = 0; L < DEPTH; ++L) {
        const int b = 2 + 11 * L;
        if (IN(b + 0)) { phase_gates(LP, L); RUN(REP_GEMM, phase_inproj(LP, L, lds)); }
        SEAM(b + 0);
        if (IN(b + 1)) RUN(REP_MIX1, phase_mix1(LP, L, lds));
        SEAM(b + 1);
        if (IN(b + 2)) phase_scan(LP);
        SEAM(b + 2);
        if (IN(b + 3)) RUN(REP_MIX3, phase_mix3(LP, L, lds));
        SEAM(b + 3);
        if (IN(b + 4)) RUN(REP_GEMM, phase_merge(LP, L, lds));
        SEAM(b + 4);
        if (IN(b + 5)) RUN(REP_GEMM, phase_outproj(LP, L, lds));
        SEAM(b + 5);
        if (IN(b + 6)) phase_ln1_router(LP, L, lds);
        SEAM(b + 6);
        if (IN(b + 7)) phase_scatter(LP, L, lds);
        SEAM(b + 7);
        if (IN(b + 8)) RUN(REP_GEMM, phase_moe_gu(LP, L, lds));
        SEAM(b + 8);
        if (IN(b + 9)) RUN(REP_GEMM, phase_moe_dn(LP, L, lds));
        SEAM(b + 9);
        if (IN(b + 10)) phase_ln2(LP, L, lds);
        SEAM(b + 10);
    }
#undef IN
#undef SEAM
}

#ifndef N_LAUNCH_MODE
#define N_LAUNCH_MODE 1
#endif
extern "C" void kernel_launch(void* const* d_in, const int* in_sizes, int n_in, void* d_out, int out_size, void* d_ws, size_t ws_size, hipStream_t stream) {
    static int grid = 0;
    if (grid == 0) {
        if (n_in != 26 || ws_size < WS_END) { fprintf(stderr, "kernel_launch: expected 26 inputs and >= %zu bytes of workspace (got %d, %zu)\n", (size_t)WS_END, n_in, ws_size); grid = -1; return; }
        int dev = 0, cus = 0, per_cu = 0;
        if (hipGetDevice(&dev) != hipSuccess || hipDeviceGetAttribute(&cus, hipDeviceAttributeMultiprocessorCount, dev) != hipSuccess) { grid = -1; return; }
        if (hipFuncSetAttribute((const void*)fwd, hipFuncAttributeMaxDynamicSharedMemorySize, LDS_BYTES) != hipSuccess) { fprintf(stderr, "kernel_launch: hipFuncSetAttribute failed\n"); grid = -1; return; }
        if (hipOccupancyMaxActiveBlocksPerMultiprocessor(&per_cu, (const void*)fwd, 512, LDS_BYTES) != hipSuccess || per_cu < 1) fprintf(stderr, "kernel_launch: occupancy query reports %d\n", per_cu);
        (void)hipGetLastError();
        grid = cus;
        if (grid != 256) fprintf(stderr, "kernel_launch: %d CUs; the row phases assume 256 workgroups\n", grid);
        grid = 256;
    }
    if (grid < 0) return;
    (void)hipMemsetAsync((char*)d_ws + WS_CTL, 0, CTL_BYTES, stream);
    Params p{};
    const float** pf = (const float**)&p;
    for (int i = 0; i < 26; ++i) pf[i] = (const float*)d_in[i];
    p.out = (float*)d_out; p.ws = (unsigned char*)d_ws;
#if N_LAUNCH_MODE == 1
    p.ph_lo = 0; p.ph_hi = NPH; p.li = 0; p.pad = 0;
    hipLaunchKernelGGL(fwd, dim3(grid), dim3(512), LDS_BYTES, stream, p);
#else
    for (int ph = 0; ph < NPH; ++ph) { p.ph_lo = ph; p.ph_hi = ph + 1; p.li = 0; p.pad = 0; hipLaunchKernelGGL(fwd, dim3(grid), dim3(512), LDS_BYTES, stream, p); }
#endif
    const hipError_t le = hipPeekAtLastError();
    if (le != hipSuccess) fprintf(stderr, "kernel_launch: launch failed: %s\n", hipGetErrorName(le));
}
```

```cpp
#include <hip/hip_runtime.h>
#include <cstdio>
#include <cstdint>

#define LAS __attribute__((address_space(3)))
typedef unsigned short bf16_t;
typedef short bf16x8 __attribute__((ext_vector_type(8)));
typedef short s16x4 __attribute__((ext_vector_type(4)));
typedef float f32x4 __attribute__((ext_vector_type(4)));
typedef float f32x2 __attribute__((ext_vector_type(2)));
typedef unsigned u32x4 __attribute__((ext_vector_type(4)));
typedef unsigned u32x2 __attribute__((ext_vector_type(2)));
#define DI __device__ __forceinline__

constexpr int D = 1024, NB = 8, SEQ = 4096, NCTX = 256, ML = NB * SEQ, MC = NB * NCTX, MT = ML + MC, DEPTH = 4;
constexpr int NPROJ = 7680, DIN = 7696, NEXP = 32, TOPK = 4;
constexpr int NROWS_MAX = (MT * TOPK / 256 + NEXP) * 256;
constexpr int NCHAIN = 2 * NB * 4, NSLOT = 68;
constexpr float LN_EPS = 1e-5f;
constexpr float DN_ALPHA = 1.6817928305074290f;
constexpr int PQ = 0, PK = 512, PV = 1024, PO = 1536, PNQ = 2048, PNK = 2560, PNV = 3072, PSU = 3584, PSV = 4096, PBG = 4608;

constexpr size_t al256(size_t x) { return (x + 255) & ~(size_t)255; }
constexpr size_t WS_CTL = 0, CTL_BYTES = 65536;
constexpr size_t WS_MOD = WS_CTL + CTL_BYTES;
constexpr size_t WS_ROPE = al256(WS_MOD + (size_t)4 * 9 * 6144 * 4);
constexpr size_t WS_WGATE = al256(WS_ROPE + 64 * 32 * 8);
constexpr size_t WS_WIN = al256(WS_WGATE + (size_t)4 * 16 * 1024 * 4);
constexpr size_t WS_WBR = al256(WS_WIN + (size_t)4 * NPROJ * 1024 * 2);
constexpr size_t WS_WOUT = al256(WS_WBR + (size_t)4 * 3 * 1024 * 512 * 2);
constexpr size_t WS_WGU = al256(WS_WOUT + (size_t)4 * 1024 * 1024 * 2);
constexpr size_t WS_WDN = al256(WS_WGU + (size_t)4 * 32 * 2048 * 1024 * 2);
constexpr size_t WS_X = al256(WS_WDN + (size_t)4 * 32 * 1024 * 1024 * 2);
constexpr size_t WS_H = al256(WS_X + (size_t)MT * D * 4);
constexpr size_t WS_H2 = al256(WS_H + (size_t)MT * D * 2);
constexpr size_t WS_P = al256(WS_H2 + (size_t)MT * D * 2);
constexpr size_t WS_GPRE = al256(WS_P + (size_t)MT * NPROJ * 2);
constexpr size_t WS_GA = al256(WS_GPRE + (size_t)MT * 16 * 4);
constexpr size_t WS_GCM = al256(WS_GA + (size_t)NCHAIN * NSLOT * 64 * 4);
constexpr size_t WS_GB = al256(WS_GCM + (size_t)NCHAIN * NSLOT * 64 * 4);
constexpr size_t WS_UC = al256(WS_GB + (size_t)NCHAIN * NSLOT * 64 * 4);
constexpr size_t WS_UN = al256(WS_UC + (size_t)NCHAIN * NSLOT * 128 * 128 * 2);
constexpr size_t WS_ABC = al256(WS_UN + (size_t)NCHAIN * NSLOT * 128 * 4);
constexpr size_t WS_MRG = al256(WS_ABC + (size_t)MT * 1536 * 2);
constexpr size_t WS_Y = al256(WS_MRG + (size_t)MT * D * 2);
constexpr size_t WS_TOPE = al256(WS_Y + (size_t)MT * D * 2);
constexpr size_t WS_TOPG = al256(WS_TOPE + (size_t)MT * 16);
constexpr size_t WS_TOPR = al256(WS_TOPG + (size_t)MT * 16);
constexpr size_t WS_DEST = al256(WS_TOPR + (size_t)MT * 16);
constexpr size_t WS_BASE = al256(WS_DEST + (size_t)MT * 16);
constexpr size_t WS_BLKE = al256(WS_BASE + 256 * 32 * 4);
constexpr size_t WS_XG = al256(WS_BLKE + 4096);
constexpr size_t WS_ACT = al256(WS_XG + (size_t)NROWS_MAX * D * 2);
constexpr size_t WS_YS = al256(WS_ACT + (size_t)NROWS_MAX * D * 2);
constexpr size_t SM_GBIAS = 0, SM_NORMG = SM_GBIAS + 64, SM_RPB = SM_NORMG + 2048, SM_SGLNG = SM_RPB + 14880, SM_SGLNB = SM_SGLNG + 2048, SM_SGW = SM_SGLNB + 2048, SM_SGB = SM_SGW + 262144,
                 SM_LN1G = SM_SGB + 2048, SM_LN1B = SM_LN1G + 4096, SM_RW = SM_LN1B + 4096, SM_RB = SM_RW + 131072, SM_BGU = SM_RB + 128, SM_BDN = SM_BGU + 262144, SM_LN2G = SM_BDN + 131072,
                 SM_LN2B = SM_LN2G + 4096, SM_END = SM_LN2B + 4096;
constexpr size_t WS_SM = al256(WS_YS + (size_t)NROWS_MAX * D * 2);
constexpr size_t WS_END = al256(WS_SM + SM_END * 4);
constexpr int CW_BAR = 0;
constexpr int CW_CNT = 16000;
static_assert((CW_CNT + 4 * 32) * 4 <= (int)CTL_BYTES, "ctl");

constexpr int LDS_BYTES = 147456;
constexpr int LDS_MISC = 147456 - 256;

DI unsigned f2bf(float f) { unsigned u = __builtin_bit_cast(unsigned, f); return (u + 0x7fffu + ((u >> 16) & 1u)) >> 16; }
DI float bf2f(unsigned b) { return __builtin_bit_cast(float, (b & 0xffffu) << 16); }
DI float bflo(unsigned w) { return __builtin_bit_cast(float, w << 16); }
DI float bfhi(unsigned w) { return __builtin_bit_cast(float, w & 0xffff0000u); }
typedef __bf16 bf16x2_t __attribute__((ext_vector_type(2)));
DI unsigned cvt_pk_bf16(float lo, float hi) { const f32x2 v = (f32x2){lo, hi}; return __builtin_bit_cast(unsigned, __builtin_convertvector(v, bf16x2_t)); }
DI unsigned pk2(float lo, float hi) { return cvt_pk_bf16(lo, hi); }
DI float wave_sum(float v) { for (int o = 32; o >= 1; o >>= 1) v += __shfl_xor(v, o); return v; }
DI float wave_max(float v) { for (int o = 32; o >= 1; o >>= 1) v = fmaxf(v, __shfl_xor(v, o)); return v; }
DI float sigmoidf_(float x) { return __builtin_amdgcn_rcpf(1.0f + __builtin_amdgcn_exp2f(-1.4426950408889634f * x)); }
DI float gelu_tanh(float x) { return x * sigmoidf_(1.5957691216057308f * (x + 0.044715f * x * x * x)); }
DI float log_sigmoid(float x) { return -(fmaxf(-x, 0.0f) + log1pf(expf(-fabsf(x)))); }
__host__ __device__ inline int rope_d(int p) { const int u = p >> 3, e = p & 7; return (u >> 3) * 64 + (e >> 2) * 32 + (u & 7) * 4 + (e & 3); }

DI int ltid() { int t = threadIdx.x; asm volatile("" : "+v"(t)); return t; }
DI int lbid() { int b = blockIdx.x; asm volatile("" : "+s"(b)); return b; }
DI int lgdim() { int g = gridDim.x; asm volatile("" : "+s"(g)); return g; }
template <int N> DI float bfly(float (&v)[N], int lane) {
    int off = 32;
#pragma unroll
    for (int n = N; n > 1; n >>= 1) {
        const unsigned mk = (lane & off) ? 0xffffffffu : 0u;
#pragma unroll
        for (int i = 0; i < n / 2; ++i) { const unsigned a = __builtin_bit_cast(unsigned, v[i]), b = __builtin_bit_cast(unsigned, v[i + n / 2]);
            const float keep = __builtin_bit_cast(float, (a & ~mk) | (b & mk)); const float send = __builtin_bit_cast(float, (b & ~mk) | (a & mk)); v[i] = keep + __shfl_xor(send, off); }
        off >>= 1;
    }
    for (; off >= 1; off >>= 1) v[0] += __shfl_xor(v[0], off);
    return v[0];
}

#define XB_TMO      128
#define XB_XCNT(j)  (256  + 64 * (j))
#define XB_XSUB(j)  (1280 + 64 * (j))
#define XB_XGEN(j)  (2304 + 64 * (j))
#define XB_TOP      3328
#define XB_TOPGEN   3392
#define XCD_BAR_WORDS 3456
#define XB_SPIN_CAP (1u << 22)
DI unsigned xb_ld(unsigned* p)              { return __hip_atomic_load(p, __ATOMIC_RELAXED, __HIP_MEMORY_SCOPE_AGENT); }
DI unsigned xb_add(unsigned* p, unsigned v) { return __hip_atomic_fetch_add(p, v, __ATOMIC_RELAXED, __HIP_MEMORY_SCOPE_AGENT); }
DI unsigned xb_xcc_id() { return (unsigned)__builtin_amdgcn_s_getreg((3 << 11) | 20) & 0xFu; }
#define XB_SPIN(cond, bar) do { unsigned _sp = 0; while (cond) { __builtin_amdgcn_s_sleep(1); \
    if ((++_sp & 255u) == 0u) { if (xb_ld(&(bar)[XB_TMO])) break; if (_sp > XB_SPIN_CAP) { atomicAdd(&(bar)[XB_TMO], 1u); break; } } } } while (0)
struct XcdBarrier { unsigned* bar; unsigned x; volatile LAS unsigned* st; };
DI XcdBarrier xcd_barrier_post(unsigned* bar, volatile LAS unsigned* st) {
    XcdBarrier b; b.bar = bar; b.x = xb_xcc_id(); b.st = st;
    if (threadIdx.x == 0) (void)xb_add(&bar[XB_XCNT(b.x)], 1u);
    return b;
}
DI void xcd_barrier_complete(unsigned* bar, unsigned x, unsigned& nloc, unsigned& nx) {
    const unsigned G = gridDim.x * gridDim.y * gridDim.z;
    unsigned sum, cnt, mine, sp = 0u;
    for (;;) {
        sum = 0u; cnt = 0u; mine = 0u;
#pragma unroll
        for (unsigned j = 0; j < 16; ++j) { const unsigned c = xb_ld(&bar[XB_XCNT(j)]); sum += c; cnt += (c > 0u) ? 1u : 0u; mine = (j == x) ? c : mine; }
        if (sum == G) break;
        __builtin_amdgcn_s_sleep(1);
        if ((++sp & 255u) == 0u) { if (xb_ld(&bar[XB_TMO])) break; if (sp > XB_SPIN_CAP) { atomicAdd(&bar[XB_TMO], 1u); break; } }
    }
    nloc = mine > 0u ? mine : 1u; nx = cnt > 0u ? cnt : 1u;
}
DI void xcd_barrier(const XcdBarrier& b) {
    asm volatile("s_waitcnt vmcnt(0)" ::: "memory");
    __syncthreads();
    if (threadIdx.x == 0) {
        unsigned* bar = b.bar;
        __builtin_amdgcn_s_waitcnt(0);
        unsigned nloc = b.st[0], nx = b.st[1];
        if (nloc == 0u) { xcd_barrier_complete(bar, b.x, nloc, nx); b.st[0] = nloc; b.st[1] = nx; }
        const unsigned old = xb_add(&bar[XB_XSUB(b.x)], 1u);
        const unsigned gen = old / nloc;
        if (old + 1u == (gen + 1u) * nloc) {
            __builtin_amdgcn_fence(__ATOMIC_RELEASE, "agent");
            asm volatile("s_waitcnt vmcnt(0)" ::: "memory");
            const unsigned og = xb_add(&bar[XB_TOP], 1u);
            const unsigned tg = og / nx;
            if (og + 1u == (tg + 1u) * nx) xb_add(&bar[XB_TOPGEN], 1u);
            else XB_SPIN(xb_ld(&bar[XB_TOPGEN]) == tg, bar);
            __builtin_amdgcn_fence(__ATOMIC_ACQUIRE, "agent");
            xb_add(&bar[XB_XGEN(b.x)], 1u);
            asm volatile("s_waitcnt vmcnt(0)" ::: "memory");
        } else {
            XB_SPIN(xb_ld(&bar[XB_XGEN(b.x)]) == gen, bar);
            __builtin_amdgcn_fence(__ATOMIC_ACQUIRE, "agent");
            asm volatile("s_waitcnt vmcnt(0)" ::: "memory");
        }
    }
    __syncthreads();
}
namespace pg8 {
constexpr int BM = 256, BK = 64, HALF = 128, HTB = HALF * BK * 2, STAGE_BYTES = 8 * HTB, NXCD = 8, WGM = 8;
__host__ __device__ __forceinline__ int lds_byte(int r, int c) { const int st = (r >> 4) * 2 + (c >> 5), rr = r & 15, cc = c & 31, ob = rr * 64 + cc * 2; return st * 1024 + (ob ^ (((ob >> 9) & 1) << 5)); }
__host__ __device__ __forceinline__ void stage_rc(int b, int& R, int& C) { const int st = b / 1024, sb = b % 1024, swz = sb ^ (((sb >> 9) & 1) << 5); R = (st >> 1) * 16 + swz / 64; C = (st & 1) * 32 + (swz % 64) / 2; }
__host__ __device__ __forceinline__ int perm32(int rho) { const int n = rho >> 4, i = rho & 15; return 8 * (i >> 2) + 4 * n + (i & 3); }

struct Unit { int pm, pn, aux; };

struct TileOrder {
    int nM, nN, nwg, G, c;
    __device__ void init(int nM_, int nN_, int G_, int c_) { nM = nM_; nN = nN_; nwg = nM * nN; G = G_; c = c_; }
    __device__ bool tile(int i, int& pm, int& pn) const {
        const long L = (long)i * G + c; if (L >= nwg) return false;
        int wgid = (int)L; { const int q = nwg / NXCD, r = nwg % NXCD, xcd = wgid % NXCD, off = wgid / NXCD; wgid = (xcd < r ? xcd * (q + 1) : r * (q + 1) + (xcd - r) * q) + off; }
        const int nig = WGM * nN, gid = wgid / nig, fm = gid * WGM, gsz = (nM - fm) < WGM ? (nM - fm) : WGM;
        pm = fm + ((wgid % nig) % gsz); pn = (wgid % nig) / gsz; return true;
    }
};

template <class Epi, class Sched>
__device__ __forceinline__ void gemm_phase(LAS unsigned char* lds, const int K, const Sched& S, const Epi& E) {
    const int tid = ltid(), wid = __builtin_amdgcn_readfirstlane(tid >> 6), lane = tid & 63, wr = wid >> 2, wc = wid & 3, fr = lane & 15, fq = lane >> 4;
    const int nt = K / BK;
    unsigned voffA[2], voffB[2]; const int lda = S.lda;
#pragma unroll
    for (int i = 0; i < 2; ++i) { int R, C; stage_rc(tid * 16 + i * 8192, R, C); const int Rb = (R & ~31) + perm32(R & 31); voffA[i] = (unsigned)(R * lda + C) * 2u; voffB[i] = (unsigned)(Rb * K + C) * 2u; }
    const size_t kstep = (size_t)(BK * 2);
    const size_t hstep = (size_t)HALF * K * 2;
    const size_t hstepA = (size_t)HALF * lda * 2;
    const unsigned ldsw = (unsigned)wid * 1024u;
    const int aoff = lds_byte(wr * 64 + fr, fq * 8), boff = lds_byte(wc * 32 + fr, fq * 8);
#define PG8_SA(b, h) (((b) * 2 + (h)) * HTB)
#define PG8_SB(b, h) ((4 + (b) * 2 + (h)) * HTB)
#define PG8_STAGE(bufoff, gbase, voff) do { _Pragma("unroll") for (int _i = 0; _i < 2; ++_i) \
        __builtin_amdgcn_global_load_lds((const unsigned*)((const char*)(gbase) + (voff)[_i]), (LAS unsigned*)(lds + (bufoff) + ldsw + _i * 8192), 16, 0, 0); } while (0)
#define PG8_LDA(dst, b, h) do { _Pragma("unroll") for (int m = 0; m < 4; ++m) _Pragma("unroll") for (int k = 0; k < 2; ++k) dst[m][k] = *(const LAS bf16x8*)(lds + PG8_SA(b, h) + aoff + m * 2048 + k * 1024); } while (0)
#define PG8_LDB(dst, b, h) do { _Pragma("unroll") for (int n = 0; n < 2; ++n) _Pragma("unroll") for (int k = 0; k < 2; ++k) dst[n][k] = *(const LAS bf16x8*)(lds + PG8_SB(b, h) + boff + n * 2048 + k * 1024); } while (0)
#define PG8_MMA(ai, bj, At, Bt) do { __builtin_amdgcn_s_setprio(1); _Pragma("unroll") for (int m = 0; m < 4; ++m) _Pragma("unroll") for (int n = 0; n < 2; ++n) _Pragma("unroll") for (int k = 0; k < 2; ++k) \
        acc[ai][bj][m][n] = __builtin_amdgcn_mfma_f32_16x16x32_bf16(Bt[n][k], At[m][k], acc[ai][bj][m][n], 0, 0, 0); __builtin_amdgcn_s_setprio(0); } while (0)
#define PG8_WAIT_V(n) asm volatile("s_waitcnt vmcnt(" #n ")" ::: "memory")
#define PG8_WAIT_L(n) asm volatile("s_waitcnt lgkmcnt(" #n ")" ::: "memory")
#define PG8_BAR __builtin_amdgcn_s_barrier()
#define PG8_SCHED __builtin_amdgcn_sched_barrier(0)
    Unit cur, nxt; int ui = 0;
    if (!S.next(0, cur)) return;
    f32x4 acc[2][2][4][2];
#pragma unroll
    for (int a = 0; a < 2; ++a)
#pragma unroll
        for (int b = 0; b < 2; ++b)
#pragma unroll
            for (int m = 0; m < 4; ++m)
#pragma unroll
                for (int n = 0; n < 2; ++n) acc[a][b][m][n] = (f32x4){0.f, 0.f, 0.f, 0.f};
    bf16x8 At[4][2], B0[2][2], B1[2][2];
    const char* cA = S.a_base(cur); const char* cB = S.b_base(cur);
    PG8_STAGE(PG8_SB(0, 0), cB, voffB); PG8_STAGE(PG8_SB(0, 1), cB + hstep, voffB); PG8_STAGE(PG8_SA(0, 0), cA, voffA); PG8_STAGE(PG8_SA(0, 1), cA + hstepA, voffA);
    if (wr == 1) PG8_BAR;
    PG8_WAIT_V(2); PG8_BAR;
    PG8_STAGE(PG8_SB(1, 0), cB + kstep, voffB); PG8_STAGE(PG8_SA(1, 0), cA + kstep, voffA); PG8_STAGE(PG8_SB(1, 1), cB + hstep + kstep, voffB);
    PG8_WAIT_V(6); PG8_BAR;
    for (;;) {
        const bool has_next = S.next(ui + 1, nxt);
        const char* nA = has_next ? S.a_base(nxt) : cA; const char* nB = has_next ? S.b_base(nxt) : cB;
        for (int t = 0; t < nt; t += 2) {
            const bool last = (t == nt - 2);
            const char* a1 = cA + (size_t)(t + 1) * kstep;
            const char* a2 = last ? nA : cA + (size_t)(t + 2) * kstep; const char* b2 = last ? nB : cB + (size_t)(t + 2) * kstep;
            const char* a3 = a2 + kstep; const char* b3 = b2 + kstep;
            PG8_LDB(B0, 0, 0); PG8_LDB(B1, 0, 1); PG8_SCHED; PG8_LDA(At, 0, 0); PG8_STAGE(PG8_SA(1, 1), a1 + hstepA, voffA);
            PG8_WAIT_V(8); PG8_WAIT_L(0); PG8_BAR; PG8_MMA(0, 0, At, B0); PG8_MMA(0, 1, At, B1); PG8_BAR; PG8_SCHED;
            PG8_LDA(At, 0, 1); PG8_STAGE(PG8_SB(0, 0), b2, voffB); PG8_STAGE(PG8_SB(0, 1), b2 + hstep, voffB); PG8_STAGE(PG8_SA(0, 0), a2, voffA);
            PG8_WAIT_V(8); PG8_WAIT_L(0); PG8_BAR; PG8_MMA(1, 0, At, B0); PG8_MMA(1, 1, At, B1); PG8_BAR; PG8_SCHED;
            PG8_LDB(B0, 1, 0); PG8_LDB(B1, 1, 1); PG8_SCHED; PG8_LDA(At, 1, 0); PG8_STAGE(PG8_SA(0, 1), a2 + hstepA, voffA);
            PG8_WAIT_V(8); PG8_WAIT_L(0); PG8_BAR; PG8_MMA(0, 0, At, B0); PG8_MMA(0, 1, At, B1); PG8_BAR; PG8_SCHED;
            PG8_LDA(At, 1, 1); PG8_STAGE(PG8_SB(1, 0), b3, voffB); PG8_STAGE(PG8_SB(1, 1), b3 + hstep, voffB); PG8_STAGE(PG8_SA(1, 0), a3, voffA);
            PG8_WAIT_V(8); PG8_WAIT_L(0); PG8_BAR; PG8_MMA(1, 0, At, B0); PG8_MMA(1, 1, At, B1); PG8_BAR; PG8_SCHED;
        }
        if (wr == 0) PG8_BAR;
        E(acc, cur, wr, wc, fr, fq);
        if (!has_next) break;
#pragma unroll
        for (int a = 0; a < 2; ++a)
#pragma unroll
            for (int b = 0; b < 2; ++b)
#pragma unroll
                for (int m = 0; m < 4; ++m)
#pragma unroll
                    for (int n = 0; n < 2; ++n) acc[a][b][m][n] = (f32x4){0.f, 0.f, 0.f, 0.f};
        cur = nxt; cA = nA; cB = nB; ++ui;
        if (wr == 1) PG8_BAR;
    }
    PG8_WAIT_V(0);
    PG8_BAR;
#undef PG8_SA
#undef PG8_SB
#undef PG8_STAGE
#undef PG8_LDA
#undef PG8_LDB
#undef PG8_MMA
#undef PG8_WAIT_V
#undef PG8_WAIT_L
#undef PG8_BAR
#undef PG8_SCHED
}
}
struct Params {
    const float *x, *c, *ctx, *c_ctx, *w_mod, *b_mod, *w_in, *gate_bias, *norm_g, *rpb, *sg_ln_g, *sg_ln_b, *sg_w, *sg_b, *w_branch, *w_out,
                *ln1_g, *ln1_b, *router_w, *router_b, *w_gu, *b_gu, *w_dn, *b_dn, *ln2_g, *ln2_b;
    float* out; unsigned char* ws;
    int ph_lo, ph_hi, li, pad;
    size_t z;
};
template <class T> DI T* wsp(const Params& p, size_t off) { return (T*)(p.ws + (off + p.z)); }
#define SMP(o) (wsp<float>(p, WS_SM) + (o))

DI int row_of(int blk, int wave, int i) { return i < 16 ? blk * 128 + wave * 16 + i : ML + blk * 8 + wave; }
DI int bsel_of(int row) { return row < ML ? (row >> 12) : 8; }

template <int MAP> DI int cmap(int n) {
    if (MAP == 1) { if (n < 1024) return (n & ~127) + rope_d(n & 127); return n < 2048 ? n : n + 16; }
    if (MAP == 2) { const int u = n >> 3, e = n & 7; return e < 4 ? 4 * u + e : 1024 + 4 * u + (e - 4); }
    return n;
}
template <int MAP> DI void cvt_tile(const float* src, int ld, bf16_t* dst, int K, int k0, int n0, LAS float* tile) {
    const int tid = ltid();
    { const int kk = tid >> 7, n = tid & 127; const int sc = cmap<MAP>(n0 + n);
#pragma unroll 4
      for (int it = 0; it < 16; ++it) { const int k = it * 4 + kk; tile[k * 129 + n] = src[(size_t)(k0 + k) * ld + sc]; } }
    __syncthreads();
    { const int n = tid >> 2, kc = (tid & 3) * 16; unsigned w[8];
#pragma unroll
      for (int j = 0; j < 8; ++j) w[j] = pk2(tile[(kc + 2 * j) * 129 + n], tile[(kc + 2 * j + 1) * 129 + n]);
      bf16_t* d = dst + (size_t)(n0 + n) * K + k0 + kc;
      *(u32x4*)d = (u32x4){w[0], w[1], w[2], w[3]}; *(u32x4*)(d + 8) = (u32x4){w[4], w[5], w[6], w[7]}; }
    __syncthreads();
}
DI void phase_prologue_a(const Params& p, LAS unsigned char* lds) {
    const int tid = ltid(), G = lgdim(), blk = lbid();
    LAS float* tile = (LAS float*)lds;
    constexpr int T_IN = 4 * 16 * 60, T_BR = 12 * 8 * 8, T_OUT = 4 * 16 * 8, T_GU = 128 * 16 * 16, T_DN = 128 * 16 * 8;
    constexpr int T_ALL = T_IN + T_BR + T_OUT + T_GU + T_DN;
    for (int t = blk; t < T_ALL; t += G) {
        int u = t;
        if (u < T_IN) { const int l = u / 960, r = u % 960; cvt_tile<1>(p.w_in + (size_t)l * 1024 * DIN, DIN, wsp<bf16_t>(p, WS_WIN) + (size_t)l * NPROJ * 1024, 1024, (r / 60) * 64, (r % 60) * 128, tile); continue; }
        u -= T_IN;
        if (u < T_BR) { const int m = u / 64, r = u % 64; cvt_tile<0>(p.w_branch + (size_t)m * 512 * 1024, 1024, wsp<bf16_t>(p, WS_WBR) + (size_t)m * 1024 * 512, 512, (r / 8) * 64, (r % 8) * 128, tile); continue; }
        u -= T_BR;
        if (u < T_OUT) { const int l = u / 128, r = u % 128; cvt_tile<0>(p.w_out + (size_t)l * 1024 * 1024, 1024, wsp<bf16_t>(p, WS_WOUT) + (size_t)l * 1024 * 1024, 1024, (r / 8) * 64, (r % 8) * 128, tile); continue; }
        u -= T_OUT;
        if (u < T_GU) { const int m = u / 256, r = u % 256; cvt_tile<2>(p.w_gu + (size_t)m * 1024 * 2048, 2048, wsp<bf16_t>(p, WS_WGU) + (size_t)m * 2048 * 1024, 1024, (r / 16) * 64, (r % 16) * 128, tile); continue; }
        u -= T_GU;
        { const int m = u / 128, r = u % 128; cvt_tile<0>(p.w_dn + (size_t)m * 1024 * 1024, 1024, wsp<bf16_t>(p, WS_WDN) + (size_t)m * 1024 * 1024, 1024, (r / 8) * 64, (r % 8) * 128, tile); }
    }
    for (int i = blk * 512 + tid; i < 64 * 32; i += G * 512) { const int pos = i >> 5, f = i & 31; const float inv = powf(10000.0f, -(float)f / 32.0f); const float ang = (float)pos * inv;
        wsp<f32x2>(p, WS_ROPE)[i] = (f32x2){cosf(ang), sinf(ang)}; }
    for (int i = blk * 512 + tid; i < 4 * 16 * 1024; i += G * 512) { const int l = i >> 14, g = (i >> 10) & 15, k = i & 1023; wsp<float>(p, WS_WGATE)[i] = p.w_in[((size_t)l * 1024 + k) * DIN + 2048 + g]; }
    { const float* srcs[15] = {p.gate_bias, p.norm_g, p.rpb, p.sg_ln_g, p.sg_ln_b, p.sg_w, p.sg_b, p.ln1_g, p.ln1_b, p.router_w, p.router_b, p.b_gu, p.b_dn, p.ln2_g, p.ln2_b};
      const size_t offs[16] = {SM_GBIAS, SM_NORMG, SM_RPB, SM_SGLNG, SM_SGLNB, SM_SGW, SM_SGB, SM_LN1G, SM_LN1B, SM_RW, SM_RB, SM_BGU, SM_BDN, SM_LN2G, SM_LN2B, SM_END};
      float* dsm = wsp<float>(p, WS_SM);
#pragma unroll
      for (int a = 0; a < 15; ++a) { const int n = (int)(offs[a + 1] - offs[a]); const float* sp = srcs[a]; for (int i = blk * 512 + tid; i < n; i += G * 512) dsm[offs[a] + i] = sp[i]; } }
    LAS float* sl = (LAS float*)lds;
    LAS float* red = sl + 9 * 1024;
    for (int i = tid; i < 9 * 1024; i += 512) { const float v = i < 8192 ? p.c[i] : p.c_ctx[i - 8192]; sl[i] = v / (1.0f + __expf(-v)); }
    __syncthreads();
    for (int u = blk; u < 4 * 96; u += G) {
        const int l = u / 96, c0 = (u % 96) * 64, col = c0 + (tid & 63), kg = tid >> 6;
        float a[9];
#pragma unroll
        for (int b = 0; b < 9; ++b) a[b] = 0.f;
        const float* w = p.w_mod + ((size_t)l * 1024 + kg * 128) * 6144 + col;
#pragma unroll 4
        for (int k = 0; k < 128; ++k) { const float wv = w[(size_t)k * 6144];
#pragma unroll
            for (int b = 0; b < 9; ++b) a[b] += sl[b * 1024 + kg * 128 + k] * wv; }
#pragma unroll
        for (int b = 0; b < 9; ++b) red[(kg * 64 + (tid & 63)) * 9 + b] = a[b];
        __syncthreads();
        for (int i = tid; i < 64 * 9; i += 512) { const int cc = i / 9, b = i % 9; float s = 0.f;
#pragma unroll
            for (int g = 0; g < 8; ++g) s += red[(g * 64 + cc) * 9 + b];
            wsp<float>(p, WS_MOD)[((size_t)l * 9 + b) * 6144 + c0 + cc] = s + p.b_mod[(size_t)l * 6144 + c0 + cc]; }
        __syncthreads();
    }
}

DI void ld_row_f32(const float* p, float (&v)[16], int lane) {
#pragma unroll
    for (int j = 0; j < 4; ++j) { const f32x4 t = *(const f32x4*)(p + 256 * j + 4 * lane); v[4 * j] = t[0]; v[4 * j + 1] = t[1]; v[4 * j + 2] = t[2]; v[4 * j + 3] = t[3]; }
}
DI void st_row_f32(float* p, const float (&v)[16], int lane) {
#pragma unroll
    for (int j = 0; j < 4; ++j) *(f32x4*)(p + 256 * j + 4 * lane) = (f32x4){v[4 * j], v[4 * j + 1], v[4 * j + 2], v[4 * j + 3]};
}
DI void ld_row_bf16(const bf16_t* p, float (&v)[16], int lane) {
#pragma unroll
    for (int j = 0; j < 4; ++j) { const u32x2 t = *(const u32x2*)(p + 256 * j + 4 * lane); v[4 * j] = bflo(t[0]); v[4 * j + 1] = bfhi(t[0]); v[4 * j + 2] = bflo(t[1]); v[4 * j + 3] = bfhi(t[1]); }
}
DI void st_row_bf16(bf16_t* p, const float (&v)[16], int lane) {
#pragma unroll
    for (int j = 0; j < 4; ++j) *(u32x2*)(p + 256 * j + 4 * lane) = (u32x2){pk2(v[4 * j], v[4 * j + 1]), pk2(v[4 * j + 2], v[4 * j + 3])};
}
DI void ln_row(float (&v)[16], const float* g, const float* b, int lane) {
    float s = 0.f;
#pragma unroll
    for (int i = 0; i < 16; ++i) s += v[i];
    const float mean = wave_sum(s) * (1.0f / 1024.0f);
    float q = 0.f;
#pragma unroll
    for (int i = 0; i < 16; ++i) { const float d = v[i] - mean; q += d * d; }
    const float rstd = 1.0f / sqrtf(wave_sum(q) * (1.0f / 1024.0f) + LN_EPS);
    float gg[16], bb[16]; ld_row_f32(g, gg, lane); ld_row_f32(b, bb, lane);
#pragma unroll
    for (int i = 0; i < 16; ++i) v[i] = (v[i] - mean) * rstd * gg[i] + bb[i];
}
DI void modulate(const float (&v)[16], float (&h)[16], const float* sh, const float* sc, int lane) {
    float a[16], b[16]; ld_row_f32(sh, a, lane); ld_row_f32(sc, b, lane);
#pragma unroll
    for (int i = 0; i < 16; ++i) h[i] = v[i] * (1.0f + b[i]) + a[i];
}
template <int N> DI void row_dots2(const float (&ha)[16], const float (&hb)[16], const LAS float* wl, int lane, float& ra, float& rb) {
    f32x2 xa[8], xb[8], sa[N], sb[N];
#pragma unroll
    for (int i = 0; i < 8; ++i) { xa[i] = (f32x2){ha[2 * i], ha[2 * i + 1]}; xb[i] = (f32x2){hb[2 * i], hb[2 * i + 1]}; }
#pragma unroll
    for (int e = 0; e < N; ++e) { sa[e] = (f32x2){0.f, 0.f}; sb[e] = (f32x2){0.f, 0.f}; }
    const LAS float* wp = wl + 4 * lane;
#pragma unroll 1
    for (int j = 0; j < 4; ++j) {
#pragma unroll
        for (int e = 0; e < N; ++e) { const f32x4 w = *(const LAS f32x4*)(wp + e * 1024); const f32x2 w0 = (f32x2){w[0], w[1]}, w1 = (f32x2){w[2], w[3]};
            sa[e] = sa[e] + xa[0] * w0; sa[e] = sa[e] + xa[1] * w1; sb[e] = sb[e] + xb[0] * w0; sb[e] = sb[e] + xb[1] * w1; }
        wp += 256;
#pragma unroll
        for (int i = 0; i < 6; ++i) { xa[i] = xa[i + 2]; xb[i] = xb[i + 2]; }
    }
    float va[N], vb[N];
#pragma unroll
    for (int e = 0; e < N; ++e) { va[e] = sa[e][0] + sa[e][1]; vb[e] = sb[e][0] + sb[e][1]; }
    ra = bfly<N>(va, lane); rb = bfly<N>(vb, lane);
}
DI void load_small_w(LAS float* wl, const float* src, int n  ) { for (int i = ltid(); i < n / 4; i += 512) *(LAS f32x4*)(wl + 4 * i) = *(const f32x4*)(src + 4 * i); __syncthreads(); }

DI void emit_h_and_gates2(const Params& p, int layer, int ra, int rb, const float (&xa)[16], const float (&xb)[16], const LAS float* wg, int lane) {
    float ha[16], hb[16];
    { const float* mod = wsp<float>(p, WS_MOD) + ((size_t)layer * 9 + bsel_of(ra)) * 6144; modulate(xa, ha, mod, mod + 1024, lane); st_row_bf16(wsp<bf16_t>(p, WS_H) + (size_t)ra * D, ha, lane); }
    if (rb >= 0) { const float* mod = wsp<float>(p, WS_MOD) + ((size_t)layer * 9 + bsel_of(rb)) * 6144; modulate(xb, hb, mod, mod + 1024, lane); st_row_bf16(wsp<bf16_t>(p, WS_H) + (size_t)rb * D, hb, lane); }
    else {
#pragma unroll
        for (int i = 0; i < 16; ++i) hb[i] = ha[i]; }
    float ga, gb; row_dots2<16>(ha, hb, wg, lane, ga, gb);
    if ((lane & 3) == 0) { wsp<float>(p, WS_GPRE)[(size_t)ra * 16 + (lane >> 2)] = ga; if (rb >= 0) wsp<float>(p, WS_GPRE)[(size_t)rb * 16 + (lane >> 2)] = gb; }
}
DI void phase_init(const Params& p, LAS unsigned char* lds) {
    const int lane = ltid() & 63, wave = ltid() >> 6, blk = lbid();
    LAS float* wg = (LAS float*)lds; load_small_w(wg, wsp<float>(p, WS_WGATE), 16 * 1024);
#pragma unroll 1
    for (int pi = 0; pi < 9; ++pi) { const int ra = row_of(blk, wave, 2 * pi), rb = pi < 8 ? row_of(blk, wave, 2 * pi + 1) : -1;
        float xa[16], xb[16]; ld_row_f32(ra < ML ? p.x + (size_t)ra * D : p.ctx + (size_t)(ra - ML) * D, xa, lane);
        st_row_f32(wsp<float>(p, WS_X) + (size_t)ra * D, xa, lane);
        if (rb >= 0) { ld_row_f32(p.x + (size_t)rb * D, xb, lane); st_row_f32(wsp<float>(p, WS_X) + (size_t)rb * D, xb, lane); }
        else {
#pragma unroll
            for (int i = 0; i < 16; ++i) xb[i] = xa[i]; }
        emit_h_and_gates2(p, 0, ra, rb, xa, xb, wg, lane); }
}

DI void route_row(const Params& p, int row, float lg, LAS int* cnt, int lane) {
    int te[4]; float tv[4];
#pragma unroll
    for (int k = 0; k < 4; ++k) {
        float bv = lg; int be = lane >> 1;
#pragma unroll
        for (int o = 32; o >= 1; o >>= 1) { const float ov = __shfl_xor(bv, o); const int oe = __shfl_xor(be, o); if (ov > bv || (ov == bv && oe < be)) { bv = ov; be = oe; } }
        te[k] = be; tv[k] = bv; if ((lane >> 1) == be) lg = -3.0e38f;
    }
    const float e1 = __expf(tv[1] - tv[0]), e2 = __expf(tv[2] - tv[0]), e3 = __expf(tv[3] - tv[0]); const float inv = 1.0f / (1.0f + e1 + e2 + e3);
    if (lane < 4) { const int e = lane == 0 ? te[0] : lane == 1 ? te[1] : lane == 2 ? te[2] : te[3]; const float gk = (lane == 0 ? 1.0f : lane == 1 ? e1 : lane == 2 ? e2 : e3) * inv;
        const int r = atomicAdd((int*)&cnt[e], 1);
        wsp<int>(p, WS_TOPE)[(size_t)row * 4 + lane] = e; wsp<float>(p, WS_TOPG)[(size_t)row * 4 + lane] = gk; wsp<int>(p, WS_TOPR)[(size_t)row * 4 + lane] = r; }
}
DI void ln1_row(const Params& p, int layer, int row, float (&h)[16], int lane) {
    const float* mod = wsp<float>(p, WS_MOD) + ((size_t)layer * 9 + bsel_of(row)) * 6144;
    float x[16], y[16], g1[16];
    ld_row_f32(wsp<float>(p, WS_X) + (size_t)row * D, x, lane); ld_row_bf16(wsp<bf16_t>(p, WS_Y) + (size_t)row * D, y, lane); ld_row_f32(mod + 2 * 1024, g1, lane);
#pragma unroll
    for (int j = 0; j < 16; ++j) x[j] = DN_ALPHA * x[j] + g1[j] * y[j];
    ln_row(x, SMP(SM_LN1G) + (size_t)layer * D, SMP(SM_LN1B) + (size_t)layer * D, lane);
    st_row_f32(wsp<float>(p, WS_X) + (size_t)row * D, x, lane);
    modulate(x, h, mod + 3 * 1024, mod + 4 * 1024, lane);
    st_row_bf16(wsp<bf16_t>(p, WS_H2) + (size_t)row * D, h, lane);
}
DI void phase_ln1_router(const Params& p, int layer, LAS unsigned char* lds) {
    const int tid = ltid(), lane = tid & 63, wave = tid >> 6, blk = lbid();
    LAS float* rw = (LAS float*)lds;
    LAS int* cnt = (LAS int*)(lds + 32 * 1024 * 4);
    { const float* src = SMP(SM_RW) + (size_t)layer * 1024 * 32;
      for (int i = tid; i < 32 * 1024; i += 512) { const int k = i >> 5, e = i & 31; rw[e * 1024 + k] = src[i]; }
      if (tid < 32) cnt[tid] = 0; }
    __syncthreads();
    const bool last = (layer == DEPTH - 1);
    const float rbias = SMP(SM_RB)[layer * 32 + (lane >> 1)];
#pragma unroll 1
    for (int pi = 0; pi < (last ? 8 : 9); ++pi) { const int ra = row_of(blk, wave, 2 * pi), rb = pi < 8 ? row_of(blk, wave, 2 * pi + 1) : -1;
        float ha[16], hb[16]; ln1_row(p, layer, ra, ha, lane);
        if (rb >= 0) ln1_row(p, layer, rb, hb, lane);
        else {
#pragma unroll
            for (int i = 0; i < 16; ++i) hb[i] = ha[i]; }
        float la, lb; row_dots2<32>(ha, hb, rw, lane, la, lb);
        route_row(p, ra, la + rbias, cnt, lane);
        if (rb >= 0) route_row(p, rb, lb + rbias, cnt, lane);
    }
    __syncthreads();
    if (tid < 32) { const int c = cnt[tid]; int base = 0; if (c > 0) base = (int)atomicAdd(wsp<unsigned>(p, WS_CTL) + CW_CNT + layer * 32 + tid, (unsigned)c); wsp<int>(p, WS_BASE)[blk * 32 + tid] = base; }
}

DI void phase_scatter(const Params& p, int layer, LAS unsigned char* lds) {
    const int tid = ltid(), lane = tid & 63, wave = tid >> 6, blk = lbid();
    LAS int* pst = (LAS int*)lds;
    if (tid == 0) { int acc = 0; for (int e = 0; e < 32; ++e) { const int c = (int)__hip_atomic_load(wsp<unsigned>(p, WS_CTL) + CW_CNT + layer * 32 + e, __ATOMIC_RELAXED, __HIP_MEMORY_SCOPE_AGENT); pst[e] = acc; pst[32 + e] = c; acc += (c + 255) & ~255; } pst[64] = acc >> 8; }
    __syncthreads();
    if (blk == 0) { int* be = wsp<int>(p, WS_BLKE); if (tid == 0) be[0] = pst[64];
#pragma unroll 1
        for (int e = 0; e < 32; ++e) { const int b0 = pst[e] >> 8, nb = (pst[32 + e] + 255) >> 8; for (int j = tid; j < nb; j += 512) be[1 + b0 + j] = e; } }
    const bool last = (layer == DEPTH - 1);
#pragma unroll 1
    for (int i = 0; i < 17; ++i) { const int row = row_of(blk, wave, i);
        if (last && row >= ML) continue;
        const u32x4* src = (const u32x4*)(wsp<bf16_t>(p, WS_H2) + (size_t)row * D);
        const u32x4 v0 = src[lane], v1 = src[64 + lane];
#pragma unroll
        for (int k = 0; k < 4; ++k) { const int e = wsp<int>(p, WS_TOPE)[(size_t)row * 4 + k], r = wsp<int>(p, WS_TOPR)[(size_t)row * 4 + k];
            const int dest = pst[e] + wsp<int>(p, WS_BASE)[blk * 32 + e] + r;
            if (lane == 0) wsp<int>(p, WS_DEST)[(size_t)row * 4 + k] = dest;
            u32x4* d = (u32x4*)(wsp<bf16_t>(p, WS_XG) + (size_t)dest * D); d[lane] = v0; d[64 + lane] = v1; }
    }
}

DI void ln2_row(const Params& p, int layer, int row, float (&x)[16], int lane) {
    const float* mod = wsp<float>(p, WS_MOD) + ((size_t)layer * 9 + bsel_of(row)) * 6144;
    float f[16], g2[16];
#pragma unroll
    for (int j = 0; j < 16; ++j) f[j] = 0.f;
#pragma unroll
    for (int k = 0; k < 4; ++k) { const int dest = wsp<int>(p, WS_DEST)[(size_t)row * 4 + k]; const float gk = wsp<float>(p, WS_TOPG)[(size_t)row * 4 + k];
        float y[16]; ld_row_bf16(wsp<bf16_t>(p, WS_YS) + (size_t)dest * D, y, lane);
#pragma unroll
        for (int j = 0; j < 16; ++j) f[j] += gk * y[j]; }
    ld_row_f32(wsp<float>(p, WS_X) + (size_t)row * D, x, lane); ld_row_f32(mod + 5 * 1024, g2, lane);
#pragma unroll
    for (int j = 0; j < 16; ++j) x[j] = DN_ALPHA * x[j] + g2[j] * f[j];
    ln_row(x, SMP(SM_LN2G) + (size_t)layer * D, SMP(SM_LN2B) + (size_t)layer * D, lane);
}
DI void phase_ln2(const Params& p, int layer, LAS unsigned char* lds) {
    const int tid = ltid(), lane = tid & 63, wave = tid >> 6, blk = lbid();
    const bool last = (layer == DEPTH - 1);
    LAS float* wg = (LAS float*)lds;
    if (!last) load_small_w(wg, wsp<float>(p, WS_WGATE) + (size_t)(layer + 1) * 16 * 1024, 16 * 1024);
    if (last) {
#pragma unroll 1
        for (int i = 0; i < 16; ++i) { const int row = row_of(blk, wave, i); float x[16]; ln2_row(p, layer, row, x, lane); st_row_f32(p.out + (size_t)row * D, x, lane); }
    } else {
#pragma unroll 1
        for (int pi = 0; pi < 9; ++pi) { const int ra = row_of(blk, wave, 2 * pi), rb = pi < 8 ? row_of(blk, wave, 2 * pi + 1) : -1;
            float xa[16], xb[16]; ln2_row(p, layer, ra, xa, lane); st_row_f32(wsp<float>(p, WS_X) + (size_t)ra * D, xa, lane);
            if (rb >= 0) { ln2_row(p, layer, rb, xb, lane); st_row_f32(wsp<float>(p, WS_X) + (size_t)rb * D, xb, lane); }
            else {
#pragma unroll
                for (int i = 0; i < 16; ++i) xb[i] = xa[i]; }
            emit_h_and_gates2(p, layer + 1, ra, rb, xa, xb, wg, lane); }
    }
}
using pg8::Unit;
struct SchedDense {
    pg8::TileOrder T; const bf16_t* A; int lda; const bf16_t* Bt; int K;
    DI bool next(int i, Unit& u) const { u.aux = 0; return T.tile(i, u.pm, u.pn); }
    DI const char* a_base(const Unit& u) const { return (const char*)(A + (size_t)u.pm * 256 * lda); }
    DI const char* b_base(const Unit& u) const { return (const char*)(Bt + (size_t)u.pn * 256 * K); }
};
struct SchedMerge {
    pg8::TileOrder T; const bf16_t* A; const bf16_t* Bt; static constexpr int lda = 1536;
    DI bool next(int i, Unit& u) const { u.aux = i % 3; return T.tile(i / 3, u.pm, u.pn); }
    DI const char* a_base(const Unit& u) const { return (const char*)(A + (size_t)u.pm * 256 * 1536 + u.aux * 512); }
    DI const char* b_base(const Unit& u) const { return (const char*)(Bt + ((size_t)u.aux * 1024 + (size_t)u.pn * 256) * 512); }
};
template <int NT> struct SchedMoe {
    const int* blke; int nunits, G, c; const bf16_t* A; const bf16_t* Bt; size_t bstride; static constexpr int lda = 1024;
    DI void init(const int* blke_, int G_, int c_) { blke = blke_; nunits = blke_[0] * NT; G = G_; c = c_; }
    DI bool next(int i, Unit& u) const { constexpr int RB = 32 / NT; const int rb = (i * 8 + (c & 7)) * RB + (c >> 3) / NT; if (rb * NT >= nunits) return false; u.pm = rb; u.pn = (c >> 3) % NT; u.aux = blke[1 + rb]; return true; }
    DI const char* a_base(const Unit& u) const { return (const char*)(A + (size_t)u.pm * 256 * 1024); }
    DI const char* b_base(const Unit& u) const { return (const char*)(Bt + (size_t)u.aux * bstride + (size_t)u.pn * 256 * 1024); }
};

#define EPI_ROWS_BEGIN _Pragma("unroll") for (int ai = 0; ai < 2; ++ai) _Pragma("unroll") for (int m = 0; m < 4; ++m) { const int row = u.pm * 256 + ai * 128 + wr * 64 + m * 16 + fr;
#define EPI_ROWS_END }
DI u32x4 pack8(const f32x4& a, const f32x4& b) { return (u32x4){cvt_pk_bf16(a[0], a[1]), cvt_pk_bf16(a[2], a[3]), cvt_pk_bf16(b[0], b[1]), cvt_pk_bf16(b[2], b[3])}; }

struct EpiInproj {
    bf16_t* P; const f32x2* rope;
    DI void operator()(const f32x4 (&acc)[2][2][4][2], const Unit& u, int wr, int wc, int fr, int fq) const {
        const int pn = u.pn; const int colb = pn * 256 + wc * 32 + 8 * fq;
        const int kind = pn < 2 ? 0 : pn < 4 ? 1 : pn < 6 ? 2 : pn < 8 ? 3 : pn < 10 ? 4 : pn < 14 ? 2 : pn < 18 ? 5 : 3;
        const bool latent = u.pm < 128;
        const int ra = wc >> 1, f0 = ((wc & 1) * 4 + fq) * 4;
        EPI_ROWS_BEGIN
            bf16_t* rowp = P + (size_t)row * NPROJ + colb;
            f32x4 cs[2]; if (kind <= 1 && latent) { const int t = row & 4095; const int pos = ra ? (t & 63) : (t >> 6); const f32x4* rp = (const f32x4*)(rope + pos * 32 + f0); cs[0] = rp[0]; cs[1] = rp[1]; }
#pragma unroll
            for (int bj = 0; bj < 2; ++bj) { f32x4 v0 = acc[ai][bj][m][0], v1 = acc[ai][bj][m][1];
                if (kind == 0) { v0 = v0 * 0.08838834764831845f; v1 = v1 * 0.08838834764831845f; }
                if (kind == 4) { v0 = v0 * 0.125f; v1 = v1 * 0.125f; }
                if (kind <= 1 && latent) {
                    const float c[4] = {cs[0][0], cs[0][2], cs[1][0], cs[1][2]}, s[4] = {cs[0][1], cs[0][3], cs[1][1], cs[1][3]};
#pragma unroll
                    for (int j = 0; j < 4; ++j) { const float x1 = v0[j], x2 = v1[j]; v0[j] = x1 * c[j] - x2 * s[j]; v1[j] = x2 * c[j] + x1 * s[j]; } }
                if (kind == 3) {
#pragma unroll
                    for (int j = 0; j < 4; ++j) { v0[j] = sigmoidf_(v0[j]); v1[j] = sigmoidf_(v1[j]); } }
                if (kind == 5) {
#pragma unroll
                    for (int j = 0; j < 4; ++j) { v0[j] = gelu_tanh(v0[j]); v1[j] = gelu_tanh(v1[j]); } }
                *(u32x4*)(rowp + bj * 128) = pack8(v0, v1); }
        EPI_ROWS_END
    }
};
struct EpiMerge {
    bf16_t* Mg; const bf16_t* P;
    DI void operator()(const f32x4 (&acc)[2][2][4][2], const Unit& u, int wr, int wc, int fr, int fq) const {
        const int colb = u.pn * 256 + wc * 32 + 8 * fq;
        EPI_ROWS_BEGIN
#pragma unroll
            for (int bj = 0; bj < 2; ++bj) { const int col = colb + bj * 128;
                const u32x4 g = *(const u32x4*)(P + (size_t)row * NPROJ + PBG + u.aux * 1024 + col);
                f32x4 v0 = acc[ai][bj][m][0], v1 = acc[ai][bj][m][1];
                v0 = v0 * (f32x4){bflo(g[0]), bfhi(g[0]), bflo(g[1]), bfhi(g[1])}; v1 = v1 * (f32x4){bflo(g[2]), bfhi(g[2]), bflo(g[3]), bfhi(g[3])};
                u32x4* dst = (u32x4*)(Mg + (size_t)row * D + col);
                if (u.aux > 0) { const u32x4 o = *dst; v0 = v0 + (f32x4){bflo(o[0]), bfhi(o[0]), bflo(o[1]), bfhi(o[1])}; v1 = v1 + (f32x4){bflo(o[2]), bfhi(o[2]), bflo(o[3]), bfhi(o[3])}; }
                *dst = pack8(v0, v1); }
        EPI_ROWS_END
    }
};
struct EpiStore {
    bf16_t* O; int ldo; const float* bias; int bias_stride;
    DI void operator()(const f32x4 (&acc)[2][2][4][2], const Unit& u, int wr, int wc, int fr, int fq) const {
        const int colb = u.pn * 256 + wc * 32 + 8 * fq;
        f32x4 bv[2][2];
#pragma unroll
        for (int bj = 0; bj < 2; ++bj)
#pragma unroll
            for (int n = 0; n < 2; ++n) bv[bj][n] = bias ? *(const f32x4*)(bias + (size_t)u.aux * bias_stride + colb + bj * 128 + 4 * n) : (f32x4){0.f, 0.f, 0.f, 0.f};
        EPI_ROWS_BEGIN
#pragma unroll
            for (int bj = 0; bj < 2; ++bj) *(u32x4*)(O + (size_t)row * ldo + colb + bj * 128) = pack8(acc[ai][bj][m][0] + bv[bj][0], acc[ai][bj][m][1] + bv[bj][1]);
        EPI_ROWS_END
    }
};
struct EpiGu {
    bf16_t* ACT; const float* b_gu;
    DI void operator()(const f32x4 (&acc)[2][2][4][2], const Unit& u, int wr, int wc, int fr, int fq) const {
        f32x4 bg[2], bu[2];
#pragma unroll
        for (int bj = 0; bj < 2; ++bj) { const int oc = u.pn * 128 + bj * 64 + wc * 16 + 4 * fq; bg[bj] = *(const f32x4*)(b_gu + (size_t)u.aux * 2048 + oc); bu[bj] = *(const f32x4*)(b_gu + (size_t)u.aux * 2048 + 1024 + oc); }
        EPI_ROWS_BEGIN
#pragma unroll
            for (int bj = 0; bj < 2; ++bj) { const int oc = u.pn * 128 + bj * 64 + wc * 16 + 4 * fq;
                const f32x4 g = acc[ai][bj][m][0] + bg[bj], up = acc[ai][bj][m][1] + bu[bj]; float a[4];
#pragma unroll
                for (int j = 0; j < 4; ++j) { const float gt = fminf(g[j], 7.0f), ut = fminf(fmaxf(up[j], -7.0f), 7.0f); a[j] = gt * sigmoidf_(1.702f * gt) * (ut + 1.0f); }
                *(u32x2*)(ACT + (size_t)row * 1024 + oc) = (u32x2){cvt_pk_bf16(a[0], a[1]), cvt_pk_bf16(a[2], a[3])}; }
        EPI_ROWS_END
    }
};

DI void phase_inproj(const Params& p, int layer, LAS unsigned char* lds) {
    SchedDense S; S.T.init(MT / 256, NPROJ / 256, lgdim(), lbid()); S.A = wsp<bf16_t>(p, WS_H); S.lda = 1024; S.Bt = wsp<bf16_t>(p, WS_WIN) + (size_t)layer * NPROJ * 1024; S.K = 1024;
    EpiInproj E{wsp<bf16_t>(p, WS_P), wsp<f32x2>(p, WS_ROPE)};
    pg8::gemm_phase(lds, 1024, S, E);
}
DI void phase_merge(const Params& p, int layer, LAS unsigned char* lds) {
    SchedMerge S; S.T.init(MT / 256, 4, lgdim(), lbid()); S.A = wsp<bf16_t>(p, WS_ABC); S.Bt = wsp<bf16_t>(p, WS_WBR) + (size_t)layer * 3 * 1024 * 512;
    EpiMerge E{wsp<bf16_t>(p, WS_MRG), wsp<bf16_t>(p, WS_P)};
    pg8::gemm_phase(lds, 512, S, E);
}
DI void phase_outproj(const Params& p, int layer, LAS unsigned char* lds) {
    SchedDense S; S.T.init(MT / 256, 4, lgdim(), lbid()); S.A = wsp<bf16_t>(p, WS_MRG); S.lda = 1024; S.Bt = wsp<bf16_t>(p, WS_WOUT) + (size_t)layer * 1024 * 1024; S.K = 1024;
    EpiStore E{wsp<bf16_t>(p, WS_Y), 1024, nullptr, 0};
    pg8::gemm_phase(lds, 1024, S, E);
}
DI void phase_moe_gu(const Params& p, int layer, LAS unsigned char* lds) {
    SchedMoe<8> S; S.init(wsp<int>(p, WS_BLKE), lgdim(), lbid()); S.A = wsp<bf16_t>(p, WS_XG); S.Bt = wsp<bf16_t>(p, WS_WGU) + (size_t)layer * 32 * 2048 * 1024; S.bstride = (size_t)2048 * 1024;
    EpiGu E{wsp<bf16_t>(p, WS_ACT), SMP(SM_BGU) + (size_t)layer * 32 * 2048};
    pg8::gemm_phase(lds, 1024, S, E);
}
DI void phase_moe_dn(const Params& p, int layer, LAS unsigned char* lds) {
    SchedMoe<4> S; S.init(wsp<int>(p, WS_BLKE), lgdim(), lbid()); S.A = wsp<bf16_t>(p, WS_ACT); S.Bt = wsp<bf16_t>(p, WS_WDN) + (size_t)layer * 32 * 1024 * 1024; S.bstride = (size_t)1024 * 1024;
    EpiStore E{wsp<bf16_t>(p, WS_YS), 1024, SMP(SM_BDN) + (size_t)layer * 32 * 1024, 1024};
    pg8::gemm_phase(lds, 1024, S, E);
}
DI int chain_tok(int dir, int b, int j, int tau) {
    if (dir == 0) return j < 4 ? ML + b * 256 + j * 64 + tau : b * 4096 + (j - 4) * 64 + tau;
    return j < 4 ? ML + b * 256 + (3 - j) * 64 + (63 - tau) : b * 4096 + (67 - j) * 64 + (63 - tau);
}
DI void phase_gates(const Params& p, int layer) {
    const int lane = ltid() & 63, gw = lbid() * 8 + (ltid() >> 6), nw = lgdim() * 8;
    const float* gb = SMP(SM_GBIAS) + layer * 16;
    for (int u = gw; u < NCHAIN * NSLOT; u += nw) {
        const int ch = u / NSLOT, j = u % NSLOT, dir = ch >> 5, b = (ch >> 2) & 7, h = ch & 3;
        const int tok = chain_tok(dir, b, j, lane);
        const float* g = wsp<float>(p, WS_GPRE) + (size_t)tok * 16;
        const float li = g[(dir * 2) * 4 + h] + gb[(dir * 2) * 4 + h];
        const float lf = log_sigmoid(g[(dir * 2 + 1) * 4 + h] + gb[(dir * 2 + 1) * 4 + h]);
        float bc = lf;
#pragma unroll
        for (int o = 1; o < 64; o <<= 1) { const float t = __shfl_up(bc, o); if (lane >= o) bc += t; }
        const float a = li - bc; float cm = a;
#pragma unroll
        for (int o = 1; o < 64; o <<= 1) { const float t = __shfl_up(cm, o); if (lane >= o) cm = fmaxf(cm, t); }
        const size_t o = (size_t)u * 64 + lane;
        wsp<float>(p, WS_GA)[o] = a; wsp<float>(p, WS_GCM)[o] = cm; wsp<float>(p, WS_GB)[o] = bc;
    }
}
DI float chain_m(const Params& p, int ch, int j) {
    const float* gcm = wsp<float>(p, WS_GCM) + (size_t)ch * NSLOT * 64 + 63; const float* gbb = wsp<float>(p, WS_GB) + (size_t)ch * NSLOT * 64 + 63;
    float m = 0.f; for (int i = 0; i < j; ++i) m = gbb[i * 64] + fmaxf(m, gcm[i * 64]); return m;
}
DI float chain_m_wave(const Params& p, int ch, int j, int lane) {
    const float* gcm = wsp<float>(p, WS_GCM) + (size_t)ch * NSLOT * 64 + 63; const float* gbb = wsp<float>(p, WS_GB) + (size_t)ch * NSLOT * 64 + 63;
    float A = gbb[lane * 64], B = gcm[lane * 64] + A;
    float xa[4], xb[4];
#pragma unroll
    for (int i = 0; i < 4; ++i) { xa[i] = gbb[(64 + i) * 64]; xb[i] = gcm[(64 + i) * 64] + xa[i]; }
#pragma unroll
    for (int o = 1; o < 64; o <<= 1) { const float fa = __shfl_up(A, o), fb = __shfl_up(B, o); if (lane >= o) { B = fmaxf(fb + A, B); A = fa + A; } }
    const float mi = fmaxf(A, B);
    float m = j == 0 ? 0.f : __shfl(mi, (j < 64 ? j : 64) - 1);
#pragma unroll
    for (int i = 0; i < 3; ++i) if (64 + i < j) m = fmaxf(m + xa[i], xb[i]);
    return m;
}

#define MFMA16(a, b, c) __builtin_amdgcn_mfma_f32_16x16x32_bf16((a), (b), (c), 0, 0, 0)
DI bf16x8 tr_frag(LAS unsigned char* base, int off0, int off1) {
    const s16x4 lo = __builtin_amdgcn_ds_read_tr16_b64_v4i16((LAS s16x4*)(base + off0)); const s16x4 hi = __builtin_amdgcn_ds_read_tr16_b64_v4i16((LAS s16x4*)(base + off1));
    return __builtin_shufflevector(lo, hi, 0, 1, 2, 3, 4, 5, 6, 7);
}
DI bf16x8 pack_frag(const float (&a)[4], const float (&b)[4]) { const u32x4 w = (u32x4){cvt_pk_bf16(a[0], a[1]), cvt_pk_bf16(a[2], a[3]), cvt_pk_bf16(b[0], b[1]), cvt_pk_bf16(b[2], b[3])}; return __builtin_bit_cast(bf16x8, w); }

DI void mlstm_u_unit(const Params& p, int u, LAS unsigned char* lds) {
    const int tid = ltid(), lane = tid & 63, wave = __builtin_amdgcn_readfirstlane(tid >> 6), g = lane >> 4, c = lane & 15;
    const int ch = u / (NSLOT - 1), j = u % (NSLOT - 1), dir = ch >> 5, b = (ch >> 2) & 7, h = ch & 3;
    const int tokb = dir == 0 ? (j < 4 ? ML + b * 256 + j * 64 : b * 4096 + (j - 4) * 64) : (j < 4 ? ML + b * 256 + (3 - j) * 64 : b * 4096 + (67 - j) * 64);
    constexpr int VS = 304, KS = 272;
    LAS unsigned char* Vs = lds; LAS unsigned char* Kw = lds + 64 * VS; LAS float* wl = (LAS float*)(lds + 64 * VS + 64 * KS);
    const size_t slot = (size_t)ch * NSLOT + j;
    if (tid < 64) { const int tau = dir ? 63 - tid : tid; const float mj = chain_m_wave(p, ch, j, tid); const float Mend = fmaxf(mj, wsp<float>(p, WS_GCM)[slot * 64 + 63]); wl[tid] = __expf(wsp<float>(p, WS_GA)[slot * 64 + tau] - Mend); }
    __syncthreads();
    { const int s = tid >> 3, pc = tid & 7; const bf16_t* row = wsp<bf16_t>(p, WS_P) + (size_t)(tokb + s) * NPROJ + h * 128 + pc * 16;
      const u32x4 v0 = *(const u32x4*)(row + PV), v1 = *(const u32x4*)(row + PV + 8); *(LAS u32x4*)(Vs + s * VS + pc * 32) = v0; *(LAS u32x4*)(Vs + s * VS + pc * 32 + 16) = v1;
      const u32x4 k0 = *(const u32x4*)(row + PK), k1 = *(const u32x4*)(row + PK + 8); const float w = wl[s]; u32x4 o0, o1;
#pragma unroll
      for (int e = 0; e < 4; ++e) { o0[e] = cvt_pk_bf16(w * bflo(k0[e]), w * bfhi(k0[e])); o1[e] = cvt_pk_bf16(w * bflo(k1[e]), w * bfhi(k1[e])); }
      *(LAS u32x4*)(Kw + s * KS + pc * 32) = o0; *(LAS u32x4*)(Kw + s * KS + pc * 32 + 16) = o1;
      *(LAS unsigned*)(Vs + s * VS + 256 + pc * 4) = pc == 0 ? 0x3F80u : 0u; }
    __syncthreads();
    bf16x8 kf[2];
#pragma unroll
    for (int kk = 0; kk < 2; ++kk) { const int o = (32 * kk + 8 * g + (c >> 2)) * KS + (16 * wave + 4 * (c & 3)) * 2; kf[kk] = tr_frag(Kw, o, o + 4 * KS); }
    bf16_t* uc = wsp<bf16_t>(p, WS_UC) + slot * 16384; float* un = wsp<float>(p, WS_UN) + slot * 128;
#pragma unroll
    for (int vb = 0; vb < 9; ++vb) { f32x4 acc = (f32x4){0.f, 0.f, 0.f, 0.f};
#pragma unroll
        for (int kk = 0; kk < 2; ++kk) { const int o = (32 * kk + 8 * g + (c >> 2)) * VS + (16 * vb + 4 * (c & 3)) * 2; acc = MFMA16(kf[kk], tr_frag(Vs, o, o + 4 * VS), acc); }
        if (vb < 8) *(u32x2*)(uc + (16 * vb + c) * 128 + 16 * wave + 4 * g) = (u32x2){cvt_pk_bf16(acc[0], acc[1]), cvt_pk_bf16(acc[2], acc[3])};
        else if (c == 0) *(f32x4*)(un + 16 * wave + 4 * g) = acc; }
    __syncthreads();
}
DI void phase_scan(const Params& p) {
    const int gt = lbid() * 512 + ltid(), nthr = lgdim() * 512;
    for (int w = gt; w < NCHAIN * 2048; w += nthr) {
        const int ch = w >> 11, e8 = w & 2047;
        const float* gcm = wsp<float>(p, WS_GCM) + (size_t)ch * NSLOT * 64 + 63; const float* gbb = wsp<float>(p, WS_GB) + (size_t)ch * NSLOT * 64 + 63;
        u32x4* base = (u32x4*)(wsp<bf16_t>(p, WS_UC) + (size_t)ch * NSLOT * 16384) + e8;
        float* nb = wsp<float>(p, WS_UN) + (size_t)ch * NSLOT * 128 + e8;
        float c[8], nn = 0.f, m = 0.f;
#pragma unroll
        for (int i = 0; i < 8; ++i) c[i] = 0.f;
        for (int j = 0; j < NSLOT; ++j) {
            u32x4 uu = (u32x4){0u, 0u, 0u, 0u}; float un = 0.f;
            if (j < NSLOT - 1) { uu = base[(size_t)j * 2048]; if (e8 < 128) un = nb[j * 128]; }
            base[(size_t)j * 2048] = (u32x4){pk2(c[0], c[1]), pk2(c[2], c[3]), pk2(c[4], c[5]), pk2(c[6], c[7])};
            if (e8 < 128) nb[j * 128] = nn;
            const float cme = gcm[j * 64], be = gbb[j * 64]; const float Mend = fmaxf(m, cme); const float dec = __expf(m - Mend); m = be + Mend;
            c[0] = dec * c[0] + bflo(uu[0]); c[1] = dec * c[1] + bfhi(uu[0]); c[2] = dec * c[2] + bflo(uu[1]); c[3] = dec * c[3] + bfhi(uu[1]);
            c[4] = dec * c[4] + bflo(uu[2]); c[5] = dec * c[5] + bfhi(uu[2]); c[6] = dec * c[6] + bflo(uu[3]); c[7] = dec * c[7] + bfhi(uu[3]);
            nn = dec * nn + un;
        }
    }
}
DI void mlstm_h_unit(const Params& p, int layer, int u, LAS unsigned char* lds) {
    const int tid = ltid(), lane = tid & 63, wave = __builtin_amdgcn_readfirstlane(tid >> 6), g = lane >> 4, c = lane & 15;
    const int b = u / (4 * 68), h = (u / 68) & 3, cc = u % 68; const bool isctx = cc < 4; const int ck = isctx ? cc : cc - 4;
    const int tok0 = isctx ? ML + b * 256 + ck * 64 : b * 4096 + ck * 64;
    constexpr int QS = 272, VS = 304, CS = 272;
    LAS unsigned char* Qs = lds; LAS unsigned char* Ks = lds + 64 * QS; LAS unsigned char* Vs = lds + 128 * QS; LAS unsigned char* Cs = Vs + 64 * VS;
    LAS float* G = (LAS float*)(Cs + 2 * 144 * CS);
    const bf16_t* P = wsp<bf16_t>(p, WS_P);
    { const int t = tid >> 3, pc = tid & 7; const bf16_t* row = P + (size_t)(tok0 + t) * NPROJ + h * 128 + pc * 16;
      *(LAS u32x4*)(Qs + t * QS + pc * 32) = *(const u32x4*)(row + PQ); *(LAS u32x4*)(Qs + t * QS + pc * 32 + 16) = *(const u32x4*)(row + PQ + 8);
      *(LAS u32x4*)(Ks + t * QS + pc * 32) = *(const u32x4*)(row + PK); *(LAS u32x4*)(Ks + t * QS + pc * 32 + 16) = *(const u32x4*)(row + PK + 8);
      *(LAS u32x4*)(Vs + t * VS + pc * 32) = *(const u32x4*)(row + PV); *(LAS u32x4*)(Vs + t * VS + pc * 32 + 16) = *(const u32x4*)(row + PV + 8);
      *(LAS unsigned*)(Vs + t * VS + 256 + pc * 4) = pc == 0 ? 0x3F80u : 0u; }
#pragma unroll
    for (int dir = 0; dir < 2; ++dir) {
        const int ch = (dir * 8 + b) * 4 + h; const int j = dir == 0 ? (isctx ? ck : 4 + ck) : (isctx ? 3 - ck : 67 - ck); const size_t slot = (size_t)ch * NSLOT + j;
        const u32x4* src = (const u32x4*)(wsp<bf16_t>(p, WS_UC) + slot * 16384); LAS unsigned char* Cd = Cs + dir * 144 * CS;
#pragma unroll
        for (int k = 0; k < 4; ++k) { const int idx = tid + 512 * k; *(LAS u32x4*)(Cd + (idx >> 4) * CS + (idx & 15) * 16) = src[idx]; }
        if (tid < 64) { const float* nv = wsp<float>(p, WS_UN) + slot * 128 + 2 * tid; *(LAS unsigned*)(Cd + 128 * CS + tid * 4) = pk2(nv[0], nv[1]); }
        for (int idx = tid; idx < 960; idx += 512) *(LAS unsigned*)(Cd + (129 + (idx >> 6)) * CS + (idx & 63) * 4) = 0u;
        if (tid >= 256 && tid < 320) { const int s = tid - 256, tau = dir ? 63 - s : s; const float mprev = chain_m_wave(p, ch, j, s);
            const float a = wsp<float>(p, WS_GA)[slot * 64 + tau], cm = wsp<float>(p, WS_GCM)[slot * 64 + tau], bb = wsp<float>(p, WS_GB)[slot * 64 + tau]; const float Mt = fmaxf(mprev, cm);
            LAS float* Gd = G + dir * 256; Gd[s] = a; Gd[64 + s] = Mt; Gd[128 + s] = __expf(mprev - Mt); Gd[192 + s] = __expf(-(bb + Mt)); }
    }
    __syncthreads();
    const int dir = wave >> 2, tb = wave & 3, t = 16 * tb + c;
    const LAS float* Gd = G + dir * 256; const float Mt = Gd[64 + t], wi = Gd[128 + t], fl = Gd[192 + t];
    bf16x8 qf[4];
#pragma unroll
    for (int kk = 0; kk < 4; ++kk) qf[kk] = *(const LAS bf16x8*)(Qs + t * QS + (kk * 32 + g * 8) * 2);
    f32x4 acc[9];
    { const LAS unsigned char* Cd = Cs + dir * 144 * CS;
#pragma unroll
      for (int vb = 0; vb < 9; ++vb) { f32x4 a = (f32x4){0.f, 0.f, 0.f, 0.f};
#pragma unroll
          for (int kk = 0; kk < 4; ++kk) a = MFMA16(*(const LAS bf16x8*)(Cd + (16 * vb + c) * CS + (kk * 32 + g * 8) * 2), qf[kk], a);
          acc[vb] = a * wi; } }
#pragma unroll
    for (int pr = 0; pr < 2; ++pr) {
        const bool needed = dir == 0 ? (2 * pr <= tb) : (2 * pr + 1 >= tb);
        if (needed) {
            f32x4 sA = (f32x4){0.f, 0.f, 0.f, 0.f}, sB = sA;
#pragma unroll
            for (int kk = 0; kk < 4; ++kk) { sA = MFMA16(*(const LAS bf16x8*)(Ks + (32 * pr + c) * QS + (kk * 32 + g * 8) * 2), qf[kk], sA); sB = MFMA16(*(const LAS bf16x8*)(Ks + (32 * pr + 16 + c) * QS + (kk * 32 + g * 8) * 2), qf[kk], sB); }
            float pA[4], pB[4];
#pragma unroll
            for (int i = 0; i < 4; ++i) { const int sa = 32 * pr + 4 * g + i, sb = sa + 16;
                const bool vA = dir == 0 ? (sa <= t) : (sa >= t), vB = dir == 0 ? (sb <= t) : (sb >= t);
                pA[i] = vA ? sA[i] * __expf(Gd[sa] - Mt) : 0.f; pB[i] = vB ? sB[i] * __expf(Gd[sb] - Mt) : 0.f; }
            const bf16x8 pf = pack_frag(pA, pB);
#pragma unroll
            for (int vb = 0; vb < 9; ++vb) { const int o = (32 * pr + 4 * g + (c >> 2)) * VS + (16 * vb + 4 * (c & 3)) * 2; acc[vb] = MFMA16(tr_frag(Vs, o, o + 16 * VS), pf, acc[vb]); }
        }
    }
    { const float den = __shfl(acc[8][0], c); const float inv = 1.0f / fmaxf(fabsf(den), fl);
#pragma unroll
      for (int vb = 0; vb < 8; ++vb) acc[vb] = acc[vb] * inv; }
    __syncthreads();
    LAS float* Hx = (LAS float*)lds;
    if (dir == 1) {
#pragma unroll
        for (int vb = 0; vb < 8; ++vb) *(LAS f32x4*)(Hx + t * 132 + 16 * vb + 4 * g) = acc[vb]; }
    __syncthreads();
    if (dir == 0) {
        float s = 0.f;
#pragma unroll
        for (int vb = 0; vb < 8; ++vb) { acc[vb] = acc[vb] + *(const LAS f32x4*)(Hx + t * 132 + 16 * vb + 4 * g); s += (acc[vb][0] + acc[vb][1]) + (acc[vb][2] + acc[vb][3]); }
        s += __shfl_xor(s, 16); s += __shfl_xor(s, 32); const float mean = s * (1.0f / 128.0f); float q = 0.f;
#pragma unroll
        for (int vb = 0; vb < 8; ++vb) { const f32x4 d = acc[vb] - mean; q += (d[0] * d[0] + d[1] * d[1]) + (d[2] * d[2] + d[3] * d[3]); }
        q += __shfl_xor(q, 16); q += __shfl_xor(q, 32); const float rstd = 1.0f / sqrtf(q * (1.0f / 128.0f) + LN_EPS);
        const size_t tok = (size_t)(tok0 + t); const float* ng = SMP(SM_NORMG) + (size_t)layer * 512 + h * 128;
#pragma unroll
        for (int vb = 0; vb < 8; ++vb) { const int v0 = 16 * vb + 4 * g; const f32x4 gg = *(const f32x4*)(ng + v0); const u32x2 ow = *(const u32x2*)(P + tok * NPROJ + PO + h * 128 + v0);
            const f32x4 r = (acc[vb] - mean) * rstd * gg * (f32x4){bflo(ow[0]), bfhi(ow[0]), bflo(ow[1]), bfhi(ow[1])};
            *(u32x2*)(wsp<bf16_t>(p, WS_ABC) + tok * 1536 + h * 128 + v0) = (u32x2){cvt_pk_bf16(r[0], r[1]), cvt_pk_bf16(r[2], r[3])}; }
    }
    __syncthreads();
}

DI int na_koff(int key, int chunk) { return key * 128 + ((chunk ^ (key & 7)) << 4); }
DI void na_unit(const Params& p, int layer, int u, LAS unsigned char* lds) {
    const int tid = ltid(), lane = tid & 63, wave = __builtin_amdgcn_readfirstlane(tid >> 6), g = lane >> 4, c = lane & 15;
    const bool lat = u < 4096; int b, h, r = 0, qb = 0;
    if (lat) { b = u >> 9; h = (u >> 6) & 7; r = u & 63; } else { const int v = u - 4096; b = v >> 5; h = (v >> 2) & 7; qb = v & 3; }
    const int ct = wave & 3, half = wave >> 2;
    const int tokq = lat ? b * 4096 + r * 64 + 16 * ct + c : ML + b * 256 + qb * 64 + 16 * ct + c;
    const bf16_t* P = wsp<bf16_t>(p, WS_P);
    LAS unsigned char* KL = lds; LAS unsigned char* VL = lds + 65536; LAS float* rpbl = (LAS float*)(lds + 131072);
    bf16x8 qf[2];
#pragma unroll
    for (int kk = 0; kk < 2; ++kk) qf[kk] = *(const bf16x8*)(P + (size_t)tokq * NPROJ + PNQ + h * 64 + kk * 32 + g * 8);
    { const int key = tid >> 1, hf = tid & 1; const bf16_t* row = P + (size_t)(ML + b * 256 + key) * NPROJ + h * 64 + hf * 32;
#pragma unroll
      for (int q = 0; q < 4; ++q) { *(LAS u32x4*)(KL + na_koff(key, hf * 4 + q)) = *(const u32x4*)(row + PNK + q * 8); *(LAS u32x4*)(VL + na_koff(key, hf * 4 + q)) = *(const u32x4*)(row + PNV + q * 8); }
      if (lat && tid < 465) rpbl[tid] = SMP(SM_RPB)[((size_t)layer * 8 + h) * 465 + tid]; }
    __syncthreads();
    float m = -1.0e30f, l = 0.f; f32x4 acc[4];
#pragma unroll
    for (int db = 0; db < 4; ++db) acc[db] = (f32x4){0.f, 0.f, 0.f, 0.f};
#define NA_STEP(KEYA, KEYB, MASKED) do { \
        f32x4 sA = (f32x4){0.f, 0.f, 0.f, 0.f}, sB = sA; \
        _Pragma("unroll") for (int kk = 0; kk < 2; ++kk) { sA = MFMA16(*(const LAS bf16x8*)(KL + na_koff((KEYA) + c, kk * 4 + g)), qf[kk], sA); sB = MFMA16(*(const LAS bf16x8*)(KL + na_koff((KEYB) + c, kk * 4 + g)), qf[kk], sB); } \
        float xa[4], xb[4]; float mx = -1.0e30f; \
        _Pragma("unroll") for (int i = 0; i < 4; ++i) { xa[i] = sA[i]; xb[i] = sB[i]; if (MASKED) { const int kcA = c0 + 4 * g + i, kcB = kcA + 16; \
            xa[i] = (kcA >= cs && kcA < cs + 16) ? xa[i] + rpbl[brow + (kcA - qc + 15)] : -1.0e30f; xb[i] = (kcB >= cs && kcB < cs + 16) ? xb[i] + rpbl[brow + (kcB - qc + 15)] : -1.0e30f; } \
            mx = fmaxf(mx, fmaxf(xa[i], xb[i])); } \
        mx = fmaxf(mx, __shfl_xor(mx, 16)); mx = fmaxf(mx, __shfl_xor(mx, 32)); \
        const float mn = fmaxf(m, mx), al = __expf(m - mn); m = mn; float ps = 0.f; \
        _Pragma("unroll") for (int i = 0; i < 4; ++i) { xa[i] = __expf(xa[i] - mn); xb[i] = __expf(xb[i] - mn); ps += xa[i] + xb[i]; } \
        l = l * al + ps; const bf16x8 pf = pack_frag(xa, xb); \
        _Pragma("unroll") for (int db = 0; db < 4; ++db) { const int ka = (KEYA) + 4 * g + (c >> 2), kb2 = (KEYB) + 4 * g + (c >> 2), chk = 2 * db + ((c & 3) >> 1), by = 8 * (c & 1); \
            acc[db] = MFMA16(tr_frag(VL, na_koff(ka, chk) + by, na_koff(kb2, chk) + by), pf, acc[db] * al); } \
    } while (0)
    { const int c0 = 0, cs = 0, qc = 0, brow = 0; (void)c0; (void)cs; (void)qc; (void)brow;
#pragma unroll 1
      for (int st = 0; st < 4; ++st) { const int k0 = 128 * half + 32 * st; NA_STEP(k0, k0 + 16, false); } }
    __syncthreads();
    if (lat) {
        const int rs = min(max(r - 4, 0), 56);
        { const int key = tid; const bf16_t* row = P + (size_t)(b * 4096 + (rs + (key >> 6)) * 64 + (key & 63)) * NPROJ + h * 64;
#pragma unroll
          for (int q = 0; q < 8; ++q) { *(LAS u32x4*)(KL + na_koff(key, q)) = *(const u32x4*)(row + PNK + q * 8); *(LAS u32x4*)(VL + na_koff(key, q)) = *(const u32x4*)(row + PNV + q * 8); } }
        __syncthreads();
        const int c0 = ct == 0 ? 0 : ct == 1 ? 8 : ct == 2 ? 24 : 32, qc = 16 * ct + c, cs = min(max(qc - 8, 0), 48);
#pragma unroll 1
        for (int st = 0; st < 4; ++st) { const int rr = 4 * half + st; const int brow = (rs + rr - r + 7) * 31; const int k0 = rr * 64 + c0; NA_STEP(k0, k0 + 16, true); }
        __syncthreads();
    }
#undef NA_STEP
    l += __shfl_xor(l, 16); l += __shfl_xor(l, 32);
    LAS float* X = (LAS float*)lds + (ct * 64 + lane) * 20;
    if (half == 1) { X[0] = m; X[1] = l;
#pragma unroll
        for (int db = 0; db < 4; ++db) *(LAS f32x4*)(X + 4 + 4 * db) = acc[db]; }
    __syncthreads();
    if (half == 0) { const float m1 = X[0], l1 = X[1]; const float mn = fmaxf(m, m1), e0 = __expf(m - mn), e1 = __expf(m1 - mn); const float inv = 1.0f / (l * e0 + l1 * e1);
#pragma unroll
        for (int db = 0; db < 4; ++db) { const f32x4 o = (acc[db] * e0 + *(const LAS f32x4*)(X + 4 + 4 * db) * e1) * inv;
            *(u32x2*)(wsp<bf16_t>(p, WS_ABC) + (size_t)tokq * 1536 + 512 + h * 64 + 16 * db + 4 * g) = (u32x2){cvt_pk_bf16(o[0], o[1]), cvt_pk_bf16(o[2], o[3])}; } }
    __syncthreads();
}

DI void sgu_unit(const Params& p, int layer, int u, LAS unsigned char* lds) {
    const int tid = ltid(), lane = tid & 63, wave = __builtin_amdgcn_readfirstlane(tid >> 6), g = lane >> 4, c = lane & 15;
    const int g4 = u & 3, n = (u >> 2) % 34, b = (u >> 2) / 34;
    const int tok0 = n < 32 ? b * 4096 + n * 128 : ML + b * 256 + (n - 32) * 128;
    constexpr int RS = 272;
    LAS unsigned char* vn = lds; LAS unsigned char* Wl = lds + 128 * RS; LAS float* st = (LAS float*)(lds + 256 * RS);
    const bf16_t* P = wsp<bf16_t>(p, WS_P);
    u32x4 wv[16];
#pragma unroll
    for (int i = 0; i < 16; ++i) wv[i] = *(const u32x4*)(P + (size_t)(tok0 + wave * 16 + i) * NPROJ + PSV + lane * 8);
#pragma unroll
    for (int i = 0; i < 16; ++i) { const int pp = wave * 16 + i; const u32x4 w = wv[i];
        const float x[8] = {bflo(w[0]), bfhi(w[0]), bflo(w[1]), bfhi(w[1]), bflo(w[2]), bfhi(w[2]), bflo(w[3]), bfhi(w[3])}; float s = 0.f;
#pragma unroll
        for (int e = 0; e < 8; ++e) s += x[e];
        const float mean = wave_sum(s) * (1.0f / 512.0f); float q = 0.f;
#pragma unroll
        for (int e = 0; e < 8; ++e) q += (x[e] - mean) * (x[e] - mean);
        const float rstd = 1.0f / sqrtf(wave_sum(q) * (1.0f / 512.0f) + LN_EPS);
        if (lane == 0) { st[pp * 2] = mean; st[pp * 2 + 1] = rstd; } }
    __syncthreads();
    { const int pp = tid >> 2, pc = tid & 3; const float mean = st[pp * 2], rstd = st[pp * 2 + 1];
      const float* lg = SMP(SM_SGLNG) + (size_t)layer * 512 + g4 * 128 + pc * 32; const float* lb = SMP(SM_SGLNB) + (size_t)layer * 512 + g4 * 128 + pc * 32;
      const bf16_t* src = P + (size_t)(tok0 + pp) * NPROJ + PSV + g4 * 128 + pc * 32;
      const float* wsrc = SMP(SM_SGW) + (((size_t)layer * 4 + g4) * 128 + pp) * 128 + pc * 32;
#pragma unroll
      for (int q = 0; q < 4; ++q) { const u32x4 w = *(const u32x4*)(src + q * 8); const f32x4 g0 = *(const f32x4*)(lg + q * 8), g1 = *(const f32x4*)(lg + q * 8 + 4), b0 = *(const f32x4*)(lb + q * 8), b1 = *(const f32x4*)(lb + q * 8 + 4);
          const f32x4 x0 = ((f32x4){bflo(w[0]), bfhi(w[0]), bflo(w[1]), bfhi(w[1])} - mean) * rstd * g0 + b0, x1 = ((f32x4){bflo(w[2]), bfhi(w[2]), bflo(w[3]), bfhi(w[3])} - mean) * rstd * g1 + b1;
          *(LAS u32x4*)(vn + pp * RS + pc * 64 + q * 16) = pack8(x0, x1);
          const f32x4 w0 = *(const f32x4*)(wsrc + q * 8), w1 = *(const f32x4*)(wsrc + q * 8 + 4); *(LAS u32x4*)(Wl + pp * RS + pc * 64 + q * 16) = pack8(w0, w1); } }
    __syncthreads();
    bf16x8 wf[4];
#pragma unroll
    for (int kk = 0; kk < 4; ++kk) wf[kk] = *(const LAS bf16x8*)(Wl + (16 * wave + c) * RS + (kk * 32 + g * 8) * 2);
    const size_t tok = (size_t)(tok0 + 16 * wave + c); const float bs = SMP(SM_SGB)[((size_t)layer * 4 + g4) * 128 + 16 * wave + c];
#pragma unroll
    for (int cb = 0; cb < 8; ++cb) { f32x4 acc = (f32x4){0.f, 0.f, 0.f, 0.f};
#pragma unroll
        for (int kk = 0; kk < 4; ++kk) { const int o = (32 * kk + 8 * g + (c >> 2)) * RS + (16 * cb + 4 * (c & 3)) * 2; acc = MFMA16(tr_frag(vn, o, o + 4 * RS), wf[kk], acc); }
        const u32x2 uw = *(const u32x2*)(P + tok * NPROJ + PSU + g4 * 128 + 16 * cb + 4 * g);
        const f32x4 o = (f32x4){bflo(uw[0]), bfhi(uw[0]), bflo(uw[1]), bfhi(uw[1])} * (acc + bs);
        *(u32x2*)(wsp<bf16_t>(p, WS_ABC) + tok * 1536 + 1024 + g4 * 128 + 16 * cb + 4 * g) = (u32x2){cvt_pk_bf16(o[0], o[1]), cvt_pk_bf16(o[2], o[3])}; }
    __syncthreads();
}

DI void mlstm_u_unit_naive(const Params& p, int u, LAS unsigned char* lds) {
    const int tid = ltid(), ch = u / (NSLOT - 1), j = u % (NSLOT - 1), dir = ch >> 5, b = (ch >> 2) & 7, h = ch & 3;
    LAS float* Vs = (LAS float*)lds; LAS float* Ks = Vs + 64 * 128;
    const float mj = chain_m(p, ch, j);
    const float Mend = fmaxf(mj, wsp<float>(p, WS_GCM)[((size_t)ch * NSLOT + j) * 64 + 63]);
    const bf16_t* P = wsp<bf16_t>(p, WS_P);
    for (int i = tid; i < 64 * 128; i += 512) { const int tau = i >> 7, d = i & 127; const int tok = chain_tok(dir, b, j, tau);
        const float w = __expf(wsp<float>(p, WS_GA)[((size_t)ch * NSLOT + j) * 64 + tau] - Mend);
        Vs[i] = bf2f(P[(size_t)tok * NPROJ + PV + h * 128 + d]); Ks[i] = w * bf2f(P[(size_t)tok * NPROJ + PK + h * 128 + d]); }
    __syncthreads();
    { const int v = tid >> 2, d0 = (tid & 3) * 32; float acc[32];
#pragma unroll
      for (int i = 0; i < 32; ++i) acc[i] = 0.f;
      for (int tau = 0; tau < 64; ++tau) { const float vv = Vs[tau * 128 + v];
#pragma unroll
          for (int i = 0; i < 32; ++i) acc[i] += vv * Ks[tau * 128 + d0 + i]; }
      bf16_t* dst = wsp<bf16_t>(p, WS_UC) + (((size_t)ch * NSLOT + j) * 128 + v) * 128 + d0;
#pragma unroll
      for (int i = 0; i < 32; i += 2) *(unsigned*)(dst + i) = pk2(acc[i], acc[i + 1]); }
    if (tid < 128) { float s = 0.f; for (int tau = 0; tau < 64; ++tau) s += Ks[tau * 128 + tid]; wsp<float>(p, WS_UN)[((size_t)ch * NSLOT + j) * 128 + tid] = s; }
    __syncthreads();
}
DI void mlstm_h_unit_naive(const Params& p, int layer, int u, LAS unsigned char* lds) {
    const int tid = ltid(), b = u / (4 * 68), h = (u / 68) & 3, cc = u % 68;
    const bool isctx = cc < 4; const int ck = isctx ? cc : cc - 4;
    const int tok0 = isctx ? ML + b * 256 + ck * 64 : b * 4096 + ck * 64;
    LAS float* Qs = (LAS float*)lds; LAS float* Ks = Qs + 64 * 129; LAS float* Vs = Ks + 64 * 129;
    LAS float* Ss = Vs + 64 * 129;
    LAS float* aux = Ss + 64 * 65;
    const bf16_t* P = wsp<bf16_t>(p, WS_P);
    for (int i = tid; i < 64 * 128; i += 512) { const int t = i >> 7, d = i & 127; const size_t o = (size_t)(tok0 + t) * NPROJ + h * 128 + d;
        Qs[t * 129 + d] = bf2f(P[o + PQ]); Ks[t * 129 + d] = bf2f(P[o + PK]); Vs[t * 129 + d] = bf2f(P[o + PV]); }
    __syncthreads();
    float hacc[16];
#pragma unroll
    for (int i = 0; i < 16; ++i) hacc[i] = 0.f;
    const int t = tid >> 3, sg = tid & 7, v0 = sg * 16;
    for (int dir = 0; dir < 2; ++dir) {
        const int ch = (dir * 8 + b) * 4 + h; const int j = dir == 0 ? (isctx ? ck : 4 + ck) : (isctx ? 3 - ck : 67 - ck);
        const float mprev = chain_m(p, ch, j);
        const float* ga = wsp<float>(p, WS_GA) + ((size_t)ch * NSLOT + j) * 64; const float* gcm = wsp<float>(p, WS_GCM) + ((size_t)ch * NSLOT + j) * 64; const float* gbv = wsp<float>(p, WS_GB) + ((size_t)ch * NSLOT + j) * 64;
        const bf16_t* C = wsp<bf16_t>(p, WS_UC) + ((size_t)ch * NSLOT + j) * 16384; const float* nvec = wsp<float>(p, WS_UN) + ((size_t)ch * NSLOT + j) * 128;
        { const int taut = dir ? 63 - t : t; const float Mt = fmaxf(mprev, gcm[taut]);
          for (int s = sg; s < 64; s += 8) { const int taus = dir ? 63 - s : s; float v = 0.f;
              if (taus <= taut) { float dsum = 0.f; for (int d = 0; d < 128; ++d) dsum += Qs[t * 129 + d] * Ks[s * 129 + d]; v = dsum * __expf(ga[taus] - Mt); }
              Ss[t * 65 + s] = v; }
          if (sg == 0) { float dn = 0.f; for (int d = 0; d < 128; ++d) dn += Qs[t * 129 + d] * nvec[d]; aux[t] = __expf(mprev - Mt); aux[64 + t] = dn; aux[128 + t] = __expf(-(gbv[taut] + Mt)); } }
        __syncthreads();
        { const float wi = aux[t];
          float den = wi * aux[64 + t]; for (int s = 0; s < 64; ++s) den += Ss[t * 65 + s];
          const float dd = fmaxf(fabsf(den), aux[128 + t]);
#pragma unroll 1
          for (int vv = 0; vv < 16; ++vv) { const int v = v0 + vv; float num = 0.f;
              for (int s = 0; s < 64; ++s) num += Ss[t * 65 + s] * Vs[s * 129 + v];
              float cq = 0.f; const u32x4* cr = (const u32x4*)(C + (size_t)v * 128);
              for (int d8 = 0; d8 < 16; ++d8) { const u32x4 w = cr[d8]; const LAS float* qq = Qs + t * 129 + d8 * 8;
                  cq += bflo(w[0]) * qq[0] + bfhi(w[0]) * qq[1] + bflo(w[1]) * qq[2] + bfhi(w[1]) * qq[3] + bflo(w[2]) * qq[4] + bfhi(w[2]) * qq[5] + bflo(w[3]) * qq[6] + bfhi(w[3]) * qq[7]; }
              const float val = (num + wi * cq) / dd;
#pragma unroll
              for (int k = 0; k < 16; ++k) if (k == vv) hacc[k] += val; } }
        __syncthreads();
    }
    { float s = 0.f;
#pragma unroll
      for (int i = 0; i < 16; ++i) s += hacc[i];
      s += __shfl_xor(s, 1); s += __shfl_xor(s, 2); s += __shfl_xor(s, 4);
      const float mean = s * (1.0f / 128.0f); float q = 0.f;
#pragma unroll
      for (int i = 0; i < 16; ++i) { const float d = hacc[i] - mean; q += d * d; }
      q += __shfl_xor(q, 1); q += __shfl_xor(q, 2); q += __shfl_xor(q, 4);
      const float rstd = 1.0f / sqrtf(q * (1.0f / 128.0f) + LN_EPS);
      const size_t tok = (size_t)(tok0 + t); const float* ng = SMP(SM_NORMG) + (size_t)layer * 512 + h * 128 + v0;
      const u32x4* op = (const u32x4*)(P + tok * NPROJ + PO + h * 128 + v0); const u32x4 o0 = op[0], o1 = op[1];
      const float og[16] = {bflo(o0[0]), bfhi(o0[0]), bflo(o0[1]), bfhi(o0[1]), bflo(o0[2]), bfhi(o0[2]), bflo(o0[3]), bfhi(o0[3]), bflo(o1[0]), bfhi(o1[0]), bflo(o1[1]), bfhi(o1[1]), bflo(o1[2]), bfhi(o1[2]), bflo(o1[3]), bfhi(o1[3])};
      float r[16];
#pragma unroll
      for (int i = 0; i < 16; ++i) r[i] = (hacc[i] - mean) * rstd * ng[i] * og[i];
      u32x4* dst = (u32x4*)(wsp<bf16_t>(p, WS_ABC) + tok * 1536 + h * 128 + v0);
      dst[0] = (u32x4){pk2(r[0], r[1]), pk2(r[2], r[3]), pk2(r[4], r[5]), pk2(r[6], r[7])}; dst[1] = (u32x4){pk2(r[8], r[9]), pk2(r[10], r[11]), pk2(r[12], r[13]), pk2(r[14], r[15])}; }
    __syncthreads();
}

DI void na_task(const Params& p, int layer, int task, LAS float* ws  ) {
    const int lane = ltid() & 63; const int row = task >> 3, hd = task & 7;
    const bf16_t* P = wsp<bf16_t>(p, WS_P);
    const bool latent = row < ML; const int b = latent ? row >> 12 : (row - ML) >> 8;
    ws[lane] = bf2f(P[(size_t)row * NPROJ + PNQ + hd * 64 + lane]);
    asm volatile("s_waitcnt lgkmcnt(0)" ::: "memory");
    int r = 0, qc = 0, rs = 0, cs = 0;
    if (latent) { const int t = row & 4095; r = t >> 6; qc = t & 63; rs = min(max(r - 4, 0), 56); cs = min(max(qc - 8, 0), 48); }
    const int nkeys = latent ? 384 : 256;
    float sc[6]; float mx = -3.0e38f;
#pragma unroll
    for (int i = 0; i < 6; ++i) { const int kk = lane + 64 * i; sc[i] = -3.0e38f;
        if (kk < nkeys) { int krow; float bias = 0.f;
            if (latent && kk < 128) { const int kr = rs + (kk >> 4), kc = cs + (kk & 15); krow = b * 4096 + kr * 64 + kc; bias = SMP(SM_RPB)[(((size_t)layer * 8 + hd) * 15 + (kr - r + 7)) * 31 + (kc - qc + 15)]; }
            else krow = ML + b * 256 + (latent ? kk - 128 : kk);
            const u32x4* kp = (const u32x4*)(P + (size_t)krow * NPROJ + PNK + hd * 64); float s = 0.f;
#pragma unroll
            for (int c8 = 0; c8 < 8; ++c8) { const u32x4 w = kp[c8];
#pragma unroll
                for (int e = 0; e < 4; ++e) s += bflo(w[e]) * ws[c8 * 8 + 2 * e] + bfhi(w[e]) * ws[c8 * 8 + 2 * e + 1]; }
            sc[i] = s + bias; mx = fmaxf(mx, sc[i]); } }
    mx = wave_max(mx); float sum = 0.f;
#pragma unroll
    for (int i = 0; i < 6; ++i) { const int kk = lane + 64 * i; if (kk < nkeys) { const float e = __expf(sc[i] - mx); sum += e; ws[64 + kk] = e; } }
    sum = wave_sum(sum);
    asm volatile("s_waitcnt lgkmcnt(0)" ::: "memory");
    float o = 0.f;
    for (int kk = 0; kk < nkeys; ++kk) { int krow;
        if (latent && kk < 128) krow = b * 4096 + (rs + (kk >> 4)) * 64 + cs + (kk & 15); else krow = ML + b * 256 + (latent ? kk - 128 : kk);
        o += ws[64 + kk] * bf2f(P[(size_t)krow * NPROJ + PNV + hd * 64 + lane]); }
    wsp<bf16_t>(p, WS_ABC)[(size_t)row * 1536 + 512 + hd * 64 + lane] = (bf16_t)f2bf(o / sum);
}

DI void sgu_unit_naive(const Params& p, int layer, int u, LAS unsigned char* lds) {
    const int tid = ltid(), lane = tid & 63, wave = tid >> 6;
    const int g = u & 3, n = (u >> 2) % 34, b = (u >> 2) / 34;
    const int tok0 = n < 32 ? b * 4096 + n * 128 : ML + b * 256 + (n - 32) * 128;
    LAS float* vn = (LAS float*)lds;
    LAS float* wsm = vn + 128 * 128;
    LAS float* st = wsm + 128 * 129;
    const bf16_t* P = wsp<bf16_t>(p, WS_P);
    for (int i = 0; i < 16; ++i) { const int pp = wave * 16 + i; const u32x4 w = *(const u32x4*)(P + (size_t)(tok0 + pp) * NPROJ + PSV + lane * 8);
        const float x[8] = {bflo(w[0]), bfhi(w[0]), bflo(w[1]), bfhi(w[1]), bflo(w[2]), bfhi(w[2]), bflo(w[3]), bfhi(w[3])}; float s = 0.f;
#pragma unroll
        for (int e = 0; e < 8; ++e) s += x[e];
        const float mean = wave_sum(s) * (1.0f / 512.0f); float q = 0.f;
#pragma unroll
        for (int e = 0; e < 8; ++e) q += (x[e] - mean) * (x[e] - mean);
        const float rstd = 1.0f / sqrtf(wave_sum(q) * (1.0f / 512.0f) + LN_EPS);
        if (lane == 0) { st[pp * 2] = mean; st[pp * 2 + 1] = rstd; } }
    __syncthreads();
    const float* lg = SMP(SM_SGLNG) + (size_t)layer * 512 + g * 128; const float* lb = SMP(SM_SGLNB) + (size_t)layer * 512 + g * 128;
    for (int i = tid; i < 128 * 128; i += 512) { const int pp = i >> 7, c = i & 127;
        vn[i] = (bf2f(P[(size_t)(tok0 + pp) * NPROJ + PSV + g * 128 + c]) - st[pp * 2]) * st[pp * 2 + 1] * lg[c] + lb[c];
        wsm[pp * 129 + c] = SMP(SM_SGW)[(((size_t)layer * 4 + g) * 128 + pp) * 128 + c]; }
    __syncthreads();
    { const int q = tid >> 2, c0 = (tid & 3) * 32; float acc[32];
#pragma unroll
      for (int i = 0; i < 32; ++i) acc[i] = 0.f;
      for (int pp = 0; pp < 128; ++pp) { const float w = wsm[q * 129 + pp];
#pragma unroll
          for (int i = 0; i < 32; ++i) acc[i] += w * vn[pp * 128 + c0 + i]; }
      const float bs = SMP(SM_SGB)[((size_t)layer * 4 + g) * 128 + q];
      const size_t tok = (size_t)(tok0 + q);
#pragma unroll
      for (int i = 0; i < 32; i += 2) { const unsigned uu = *(const unsigned*)(P + tok * NPROJ + PSU + g * 128 + c0 + i);
          *(unsigned*)(wsp<bf16_t>(p, WS_ABC) + tok * 1536 + 1024 + g * 128 + c0 + i) = pk2(bflo(uu) * (acc[i] + bs), bfhi(uu) * (acc[i + 1] + bs)); } }
    __syncthreads();
}


#ifndef REP_U
#define REP_U 1
#endif
#ifndef REP_SGU
#define REP_SGU 1
#endif
#ifndef REP_NA
#define REP_NA 1
#endif
#ifndef MF_U
#define MF_U 1
#endif
#ifndef MF_H
#define MF_H 1
#endif
#ifndef MF_NA
#define MF_NA 1
#endif
#ifndef MF_SGU
#define MF_SGU 1
#endif
DI void phase_mix1(const Params& p, int layer, LAS unsigned char* lds) {
    const int G = lgdim(), blk = lbid();
#pragma unroll 1
    for (int r_ = 0; r_ < REP_U; ++r_)
#pragma unroll 1
    for (int u = blk; u < NCHAIN * (NSLOT - 1); u += G) { if (MF_U) mlstm_u_unit(p, u, lds); else mlstm_u_unit_naive(p, u, lds); }
#pragma unroll 1
    for (int r_ = 0; r_ < REP_SGU; ++r_)
#pragma unroll 1
    for (int u = blk; u < NB * 34 * 4; u += G) { if (MF_SGU) sgu_unit(p, layer, u, lds); else sgu_unit_naive(p, layer, u, lds); }
    if (MF_NA) {
        const int nna = layer == DEPTH - 1 ? 4096 : 4352;
#pragma unroll 1
        for (int r_ = 0; r_ < REP_NA; ++r_)
#pragma unroll 1
        for (int u = blk; u < nna; u += G) na_unit(p, layer, u, lds);
    } else { const int wave = ltid() >> 6; LAS float* ws = (LAS float*)lds + wave * 512;
#pragma unroll 1
        for (int t = blk * 8 + wave; t < MT * 8; t += G * 8) na_task(p, layer, t, ws); }
}
DI void phase_mix3(const Params& p, int layer, LAS unsigned char* lds) {
#pragma unroll 1
    for (int u = lbid(); u < NB * 4 * 68; u += lgdim()) { if (MF_H) mlstm_h_unit(p, layer, u, lds); else mlstm_h_unit_naive(p, layer, u, lds); }
}
constexpr int NPH = 2 + 11 * DEPTH;
#ifndef REP_PRO
#define REP_PRO 1
#endif
#ifndef REP_G_IN
#define REP_G_IN 1
#endif
#ifndef REP_G_MO
#define REP_G_MO 1
#endif
#ifndef REP_G_GU
#define REP_G_GU 1
#endif
#ifndef REP_G_DN
#define REP_G_DN 1
#endif
#ifndef REP_MIX1
#define REP_MIX1 1
#endif
#ifndef REP_MIX3
#define REP_MIX3 1
#endif
#define RUN(rep, call) do { _Pragma("unroll 1") for (int r_ = 0; r_ < (rep); ++r_) { call; } } while (0)
__global__ void __launch_bounds__(512, 2) fwd(Params p) {
    extern __shared__ __attribute__((aligned(16))) unsigned char lds_raw[];
    LAS unsigned char* lds = (LAS unsigned char*)lds_raw;
    volatile LAS unsigned* misc = (volatile LAS unsigned*)(lds + LDS_MISC);
    if (threadIdx.x < 64) misc[threadIdx.x] = 0u;
    __syncthreads();
    XcdBarrier bar = xcd_barrier_post(wsp<unsigned>(p, WS_CTL) + CW_BAR + p.li * XCD_BAR_WORDS, misc);
    const int lo = p.ph_lo, hi = p.ph_hi;
#define IN(k) (lo <= (k) && (k) < hi)
#define LP ({ Params q_ = p; asm volatile("" : "+s"(q_.z)); q_; })
#define SEAM(k) do { if (IN(k) && IN((k) + 1)) { XcdBarrier b2_ = bar; asm volatile("" : "+s"(b2_.bar), "+s"(b2_.x)); xcd_barrier(b2_); } } while (0)
    if (IN(0)) RUN(REP_PRO, phase_prologue_a(LP, lds));
    SEAM(0);
    if (IN(1)) phase_init(LP, lds);
    SEAM(1);
    for (int L = 0; L < DEPTH; ++L) {
        const int b = 2 + 11 * L;
        if (IN(b + 0)) { phase_gates(LP, L); RUN(REP_G_IN, phase_inproj(LP, L, lds)); }
        SEAM(b + 0);
        if (IN(b + 1)) RUN(REP_MIX1, phase_mix1(LP, L, lds));
        SEAM(b + 1);
        if (IN(b + 2)) phase_scan(LP);
        SEAM(b + 2);
        if (IN(b + 3)) RUN(REP_MIX3, phase_mix3(LP, L, lds));
        SEAM(b + 3);
        if (IN(b + 4)) RUN(REP_G_MO, phase_merge(LP, L, lds));
        SEAM(b + 4);
        if (IN(b + 5)) RUN(REP_G_MO, phase_outproj(LP, L, lds));
        SEAM(b + 5);
        if (IN(b + 6)) phase_ln1_router(LP, L, lds);
        SEAM(b + 6);
        if (IN(b + 7)) phase_scatter(LP, L, lds);
        SEAM(b + 7);
        if (IN(b + 8)) RUN(REP_G_GU, phase_moe_gu(LP, L, lds));
        SEAM(b + 8);
        if (IN(b + 9)) RUN(REP_G_DN, phase_moe_dn(LP, L, lds));
        SEAM(b + 9);
        if (IN(b + 10)) phase_ln2(LP, L, lds);
        SEAM(b + 10);
    }
#undef IN
#undef SEAM
}

#ifndef N_LAUNCH_MODE
#define N_LAUNCH_MODE 1
#endif
extern "C" void kernel_launch(void* const* d_in, const int* in_sizes, int n_in, void* d_out, int out_size, void* d_ws, size_t ws_size, hipStream_t stream) {
    static int grid = 0;
    if (grid == 0) {
        if (n_in != 26 || ws_size < WS_END) { fprintf(stderr, "kernel_launch: expected 26 inputs and >= %zu bytes of workspace (got %d, %zu)\n", (size_t)WS_END, n_in, ws_size); grid = -1; return; }
        int dev = 0, cus = 0, per_cu = 0;
        if (hipGetDevice(&dev) != hipSuccess || hipDeviceGetAttribute(&cus, hipDeviceAttributeMultiprocessorCount, dev) != hipSuccess) { grid = -1; return; }
        if (hipFuncSetAttribute((const void*)fwd, hipFuncAttributeMaxDynamicSharedMemorySize, LDS_BYTES) != hipSuccess) { fprintf(stderr, "kernel_launch: hipFuncSetAttribute failed\n"); grid = -1; return; }
        if (hipOccupancyMaxActiveBlocksPerMultiprocessor(&per_cu, (const void*)fwd, 512, LDS_BYTES) != hipSuccess || per_cu < 1) fprintf(stderr, "kernel_launch: occupancy query reports %d\n", per_cu);
        (void)hipGetLastError();
        grid = cus;
        if (grid != 256) fprintf(stderr, "kernel_launch: %d CUs; the row phases assume 256 workgroups\n", grid);
        grid = 256;
    }
    if (grid < 0) return;
    (void)hipMemsetAsync((char*)d_ws + WS_CTL, 0, CTL_BYTES, stream);
    Params p{};
    const float** pf = (const float**)&p;
    for (int i = 0; i < 26; ++i) pf[i] = (const float*)d_in[i];
    p.out = (float*)d_out; p.ws = (unsigned char*)d_ws;
#if N_LAUNCH_MODE == 1
    p.ph_lo = 0; p.ph_hi = NPH; p.li = 0; p.pad = 0; p.z = 0;
    hipLaunchKernelGGL(fwd, dim3(grid), dim3(512), LDS_BYTES, stream, p);
#else
    for (int ph = 0; ph < NPH; ++ph) { p.ph_lo = ph; p.ph_hi = ph + 1; p.li = 0; p.pad = 0; p.z = 0; hipLaunchKernelGGL(fwd, dim3(grid), dim3(512), LDS_BYTES, stream, p); }
#endif
    const hipError_t le = hipPeekAtLastError();
    if (le != hipSuccess) fprintf(stderr, "kernel_launch: launch failed: %s\n", hipGetErrorName(le));
}
```

```cpp
#include <hip/hip_runtime.h>
#include <cstdio>
#include <cstdint>

#define LAS __attribute__((address_space(3)))
typedef unsigned short bf16_t;
typedef short bf16x8 __attribute__((ext_vector_type(8)));
typedef short s16x4 __attribute__((ext_vector_type(4)));
typedef float f32x4 __attribute__((ext_vector_type(4)));
typedef float f32x2 __attribute__((ext_vector_type(2)));
typedef unsigned u32x4 __attribute__((ext_vector_type(4)));
typedef unsigned u32x2 __attribute__((ext_vector_type(2)));
#define DI __device__ __forceinline__

constexpr int D = 1024, NB = 8, SEQ = 4096, NCTX = 256, ML = NB * SEQ, MC = NB * NCTX, MT = ML + MC, DEPTH = 4;
constexpr int NPROJ = 7680, DIN = 7696, NEXP = 32, TOPK = 4;
constexpr int NROWS_MAX = (MT * TOPK / 256 + NEXP) * 256;
constexpr int NCHAIN = 2 * NB * 4, NSLOT = 68;
constexpr float LN_EPS = 1e-5f;
constexpr float DN_ALPHA = 1.6817928305074290f;
constexpr int PQ = 0, PK = 512, PV = 1024, PO = 1536, PNQ = 2048, PNK = 2560, PNV = 3072, PSU = 3584, PSV = 4096, PBG = 4608;

constexpr size_t al256(size_t x) { return (x + 255) & ~(size_t)255; }
constexpr size_t WS_CTL = 0, CTL_BYTES = 65536;
constexpr size_t WS_MOD = WS_CTL + CTL_BYTES;
constexpr size_t WS_ROPE = al256(WS_MOD + (size_t)4 * 9 * 6144 * 4);
constexpr size_t WS_WGATE = al256(WS_ROPE + 64 * 32 * 8);
constexpr size_t WS_WIN = al256(WS_WGATE + (size_t)4 * 16 * 1024 * 4);
constexpr size_t WS_WBR = al256(WS_WIN + (size_t)4 * NPROJ * 1024 * 2);
constexpr size_t WS_WOUT = al256(WS_WBR + (size_t)4 * 3 * 1024 * 512 * 2);
constexpr size_t WS_WGU = al256(WS_WOUT + (size_t)4 * 1024 * 1024 * 2);
constexpr size_t WS_WDN = al256(WS_WGU + (size_t)4 * 32 * 2048 * 1024 * 2);
constexpr size_t WS_X = al256(WS_WDN + (size_t)4 * 32 * 1024 * 1024 * 2);
constexpr size_t WS_H = al256(WS_X + (size_t)MT * D * 4);
constexpr size_t WS_H2 = al256(WS_H + (size_t)MT * D * 2);
constexpr size_t WS_P = al256(WS_H2 + (size_t)MT * D * 2);
constexpr size_t WS_GPRE = al256(WS_P + (size_t)MT * NPROJ * 2);
constexpr size_t WS_GA = al256(WS_GPRE + (size_t)MT * 16 * 4);
constexpr size_t WS_GCM = al256(WS_GA + (size_t)NCHAIN * NSLOT * 64 * 4);
constexpr size_t WS_GB = al256(WS_GCM + (size_t)NCHAIN * NSLOT * 64 * 4);
constexpr size_t WS_UC = al256(WS_GB + (size_t)NCHAIN * NSLOT * 64 * 4);
constexpr size_t WS_UN = al256(WS_UC + (size_t)NCHAIN * NSLOT * 128 * 128 * 2);
constexpr size_t WS_ABC = al256(WS_UN + (size_t)NCHAIN * NSLOT * 128 * 4);
constexpr size_t WS_MRG = al256(WS_ABC + (size_t)MT * 1536 * 2);
constexpr size_t WS_Y = al256(WS_MRG + (size_t)MT * D * 2);
constexpr size_t WS_TOPE = al256(WS_Y + (size_t)MT * D * 2);
constexpr size_t WS_TOPG = al256(WS_TOPE + (size_t)MT * 16);
constexpr size_t WS_TOPR = al256(WS_TOPG + (size_t)MT * 16);
constexpr size_t WS_DEST = al256(WS_TOPR + (size_t)MT * 16);
constexpr size_t WS_BASE = al256(WS_DEST + (size_t)MT * 16);
constexpr size_t WS_BLKE = al256(WS_BASE + 256 * 32 * 4);
constexpr size_t WS_XG = al256(WS_BLKE + 4096);
constexpr size_t WS_ACT = al256(WS_XG + (size_t)NROWS_MAX * D * 2);
constexpr size_t WS_YS = al256(WS_ACT + (size_t)NROWS_MAX * D * 2);
constexpr size_t SM_GBIAS = 0, SM_NORMG = SM_GBIAS + 64, SM_RPB = SM_NORMG + 2048, SM_SGLNG = SM_RPB + 14880, SM_SGLNB = SM_SGLNG + 2048, SM_SGW = SM_SGLNB + 2048, SM_SGB = SM_SGW + 262144,
                 SM_LN1G = SM_SGB + 2048, SM_LN1B = SM_LN1G + 4096, SM_RW = SM_LN1B + 4096, SM_RB = SM_RW + 131072, SM_BGU = SM_RB + 128, SM_BDN = SM_BGU + 262144, SM_LN2G = SM_BDN + 131072,
                 SM_LN2B = SM_LN2G + 4096, SM_END = SM_LN2B + 4096;
constexpr size_t WS_SM = al256(WS_YS + (size_t)NROWS_MAX * D * 2);
constexpr size_t WS_END = al256(WS_SM + SM_END * 4);
constexpr int CW_BAR = 0;
constexpr int CW_CNT = 16000;
static_assert((CW_CNT + 4 * 32) * 4 <= (int)CTL_BYTES, "ctl");

constexpr int LDS_BYTES = 147456;
constexpr int LDS_MISC = 147456 - 256;

DI unsigned f2bf(float f) { unsigned u = __builtin_bit_cast(unsigned, f); return (u + 0x7fffu + ((u >> 16) & 1u)) >> 16; }
DI float bf2f(unsigned b) { return __builtin_bit_cast(float, (b & 0xffffu) << 16); }
DI float bflo(unsigned w) { return __builtin_bit_cast(float, w << 16); }
DI float bfhi(unsigned w) { return __builtin_bit_cast(float, w & 0xffff0000u); }
typedef __bf16 bf16x2_t __attribute__((ext_vector_type(2)));
DI unsigned cvt_pk_bf16(float lo, float hi) { const f32x2 v = (f32x2){lo, hi}; return __builtin_bit_cast(unsigned, __builtin_convertvector(v, bf16x2_t)); }
DI unsigned pk2(float lo, float hi) { return cvt_pk_bf16(lo, hi); }
#define dppf(v, ctrl) __builtin_bit_cast(float, __builtin_amdgcn_update_dpp(0, __builtin_bit_cast(int, (float)(v)), (ctrl), 0xF, 0xF, true))
DI float rdl(float v, int l) { return __builtin_bit_cast(float, __builtin_amdgcn_readlane(__builtin_bit_cast(int, v), l)); }
DI float wave_sum(float v) {
    v += dppf(v, 0xB1); v += dppf(v, 0x4E); v += dppf(v, 0x141); v += dppf(v, 0x140);
    return (rdl(v, 0) + rdl(v, 16)) + (rdl(v, 32) + rdl(v, 48));
}
DI float wave_max(float v) { for (int o = 32; o >= 1; o >>= 1) v = fmaxf(v, __shfl_xor(v, o)); return v; }
DI float sigmoidf_(float x) { return __builtin_amdgcn_rcpf(1.0f + __builtin_amdgcn_exp2f(-1.4426950408889634f * x)); }
DI float gelu_tanh(float x) { return x * sigmoidf_(1.5957691216057308f * (x + 0.044715f * x * x * x)); }
DI float log_sigmoid(float x) { return -(fmaxf(-x, 0.0f) + log1pf(expf(-fabsf(x)))); }
__host__ __device__ inline int rope_d(int p) { const int u = p >> 3, e = p & 7; return (u >> 3) * 64 + (e >> 2) * 32 + (u & 7) * 4 + (e & 3); }

DI int ltid() { int t = threadIdx.x; asm volatile("" : "+v"(t)); return t; }
DI int lbid() { int b = blockIdx.x; asm volatile("" : "+s"(b)); return b; }
DI int lgdim() { int g = gridDim.x; asm volatile("" : "+s"(g)); return g; }
template <int N> DI float bfly(float (&v)[N], int lane) {
    int off = 32;
#pragma unroll
    for (int n = N; n > 1; n >>= 1) {
        const unsigned mk = (lane & off) ? 0xffffffffu : 0u;
#pragma unroll
        for (int i = 0; i < n / 2; ++i) { const unsigned a = __builtin_bit_cast(unsigned, v[i]), b = __builtin_bit_cast(unsigned, v[i + n / 2]);
            const float keep = __builtin_bit_cast(float, (a & ~mk) | (b & mk)); const float send = __builtin_bit_cast(float, (b & ~mk) | (a & mk)); v[i] = keep + __shfl_xor(send, off); }
        off >>= 1;
    }
    for (; off >= 1; off >>= 1) v[0] += __shfl_xor(v[0], off);
    return v[0];
}

#define XB_TMO      128
#define XB_XCNT(j)  (256  + 64 * (j))
#define XB_XSUB(j)  (1280 + 64 * (j))
#define XB_XGEN(j)  (2304 + 64 * (j))
#define XB_TOP      3328
#define XB_TOPGEN   3392
#define XCD_BAR_WORDS 3456
#define XB_SPIN_CAP (1u << 22)
DI unsigned xb_ld(unsigned* p)              { return __hip_atomic_load(p, __ATOMIC_RELAXED, __HIP_MEMORY_SCOPE_AGENT); }
DI unsigned xb_add(unsigned* p, unsigned v) { return __hip_atomic_fetch_add(p, v, __ATOMIC_RELAXED, __HIP_MEMORY_SCOPE_AGENT); }
DI unsigned xb_xcc_id() { return (unsigned)__builtin_amdgcn_s_getreg((3 << 11) | 20) & 0xFu; }
#define XB_SPIN(cond, bar) do { unsigned _sp = 0; while (cond) { __builtin_amdgcn_s_sleep(1); \
    if ((++_sp & 255u) == 0u) { if (xb_ld(&(bar)[XB_TMO])) break; if (_sp > XB_SPIN_CAP) { atomicAdd(&(bar)[XB_TMO], 1u); break; } } } } while (0)
struct XcdBarrier { unsigned* bar; unsigned x; volatile LAS unsigned* st; };
DI XcdBarrier xcd_barrier_post(unsigned* bar, volatile LAS unsigned* st) {
    XcdBarrier b; b.bar = bar; b.x = xb_xcc_id(); b.st = st;
    if (threadIdx.x == 0) (void)xb_add(&bar[XB_XCNT(b.x)], 1u);
    return b;
}
DI void xcd_barrier_complete(unsigned* bar, unsigned x, unsigned& nloc, unsigned& nx) {
    const unsigned G = gridDim.x * gridDim.y * gridDim.z;
    unsigned sum, cnt, mine, sp = 0u;
    for (;;) {
        sum = 0u; cnt = 0u; mine = 0u;
#pragma unroll
        for (unsigned j = 0; j < 16; ++j) { const unsigned c = xb_ld(&bar[XB_XCNT(j)]); sum += c; cnt += (c > 0u) ? 1u : 0u; mine = (j == x) ? c : mine; }
        if (sum == G) break;
        __builtin_amdgcn_s_sleep(1);
        if ((++sp & 255u) == 0u) { if (xb_ld(&bar[XB_TMO])) break; if (sp > XB_SPIN_CAP) { atomicAdd(&bar[XB_TMO], 1u); break; } }
    }
    nloc = mine > 0u ? mine : 1u; nx = cnt > 0u ? cnt : 1u;
}
DI void xcd_barrier(const XcdBarrier& b) {
    asm volatile("s_waitcnt vmcnt(0)" ::: "memory");
    __syncthreads();
    if (threadIdx.x == 0) {
        unsigned* bar = b.bar;
        __builtin_amdgcn_s_waitcnt(0);
        unsigned nloc = b.st[0], nx = b.st[1];
        if (nloc == 0u) { xcd_barrier_complete(bar, b.x, nloc, nx); b.st[0] = nloc; b.st[1] = nx; }
        const unsigned old = xb_add(&bar[XB_XSUB(b.x)], 1u);
        const unsigned gen = old / nloc;
        if (old + 1u == (gen + 1u) * nloc) {
            __builtin_amdgcn_fence(__ATOMIC_RELEASE, "agent");
            asm volatile("s_waitcnt vmcnt(0)" ::: "memory");
            const unsigned og = xb_add(&bar[XB_TOP], 1u);
            const unsigned tg = og / nx;
            if (og + 1u == (tg + 1u) * nx) xb_add(&bar[XB_TOPGEN], 1u);
            else XB_SPIN(xb_ld(&bar[XB_TOPGEN]) == tg, bar);
            __builtin_amdgcn_fence(__ATOMIC_ACQUIRE, "agent");
            xb_add(&bar[XB_XGEN(b.x)], 1u);
            asm volatile("s_waitcnt vmcnt(0)" ::: "memory");
        } else {
            XB_SPIN(xb_ld(&bar[XB_XGEN(b.x)]) == gen, bar);
            __builtin_amdgcn_fence(__ATOMIC_ACQUIRE, "agent");
            asm volatile("s_waitcnt vmcnt(0)" ::: "memory");
        }
    }
    __syncthreads();
}
namespace pg8 {
constexpr int BM = 256, BK = 64, HALF = 128, HTB = HALF * BK * 2, STAGE_BYTES = 8 * HTB, NXCD = 8, WGM = 8;
__host__ __device__ __forceinline__ int lds_byte(int r, int c) { const int st = (r >> 4) * 2 + (c >> 5), rr = r & 15, cc = c & 31, ob = rr * 64 + cc * 2; return st * 1024 + (ob ^ (((ob >> 9) & 1) << 5)); }
__host__ __device__ __forceinline__ void stage_rc(int b, int& R, int& C) { const int st = b / 1024, sb = b % 1024, swz = sb ^ (((sb >> 9) & 1) << 5); R = (st >> 1) * 16 + swz / 64; C = (st & 1) * 32 + (swz % 64) / 2; }
__host__ __device__ __forceinline__ int perm32(int rho) { const int n = rho >> 4, i = rho & 15; return 8 * (i >> 2) + 4 * n + (i & 3); }

struct Unit { int pm, pn, aux; };

struct TileOrder {
    int nM, nN, nwg, G, c;
    __device__ void init(int nM_, int nN_, int G_, int c_) { nM = nM_; nN = nN_; nwg = nM * nN; G = G_; c = c_; }
    __device__ bool tile(int i, int& pm, int& pn) const {
        const long L = (long)i * G + c; if (L >= nwg) return false;
        int wgid = (int)L; { const int q = nwg / NXCD, r = nwg % NXCD, xcd = wgid % NXCD, off = wgid / NXCD; wgid = (xcd < r ? xcd * (q + 1) : r * (q + 1) + (xcd - r) * q) + off; }
        const int nig = WGM * nN, gid = wgid / nig, fm = gid * WGM, gsz = (nM - fm) < WGM ? (nM - fm) : WGM;
        pm = fm + ((wgid % nig) % gsz); pn = (wgid % nig) / gsz; return true;
    }
};

template <class Epi, class Sched>
__device__ __forceinline__ void gemm_phase(LAS unsigned char* lds, const int K, const Sched& S, const Epi& E) {
    const int tid = ltid(), wid = __builtin_amdgcn_readfirstlane(tid >> 6), lane = tid & 63, wr = wid >> 2, wc = wid & 3, fr = lane & 15, fq = lane >> 4;
    const int nt = K / BK;
    unsigned voffA[2], voffB[2]; const int lda = S.lda;
#pragma unroll
    for (int i = 0; i < 2; ++i) { int R, C; stage_rc(tid * 16 + i * 8192, R, C); const int Rb = (R & ~31) + perm32(R & 31); voffA[i] = (unsigned)(R * lda + C) * 2u; voffB[i] = (unsigned)(Rb * K + C) * 2u; }
    const size_t kstep = (size_t)(BK * 2);
    const size_t hstep = (size_t)HALF * K * 2;
    const size_t hstepA = (size_t)HALF * lda * 2;
    const unsigned ldsw = (unsigned)wid * 1024u;
    const int aoff = lds_byte(wr * 64 + fr, fq * 8), boff = lds_byte(wc * 32 + fr, fq * 8);
#define PG8_SA(b, h) (((b) * 2 + (h)) * HTB)
#define PG8_SB(b, h) ((4 + (b) * 2 + (h)) * HTB)
#define PG8_STAGE(bufoff, gbase, voff) do { _Pragma("unroll") for (int _i = 0; _i < 2; ++_i) \
        __builtin_amdgcn_global_load_lds((const unsigned*)((const char*)(gbase) + (voff)[_i]), (LAS unsigned*)(lds + (bufoff) + ldsw + _i * 8192), 16, 0, 0); } while (0)
#define PG8_LDA(dst, b, h) do { _Pragma("unroll") for (int m = 0; m < 4; ++m) _Pragma("unroll") for (int k = 0; k < 2; ++k) dst[m][k] = *(const LAS bf16x8*)(lds + PG8_SA(b, h) + aoff + m * 2048 + k * 1024); } while (0)
#define PG8_LDB(dst, b, h) do { _Pragma("unroll") for (int n = 0; n < 2; ++n) _Pragma("unroll") for (int k = 0; k < 2; ++k) dst[n][k] = *(const LAS bf16x8*)(lds + PG8_SB(b, h) + boff + n * 2048 + k * 1024); } while (0)
#define PG8_MMA(ai, bj, At, Bt) do { __builtin_amdgcn_s_setprio(1); _Pragma("unroll") for (int m = 0; m < 4; ++m) _Pragma("unroll") for (int n = 0; n < 2; ++n) _Pragma("unroll") for (int k = 0; k < 2; ++k) \
        acc[ai][bj][m][n] = __builtin_amdgcn_mfma_f32_16x16x32_bf16(Bt[n][k], At[m][k], acc[ai][bj][m][n], 0, 0, 0); __builtin_amdgcn_s_setprio(0); } while (0)
#define PG8_WAIT_V(n) asm volatile("s_waitcnt vmcnt(" #n ")" ::: "memory")
#define PG8_WAIT_L(n) asm volatile("s_waitcnt lgkmcnt(" #n ")" ::: "memory")
#define PG8_BAR __builtin_amdgcn_s_barrier()
#define PG8_SCHED __builtin_amdgcn_sched_barrier(0)
    Unit cur, nxt; int ui = 0;
    if (!S.next(0, cur)) return;
    f32x4 acc[2][2][4][2];
#pragma unroll
    for (int a = 0; a < 2; ++a)
#pragma unroll
        for (int b = 0; b < 2; ++b)
#pragma unroll
            for (int m = 0; m < 4; ++m)
#pragma unroll
                for (int n = 0; n < 2; ++n) acc[a][b][m][n] = (f32x4){0.f, 0.f, 0.f, 0.f};
    bf16x8 At[4][2], B0[2][2], B1[2][2];
    const char* cA = S.a_base(cur); const char* cB = S.b_base(cur);
    PG8_STAGE(PG8_SB(0, 0), cB, voffB); PG8_STAGE(PG8_SB(0, 1), cB + hstep, voffB); PG8_STAGE(PG8_SA(0, 0), cA, voffA); PG8_STAGE(PG8_SA(0, 1), cA + hstepA, voffA);
    if (wr == 1) PG8_BAR;
    PG8_WAIT_V(2); PG8_BAR;
    PG8_STAGE(PG8_SB(1, 0), cB + kstep, voffB); PG8_STAGE(PG8_SA(1, 0), cA + kstep, voffA); PG8_STAGE(PG8_SB(1, 1), cB + hstep + kstep, voffB);
    PG8_WAIT_V(6); PG8_BAR;
    for (;;) {
        const bool has_next = S.next(ui + 1, nxt);
        const char* nA = has_next ? S.a_base(nxt) : cA; const char* nB = has_next ? S.b_base(nxt) : cB;
        for (int t = 0; t < nt; t += 2) {
            const bool last = (t == nt - 2);
            const char* a1 = cA + (size_t)(t + 1) * kstep;
            const char* a2 = last ? nA : cA + (size_t)(t + 2) * kstep; const char* b2 = last ? nB : cB + (size_t)(t + 2) * kstep;
            const char* a3 = a2 + kstep; const char* b3 = b2 + kstep;
            PG8_LDB(B0, 0, 0); PG8_LDB(B1, 0, 1); PG8_SCHED; PG8_LDA(At, 0, 0); PG8_STAGE(PG8_SA(1, 1), a1 + hstepA, voffA);
            PG8_WAIT_V(8); PG8_WAIT_L(0); PG8_BAR; PG8_MMA(0, 0, At, B0); PG8_MMA(0, 1, At, B1); PG8_BAR; PG8_SCHED;
            PG8_LDA(At, 0, 1); PG8_STAGE(PG8_SB(0, 0), b2, voffB); PG8_STAGE(PG8_SB(0, 1), b2 + hstep, voffB); PG8_STAGE(PG8_SA(0, 0), a2, voffA);
            PG8_WAIT_V(8); PG8_WAIT_L(0); PG8_BAR; PG8_MMA(1, 0, At, B0); PG8_MMA(1, 1, At, B1); PG8_BAR; PG8_SCHED;
            PG8_LDB(B0, 1, 0); PG8_LDB(B1, 1, 1); PG8_SCHED; PG8_LDA(At, 1, 0); PG8_STAGE(PG8_SA(0, 1), a2 + hstepA, voffA);
            PG8_WAIT_V(8); PG8_WAIT_L(0); PG8_BAR; PG8_MMA(0, 0, At, B0); PG8_MMA(0, 1, At, B1); PG8_BAR; PG8_SCHED;
            PG8_LDA(At, 1, 1); PG8_STAGE(PG8_SB(1, 0), b3, voffB); PG8_STAGE(PG8_SB(1, 1), b3 + hstep, voffB); PG8_STAGE(PG8_SA(1, 0), a3, voffA);
            PG8_WAIT_V(8); PG8_WAIT_L(0); PG8_BAR; PG8_MMA(1, 0, At, B0); PG8_MMA(1, 1, At, B1); PG8_BAR; PG8_SCHED;
        }
        if (wr == 0) PG8_BAR;
        E(acc, cur, wr, wc, fr, fq);
        if (!has_next) break;
#pragma unroll
        for (int a = 0; a < 2; ++a)
#pragma unroll
            for (int b = 0; b < 2; ++b)
#pragma unroll
                for (int m = 0; m < 4; ++m)
#pragma unroll
                    for (int n = 0; n < 2; ++n) acc[a][b][m][n] = (f32x4){0.f, 0.f, 0.f, 0.f};
        cur = nxt; cA = nA; cB = nB; ++ui;
        if (wr == 1) PG8_BAR;
    }
    PG8_WAIT_V(0);
    PG8_BAR;
#undef PG8_SA
#undef PG8_SB
#undef PG8_STAGE
#undef PG8_LDA
#undef PG8_LDB
#undef PG8_MMA
#undef PG8_WAIT_V
#undef PG8_WAIT_L
#undef PG8_BAR
#undef PG8_SCHED
}
}
struct Params {
    const float *x, *c, *ctx, *c_ctx, *w_mod, *b_mod, *w_in, *gate_bias, *norm_g, *rpb, *sg_ln_g, *sg_ln_b, *sg_w, *sg_b, *w_branch, *w_out,
                *ln1_g, *ln1_b, *router_w, *router_b, *w_gu, *b_gu, *w_dn, *b_dn, *ln2_g, *ln2_b;
    float* out; unsigned char* ws;
    int ph_lo, ph_hi, li, pad;
    size_t z;
};
template <class T> DI T* wsp(const Params& p, size_t off) { return (T*)(p.ws + (off + p.z)); }
#define SMP(o) (wsp<float>(p, WS_SM) + (o))

DI int row_of(int blk, int wave, int i) { return i < 16 ? blk * 128 + wave * 16 + i : ML + blk * 8 + wave; }
DI int bsel_of(int row) { return row < ML ? (row >> 12) : 8; }

template <int MAP> DI int cmap(int n) {
    if (MAP == 1) { if (n < 1024) return (n & ~127) + rope_d(n & 127); return n < 2048 ? n : n + 16; }
    if (MAP == 2) { const int u = n >> 3, e = n & 7; return e < 4 ? 4 * u + e : 1024 + 4 * u + (e - 4); }
    return n;
}
template <int MAP> DI void cvt_tile(const float* src, int ld, bf16_t* dst, int K, int k0, int n0, LAS float* tile) {
    const int tid = ltid();
    { const int kk = tid >> 7, n = tid & 127; const int sc = cmap<MAP>(n0 + n);
#pragma unroll 4
      for (int it = 0; it < 16; ++it) { const int k = it * 4 + kk; tile[k * 129 + n] = src[(size_t)(k0 + k) * ld + sc]; } }
    __syncthreads();
    { const int n = tid >> 2, kc = (tid & 3) * 16; unsigned w[8];
#pragma unroll
      for (int j = 0; j < 8; ++j) w[j] = pk2(tile[(kc + 2 * j) * 129 + n], tile[(kc + 2 * j + 1) * 129 + n]);
      bf16_t* d = dst + (size_t)(n0 + n) * K + k0 + kc;
      *(u32x4*)d = (u32x4){w[0], w[1], w[2], w[3]}; *(u32x4*)(d + 8) = (u32x4){w[4], w[5], w[6], w[7]}; }
    __syncthreads();
}
DI void phase_prologue_a(const Params& p, LAS unsigned char* lds) {
    const int tid = ltid(), G = lgdim(), blk = lbid();
    LAS float* tile = (LAS float*)lds;
    constexpr int T_IN = 4 * 16 * 60, T_BR = 12 * 8 * 8, T_OUT = 4 * 16 * 8, T_GU = 128 * 16 * 16, T_DN = 128 * 16 * 8;
    constexpr int T_ALL = T_IN + T_BR + T_OUT + T_GU + T_DN;
    for (int t = blk; t < T_ALL; t += G) {
        int u = t;
        if (u < T_IN) { const int l = u / 960, r = u % 960; cvt_tile<1>(p.w_in + (size_t)l * 1024 * DIN, DIN, wsp<bf16_t>(p, WS_WIN) + (size_t)l * NPROJ * 1024, 1024, (r / 60) * 64, (r % 60) * 128, tile); continue; }
        u -= T_IN;
        if (u < T_BR) { const int m = u / 64, r = u % 64; cvt_tile<0>(p.w_branch + (size_t)m * 512 * 1024, 1024, wsp<bf16_t>(p, WS_WBR) + (size_t)m * 1024 * 512, 512, (r / 8) * 64, (r % 8) * 128, tile); continue; }
        u -= T_BR;
        if (u < T_OUT) { const int l = u / 128, r = u % 128; cvt_tile<0>(p.w_out + (size_t)l * 1024 * 1024, 1024, wsp<bf16_t>(p, WS_WOUT) + (size_t)l * 1024 * 1024, 1024, (r / 8) * 64, (r % 8) * 128, tile); continue; }
        u -= T_OUT;
        if (u < T_GU) { const int m = u / 256, r = u % 256; cvt_tile<2>(p.w_gu + (size_t)m * 1024 * 2048, 2048, wsp<bf16_t>(p, WS_WGU) + (size_t)m * 2048 * 1024, 1024, (r / 16) * 64, (r % 16) * 128, tile); continue; }
        u -= T_GU;
        { const int m = u / 128, r = u % 128; cvt_tile<0>(p.w_dn + (size_t)m * 1024 * 1024, 1024, wsp<bf16_t>(p, WS_WDN) + (size_t)m * 1024 * 1024, 1024, (r / 8) * 64, (r % 8) * 128, tile); }
    }
    for (int i = blk * 512 + tid; i < 64 * 32; i += G * 512) { const int pos = i >> 5, f = i & 31; const float inv = powf(10000.0f, -(float)f / 32.0f); const float ang = (float)pos * inv;
        wsp<f32x2>(p, WS_ROPE)[i] = (f32x2){cosf(ang), sinf(ang)}; }
    for (int i = blk * 512 + tid; i < 4 * 16 * 1024; i += G * 512) { const int l = i >> 14, g = (i >> 10) & 15, k = i & 1023; wsp<float>(p, WS_WGATE)[i] = p.w_in[((size_t)l * 1024 + k) * DIN + 2048 + g]; }
    { const float* srcs[15] = {p.gate_bias, p.norm_g, p.rpb, p.sg_ln_g, p.sg_ln_b, p.sg_w, p.sg_b, p.ln1_g, p.ln1_b, p.router_w, p.router_b, p.b_gu, p.b_dn, p.ln2_g, p.ln2_b};
      const size_t offs[16] = {SM_GBIAS, SM_NORMG, SM_RPB, SM_SGLNG, SM_SGLNB, SM_SGW, SM_SGB, SM_LN1G, SM_LN1B, SM_RW, SM_RB, SM_BGU, SM_BDN, SM_LN2G, SM_LN2B, SM_END};
      float* dsm = wsp<float>(p, WS_SM);
#pragma unroll
      for (int a = 0; a < 15; ++a) { const int n = (int)(offs[a + 1] - offs[a]); const float* sp = srcs[a]; for (int i = blk * 512 + tid; i < n; i += G * 512) dsm[offs[a] + i] = sp[i]; } }
    LAS float* sl = (LAS float*)lds;
    LAS float* red = sl + 9 * 1024;
    for (int i = tid; i < 9 * 1024; i += 512) { const float v = i < 8192 ? p.c[i] : p.c_ctx[i - 8192]; sl[i] = v / (1.0f + __expf(-v)); }
    __syncthreads();
    for (int u = blk; u < 4 * 96; u += G) {
        const int l = u / 96, c0 = (u % 96) * 64, col = c0 + (tid & 63), kg = tid >> 6;
        float a[9];
#pragma unroll
        for (int b = 0; b < 9; ++b) a[b] = 0.f;
        const float* w = p.w_mod + ((size_t)l * 1024 + kg * 128) * 6144 + col;
#pragma unroll 4
        for (int k = 0; k < 128; ++k) { const float wv = w[(size_t)k * 6144];
#pragma unroll
            for (int b = 0; b < 9; ++b) a[b] += sl[b * 1024 + kg * 128 + k] * wv; }
#pragma unroll
        for (int b = 0; b < 9; ++b) red[(kg * 64 + (tid & 63)) * 9 + b] = a[b];
        __syncthreads();
        for (int i = tid; i < 64 * 9; i += 512) { const int cc = i / 9, b = i % 9; float s = 0.f;
#pragma unroll
            for (int g = 0; g < 8; ++g) s += red[(g * 64 + cc) * 9 + b];
            wsp<float>(p, WS_MOD)[((size_t)l * 9 + b) * 6144 + c0 + cc] = s + p.b_mod[(size_t)l * 6144 + c0 + cc]; }
        __syncthreads();
    }
}

DI void ld_row_f32(const float* p, float (&v)[16], int lane) {
#pragma unroll
    for (int j = 0; j < 4; ++j) { const f32x4 t = *(const f32x4*)(p + 256 * j + 4 * lane); v[4 * j] = t[0]; v[4 * j + 1] = t[1]; v[4 * j + 2] = t[2]; v[4 * j + 3] = t[3]; }
}
DI void st_row_f32(float* p, const float (&v)[16], int lane) {
#pragma unroll
    for (int j = 0; j < 4; ++j) *(f32x4*)(p + 256 * j + 4 * lane) = (f32x4){v[4 * j], v[4 * j + 1], v[4 * j + 2], v[4 * j + 3]};
}
DI void ld_row_bf16(const bf16_t* p, float (&v)[16], int lane) {
#pragma unroll
    for (int j = 0; j < 4; ++j) { const u32x2 t = *(const u32x2*)(p + 256 * j + 4 * lane); v[4 * j] = bflo(t[0]); v[4 * j + 1] = bfhi(t[0]); v[4 * j + 2] = bflo(t[1]); v[4 * j + 3] = bfhi(t[1]); }
}
DI void st_row_bf16(bf16_t* p, const float (&v)[16], int lane) {
#pragma unroll
    for (int j = 0; j < 4; ++j) *(u32x2*)(p + 256 * j + 4 * lane) = (u32x2){pk2(v[4 * j], v[4 * j + 1]), pk2(v[4 * j + 2], v[4 * j + 3])};
}
DI void ln_row(float (&v)[16], const float* g, const float* b, int lane) {
    float s = 0.f;
#pragma unroll
    for (int i = 0; i < 16; ++i) s += v[i];
    const float mean = wave_sum(s) * (1.0f / 1024.0f);
    float q = 0.f;
#pragma unroll
    for (int i = 0; i < 16; ++i) { const float d = v[i] - mean; q += d * d; }
    const float rstd = 1.0f / sqrtf(wave_sum(q) * (1.0f / 1024.0f) + LN_EPS);
    float gg[16], bb[16]; ld_row_f32(g, gg, lane); ld_row_f32(b, bb, lane);
#pragma unroll
    for (int i = 0; i < 16; ++i) v[i] = (v[i] - mean) * rstd * gg[i] + bb[i];
}
DI void modulate(const float (&v)[16], float (&h)[16], const float* sh, const float* sc, int lane) {
    float a[16], b[16]; ld_row_f32(sh, a, lane); ld_row_f32(sc, b, lane);
#pragma unroll
    for (int i = 0; i < 16; ++i) h[i] = v[i] * (1.0f + b[i]) + a[i];
}
template <int N> DI void row_dots2(const float (&ha)[16], const float (&hb)[16], const LAS float* wl, int lane, float& ra, float& rb) {
    f32x2 xa[8], xb[8], sa[N], sb[N];
#pragma unroll
    for (int i = 0; i < 8; ++i) { xa[i] = (f32x2){ha[2 * i], ha[2 * i + 1]}; xb[i] = (f32x2){hb[2 * i], hb[2 * i + 1]}; }
#pragma unroll
    for (int e = 0; e < N; ++e) { sa[e] = (f32x2){0.f, 0.f}; sb[e] = (f32x2){0.f, 0.f}; }
    const LAS float* wp = wl + 4 * lane;
#pragma unroll 1
    for (int j = 0; j < 4; ++j) {
#pragma unroll
        for (int e = 0; e < N; ++e) { const f32x4 w = *(const LAS f32x4*)(wp + e * 1024); const f32x2 w0 = (f32x2){w[0], w[1]}, w1 = (f32x2){w[2], w[3]};
            sa[e] = sa[e] + xa[0] * w0; sa[e] = sa[e] + xa[1] * w1; sb[e] = sb[e] + xb[0] * w0; sb[e] = sb[e] + xb[1] * w1; }
        wp += 256;
#pragma unroll
        for (int i = 0; i < 6; ++i) { xa[i] = xa[i + 2]; xb[i] = xb[i + 2]; }
    }
    float va[N], vb[N];
#pragma unroll
    for (int e = 0; e < N; ++e) { va[e] = sa[e][0] + sa[e][1]; vb[e] = sb[e][0] + sb[e][1]; }
    ra = bfly<N>(va, lane); rb = bfly<N>(vb, lane);
}
DI void load_small_w(LAS float* wl, const float* src, int n  ) { for (int i = ltid(); i < n / 4; i += 512) *(LAS f32x4*)(wl + 4 * i) = *(const f32x4*)(src + 4 * i); __syncthreads(); }

DI int pair_row(int blk, int wave, int pi) { return pi < 8 ? blk * 128 + wave * 16 + 2 * pi : ML + blk * 8 + 2 * wave; }
DI int n_pairs(int wave, bool with_ctx) { return (with_ctx && wave < 4) ? 9 : 8; }
DI void emit_h_and_gates2(const Params& p, int layer, int ra, const float (&xa)[16], const float (&xb)[16], const LAS float* wg, int lane) {
    float ha[16], hb[16]; const float* mod = wsp<float>(p, WS_MOD) + ((size_t)layer * 9 + bsel_of(ra)) * 6144;
    float sh[16], sc[16]; ld_row_f32(mod, sh, lane); ld_row_f32(mod + 1024, sc, lane);
#pragma unroll
    for (int i = 0; i < 16; ++i) { ha[i] = xa[i] * (1.0f + sc[i]) + sh[i]; hb[i] = xb[i] * (1.0f + sc[i]) + sh[i]; }
    st_row_bf16(wsp<bf16_t>(p, WS_H) + (size_t)ra * D, ha, lane); st_row_bf16(wsp<bf16_t>(p, WS_H) + (size_t)(ra + 1) * D, hb, lane);
    float ga, gb; row_dots2<16>(ha, hb, wg, lane, ga, gb);
    if ((lane & 3) == 0) { wsp<float>(p, WS_GPRE)[(size_t)ra * 16 + (lane >> 2)] = ga; wsp<float>(p, WS_GPRE)[(size_t)(ra + 1) * 16 + (lane >> 2)] = gb; }
}
DI void phase_init(const Params& p, LAS unsigned char* lds) {
    const int lane = ltid() & 63, wave = ltid() >> 6, blk = lbid();
    LAS float* wg = (LAS float*)lds; load_small_w(wg, wsp<float>(p, WS_WGATE), 16 * 1024);
#pragma unroll 1
    for (int pi = 0; pi < n_pairs(wave, true); ++pi) { const int ra = pair_row(blk, wave, pi);
        const float* src = ra < ML ? p.x + (size_t)ra * D : p.ctx + (size_t)(ra - ML) * D;
        float xa[16], xb[16]; ld_row_f32(src, xa, lane); ld_row_f32(src + D, xb, lane);
        st_row_f32(wsp<float>(p, WS_X) + (size_t)ra * D, xa, lane); st_row_f32(wsp<float>(p, WS_X) + (size_t)(ra + 1) * D, xb, lane);
        emit_h_and_gates2(p, 0, ra, xa, xb, wg, lane); }
}

DI void route_row(const Params& p, int row, float lg, LAS int* cnt, int lane) {
    const int me = lane >> 1; int rank = 0;
#pragma unroll
    for (int e = 0; e < 32; ++e) { const float o = rdl(lg, 2 * e); rank += (o > lg || (o == lg && e < me)) ? 1 : 0; }
    int te[4]; float tv[4];
#pragma unroll
    for (int k = 0; k < 4; ++k) { const unsigned long long mk = __builtin_amdgcn_ballot_w64(rank == k && (lane & 1) == 0); const int src = (int)__builtin_ctzll(mk | (1ull << 63)); te[k] = src >> 1; tv[k] = rdl(lg, src); }
    const float e1 = __expf(tv[1] - tv[0]), e2 = __expf(tv[2] - tv[0]), e3 = __expf(tv[3] - tv[0]); const float inv = 1.0f / (1.0f + e1 + e2 + e3);
    if (lane < 4) { const int e = lane == 0 ? te[0] : lane == 1 ? te[1] : lane == 2 ? te[2] : te[3]; const float gk = (lane == 0 ? 1.0f : lane == 1 ? e1 : lane == 2 ? e2 : e3) * inv;
        const int r = atomicAdd((int*)&cnt[e], 1);
        wsp<int>(p, WS_TOPE)[(size_t)row * 4 + lane] = e; wsp<float>(p, WS_TOPG)[(size_t)row * 4 + lane] = gk; wsp<int>(p, WS_TOPR)[(size_t)row * 4 + lane] = r; }
}
DI void ln_pair(float (&xa)[16], float (&xb)[16], const float* g, const float* b, int lane) {
    float s0 = 0.f, s1 = 0.f;
#pragma unroll
    for (int i = 0; i < 16; ++i) { s0 += xa[i]; s1 += xb[i]; }
    const float m0 = wave_sum(s0) * (1.0f / 1024.0f), m1 = wave_sum(s1) * (1.0f / 1024.0f);
    float q0 = 0.f, q1 = 0.f;
#pragma unroll
    for (int i = 0; i < 16; ++i) { const float d0 = xa[i] - m0, d1 = xb[i] - m1; q0 += d0 * d0; q1 += d1 * d1; }
    const float r0 = 1.0f / sqrtf(wave_sum(q0) * (1.0f / 1024.0f) + LN_EPS), r1 = 1.0f / sqrtf(wave_sum(q1) * (1.0f / 1024.0f) + LN_EPS);
    float gg[16], bb[16]; ld_row_f32(g, gg, lane); ld_row_f32(b, bb, lane);
#pragma unroll
    for (int i = 0; i < 16; ++i) { xa[i] = (xa[i] - m0) * r0 * gg[i] + bb[i]; xb[i] = (xb[i] - m1) * r1 * gg[i] + bb[i]; }
}
DI void phase_ln1_router(const Params& p, int layer, LAS unsigned char* lds) {
    const int tid = ltid(), lane = tid & 63, wave = tid >> 6, blk = lbid();
    LAS float* rw = (LAS float*)lds;
    LAS int* cnt = (LAS int*)(lds + 32 * 1024 * 4);
    { const float* src = SMP(SM_RW) + (size_t)layer * 1024 * 32;
      for (int i = tid; i < 32 * 1024; i += 512) { const int k = i >> 5, e = i & 31; rw[e * 1024 + k] = src[i]; }
      if (tid < 32) cnt[tid] = 0; }
    __syncthreads();
    const bool last = (layer == DEPTH - 1);
    const float rbias = SMP(SM_RB)[layer * 32 + (lane >> 1)];
    const int np = n_pairs(wave, !last);
    float xa[16], xb[16]; u32x2 ya[4], yb[4];
    { const int ra = pair_row(blk, wave, 0); ld_row_f32(wsp<float>(p, WS_X) + (size_t)ra * D, xa, lane); ld_row_f32(wsp<float>(p, WS_X) + (size_t)(ra + 1) * D, xb, lane);
#pragma unroll
      for (int j = 0; j < 4; ++j) { ya[j] = *(const u32x2*)(wsp<bf16_t>(p, WS_Y) + (size_t)ra * D + 256 * j + 4 * lane); yb[j] = *(const u32x2*)(wsp<bf16_t>(p, WS_Y) + (size_t)(ra + 1) * D + 256 * j + 4 * lane); } }
#pragma unroll 1
    for (int pi = 0; pi < np; ++pi) { const int ra = pair_row(blk, wave, pi);
        const float* mod = wsp<float>(p, WS_MOD) + ((size_t)layer * 9 + bsel_of(ra)) * 6144;
        float za[16], zb[16]; { float g1[16]; ld_row_f32(mod + 2 * 1024, g1, lane);
#pragma unroll
          for (int j = 0; j < 4; ++j) { za[4 * j] = DN_ALPHA * xa[4 * j] + g1[4 * j] * bflo(ya[j][0]); za[4 * j + 1] = DN_ALPHA * xa[4 * j + 1] + g1[4 * j + 1] * bfhi(ya[j][0]); za[4 * j + 2] = DN_ALPHA * xa[4 * j + 2] + g1[4 * j + 2] * bflo(ya[j][1]); za[4 * j + 3] = DN_ALPHA * xa[4 * j + 3] + g1[4 * j + 3] * bfhi(ya[j][1]);
              zb[4 * j] = DN_ALPHA * xb[4 * j] + g1[4 * j] * bflo(yb[j][0]); zb[4 * j + 1] = DN_ALPHA * xb[4 * j + 1] + g1[4 * j + 1] * bfhi(yb[j][0]); zb[4 * j + 2] = DN_ALPHA * xb[4 * j + 2] + g1[4 * j + 2] * bflo(yb[j][1]); zb[4 * j + 3] = DN_ALPHA * xb[4 * j + 3] + g1[4 * j + 3] * bfhi(yb[j][1]); } }
        if (pi + 1 < np) { const int rn = pair_row(blk, wave, pi + 1);
            ld_row_f32(wsp<float>(p, WS_X) + (size_t)rn * D, xa, lane); ld_row_f32(wsp<float>(p, WS_X) + (size_t)(rn + 1) * D, xb, lane);
#pragma unroll
            for (int j = 0; j < 4; ++j) { ya[j] = *(const u32x2*)(wsp<bf16_t>(p, WS_Y) + (size_t)rn * D + 256 * j + 4 * lane); yb[j] = *(const u32x2*)(wsp<bf16_t>(p, WS_Y) + (size_t)(rn + 1) * D + 256 * j + 4 * lane); } }
        ln_pair(za, zb, SMP(SM_LN1G) + (size_t)layer * D, SMP(SM_LN1B) + (size_t)layer * D, lane);
        st_row_f32(wsp<float>(p, WS_X) + (size_t)ra * D, za, lane); st_row_f32(wsp<float>(p, WS_X) + (size_t)(ra + 1) * D, zb, lane);
        float ha[16], hb[16]; { float sh[16], sc[16]; ld_row_f32(mod + 3 * 1024, sh, lane); ld_row_f32(mod + 4 * 1024, sc, lane);
#pragma unroll
          for (int i = 0; i < 16; ++i) { ha[i] = za[i] * (1.0f + sc[i]) + sh[i]; hb[i] = zb[i] * (1.0f + sc[i]) + sh[i]; } }
        st_row_bf16(wsp<bf16_t>(p, WS_H2) + (size_t)ra * D, ha, lane); st_row_bf16(wsp<bf16_t>(p, WS_H2) + (size_t)(ra + 1) * D, hb, lane);
        float la, lb; row_dots2<32>(ha, hb, rw, lane, la, lb);
        route_row(p, ra, la + rbias, cnt, lane); route_row(p, ra + 1, lb + rbias, cnt, lane);
    }
    __syncthreads();
    if (tid < 32) { const int c = cnt[tid]; int base = 0; if (c > 0) base = (int)atomicAdd(wsp<unsigned>(p, WS_CTL) + CW_CNT + layer * 32 + tid, (unsigned)c); wsp<int>(p, WS_BASE)[blk * 32 + tid] = base; }
}

DI void phase_scatter(const Params& p, int layer, LAS unsigned char* lds) {
    const int tid = ltid(), lane = tid & 63, wave = tid >> 6, blk = lbid();
    LAS int* pst = (LAS int*)lds;
    if (tid == 0) { int acc = 0; for (int e = 0; e < 32; ++e) { const int c = (int)__hip_atomic_load(wsp<unsigned>(p, WS_CTL) + CW_CNT + layer * 32 + e, __ATOMIC_RELAXED, __HIP_MEMORY_SCOPE_AGENT); pst[e] = acc; pst[32 + e] = c; acc += (c + 255) & ~255; } pst[64] = acc >> 8; }
    __syncthreads();
    if (blk == 0) { int* be = wsp<int>(p, WS_BLKE); if (tid == 0) be[0] = pst[64];
#pragma unroll 1
        for (int e = 0; e < 32; ++e) { const int b0 = pst[e] >> 8, nb = (pst[32 + e] + 255) >> 8; for (int j = tid; j < nb; j += 512) be[1 + b0 + j] = e; } }
    const bool last = (layer == DEPTH - 1);
#pragma unroll 1
    for (int i = 0; i < 17; ++i) { const int row = row_of(blk, wave, i);
        if (last && row >= ML) continue;
        const u32x4* src = (const u32x4*)(wsp<bf16_t>(p, WS_H2) + (size_t)row * D);
        const u32x4 v0 = src[lane], v1 = src[64 + lane];
#pragma unroll
        for (int k = 0; k < 4; ++k) { const int e = wsp<int>(p, WS_TOPE)[(size_t)row * 4 + k], r = wsp<int>(p, WS_TOPR)[(size_t)row * 4 + k];
            const int dest = pst[e] + wsp<int>(p, WS_BASE)[blk * 32 + e] + r;
            if (lane == 0) wsp<int>(p, WS_DEST)[(size_t)row * 4 + k] = dest;
            u32x4* d = (u32x4*)(wsp<bf16_t>(p, WS_XG) + (size_t)dest * D); d[lane] = v0; d[64 + lane] = v1; }
    }
}

DI void phase_ln2(const Params& p, int layer, LAS unsigned char* lds) {
    const int tid = ltid(), lane = tid & 63, wave = tid >> 6, blk = lbid();
    const bool last = (layer == DEPTH - 1);
    LAS float* wg = (LAS float*)lds;
    if (!last) load_small_w(wg, wsp<float>(p, WS_WGATE) + (size_t)(layer + 1) * 16 * 1024, 16 * 1024);
    const int np = n_pairs(wave, !last);
#pragma unroll 1
    for (int pi = 0; pi < np; ++pi) { const int ra = pair_row(blk, wave, pi);
        const float* mod = wsp<float>(p, WS_MOD) + ((size_t)layer * 9 + bsel_of(ra)) * 6144;
        int da[4], db[4]; float ka[4], kb[4];
#pragma unroll
        for (int k = 0; k < 4; ++k) { da[k] = wsp<int>(p, WS_DEST)[(size_t)ra * 4 + k]; db[k] = wsp<int>(p, WS_DEST)[(size_t)ra * 4 + 4 + k]; ka[k] = wsp<float>(p, WS_TOPG)[(size_t)ra * 4 + k]; kb[k] = wsp<float>(p, WS_TOPG)[(size_t)ra * 4 + 4 + k]; }
        float xa[16], xb[16], g2[16]; ld_row_f32(wsp<float>(p, WS_X) + (size_t)ra * D, xa, lane); ld_row_f32(wsp<float>(p, WS_X) + (size_t)(ra + 1) * D, xb, lane); ld_row_f32(mod + 5 * 1024, g2, lane);
        float fa[16], fb[16];
#pragma unroll
        for (int j = 0; j < 16; ++j) { fa[j] = 0.f; fb[j] = 0.f; }
#pragma unroll
        for (int k = 0; k < 4; ++k) { float y0[16], y1[16]; ld_row_bf16(wsp<bf16_t>(p, WS_YS) + (size_t)da[k] * D, y0, lane); ld_row_bf16(wsp<bf16_t>(p, WS_YS) + (size_t)db[k] * D, y1, lane);
#pragma unroll
            for (int j = 0; j < 16; ++j) { fa[j] += ka[k] * y0[j]; fb[j] += kb[k] * y1[j]; } }
#pragma unroll
        for (int j = 0; j < 16; ++j) { xa[j] = DN_ALPHA * xa[j] + g2[j] * fa[j]; xb[j] = DN_ALPHA * xb[j] + g2[j] * fb[j]; }
        ln_pair(xa, xb, SMP(SM_LN2G) + (size_t)layer * D, SMP(SM_LN2B) + (size_t)layer * D, lane);
        if (last) { st_row_f32(p.out + (size_t)ra * D, xa, lane); st_row_f32(p.out + (size_t)(ra + 1) * D, xb, lane); }
        else { st_row_f32(wsp<float>(p, WS_X) + (size_t)ra * D, xa, lane); st_row_f32(wsp<float>(p, WS_X) + (size_t)(ra + 1) * D, xb, lane); emit_h_and_gates2(p, layer + 1, ra, xa, xb, wg, lane); }
    }
}
using pg8::Unit;
struct SchedDense {
    pg8::TileOrder T; const bf16_t* A; int lda; const bf16_t* Bt; int K;
    DI bool next(int i, Unit& u) const { u.aux = 0; return T.tile(i, u.pm, u.pn); }
    DI const char* a_base(const Unit& u) const { return (const char*)(A + (size_t)u.pm * 256 * lda); }
    DI const char* b_base(const Unit& u) const { return (const char*)(Bt + (size_t)u.pn * 256 * K); }
};
struct SchedMerge {
    pg8::TileOrder T; const bf16_t* A; const bf16_t* Bt; static constexpr int lda = 1536;
    DI bool next(int i, Unit& u) const { u.aux = i % 3; return T.tile(i / 3, u.pm, u.pn); }
    DI const char* a_base(const Unit& u) const { return (const char*)(A + (size_t)u.pm * 256 * 1536 + u.aux * 512); }
    DI const char* b_base(const Unit& u) const { return (const char*)(Bt + ((size_t)u.aux * 1024 + (size_t)u.pn * 256) * 512); }
};
template <int NT> struct SchedMoe {
    const int* blke; int nunits, G, c; const bf16_t* A; const bf16_t* Bt; size_t bstride; static constexpr int lda = 1024;
    DI void init(const int* blke_, int G_, int c_) { blke = blke_; nunits = blke_[0] * NT; G = G_; c = c_; }
    DI bool next(int i, Unit& u) const { constexpr int RB = 32 / NT; const int rb = (i * 8 + (c & 7)) * RB + (c >> 3) / NT; if (rb * NT >= nunits) return false; u.pm = rb; u.pn = (c >> 3) % NT; u.aux = blke[1 + rb]; return true; }
    DI const char* a_base(const Unit& u) const { return (const char*)(A + (size_t)u.pm * 256 * 1024); }
    DI const char* b_base(const Unit& u) const { return (const char*)(Bt + (size_t)u.aux * bstride + (size_t)u.pn * 256 * 1024); }
};

#define EPI_ROWS_BEGIN _Pragma("unroll") for (int ai = 0; ai < 2; ++ai) _Pragma("unroll") for (int m = 0; m < 4; ++m) { const int row = u.pm * 256 + ai * 128 + wr * 64 + m * 16 + fr;
#define EPI_ROWS_END }
DI u32x4 pack8(const f32x4& a, const f32x4& b) { return (u32x4){cvt_pk_bf16(a[0], a[1]), cvt_pk_bf16(a[2], a[3]), cvt_pk_bf16(b[0], b[1]), cvt_pk_bf16(b[2], b[3])}; }

struct EpiInproj {
    bf16_t* P; const f32x2* rope;
    DI void operator()(const f32x4 (&acc)[2][2][4][2], const Unit& u, int wr, int wc, int fr, int fq) const {
        const int pn = u.pn; const int colb = pn * 256 + wc * 32 + 8 * fq;
        const int kind = pn < 2 ? 0 : pn < 4 ? 1 : pn < 6 ? 2 : pn < 8 ? 3 : pn < 10 ? 4 : pn < 14 ? 2 : pn < 18 ? 5 : 3;
        const bool latent = u.pm < 128;
        const int ra = wc >> 1, f0 = ((wc & 1) * 4 + fq) * 4;
        EPI_ROWS_BEGIN
            bf16_t* rowp = P + (size_t)row * NPROJ + colb;
            f32x4 cs[2]; if (kind <= 1 && latent) { const int t = row & 4095; const int pos = ra ? (t & 63) : (t >> 6); const f32x4* rp = (const f32x4*)(rope + pos * 32 + f0); cs[0] = rp[0]; cs[1] = rp[1]; }
#pragma unroll
            for (int bj = 0; bj < 2; ++bj) { f32x4 v0 = acc[ai][bj][m][0], v1 = acc[ai][bj][m][1];
                if (kind == 0) { v0 = v0 * 0.08838834764831845f; v1 = v1 * 0.08838834764831845f; }
                if (kind == 4) { v0 = v0 * 0.18033688011112042f; v1 = v1 * 0.18033688011112042f; }
                if (kind <= 1 && latent) {
                    const float c[4] = {cs[0][0], cs[0][2], cs[1][0], cs[1][2]}, s[4] = {cs[0][1], cs[0][3], cs[1][1], cs[1][3]};
#pragma unroll
                    for (int j = 0; j < 4; ++j) { const float x1 = v0[j], x2 = v1[j]; v0[j] = x1 * c[j] - x2 * s[j]; v1[j] = x2 * c[j] + x1 * s[j]; } }
                if (kind == 3) {
#pragma unroll
                    for (int j = 0; j < 4; ++j) { v0[j] = sigmoidf_(v0[j]); v1[j] = sigmoidf_(v1[j]); } }
                if (kind == 5) {
#pragma unroll
                    for (int j = 0; j < 4; ++j) { v0[j] = gelu_tanh(v0[j]); v1[j] = gelu_tanh(v1[j]); } }
                *(u32x4*)(rowp + bj * 128) = pack8(v0, v1); }
        EPI_ROWS_END
    }
};
struct EpiMerge {
    bf16_t* Mg; const bf16_t* P;
    DI void operator()(const f32x4 (&acc)[2][2][4][2], const Unit& u, int wr, int wc, int fr, int fq) const {
        const int colb = u.pn * 256 + wc * 32 + 8 * fq;
        EPI_ROWS_BEGIN
#pragma unroll
            for (int bj = 0; bj < 2; ++bj) { const int col = colb + bj * 128;
                const u32x4 g = *(const u32x4*)(P + (size_t)row * NPROJ + PBG + u.aux * 1024 + col);
                f32x4 v0 = acc[ai][bj][m][0], v1 = acc[ai][bj][m][1];
                v0 = v0 * (f32x4){bflo(g[0]), bfhi(g[0]), bflo(g[1]), bfhi(g[1])}; v1 = v1 * (f32x4){bflo(g[2]), bfhi(g[2]), bflo(g[3]), bfhi(g[3])};
                u32x4* dst = (u32x4*)(Mg + (size_t)row * D + col);
                if (u.aux > 0) { const u32x4 o = *dst; v0 = v0 + (f32x4){bflo(o[0]), bfhi(o[0]), bflo(o[1]), bfhi(o[1])}; v1 = v1 + (f32x4){bflo(o[2]), bfhi(o[2]), bflo(o[3]), bfhi(o[3])}; }
                *dst = pack8(v0, v1); }
        EPI_ROWS_END
    }
};
struct EpiStore {
    bf16_t* O; int ldo; const float* bias; int bias_stride;
    DI void operator()(const f32x4 (&acc)[2][2][4][2], const Unit& u, int wr, int wc, int fr, int fq) const {
        const int colb = u.pn * 256 + wc * 32 + 8 * fq;
        f32x4 bv[2][2];
#pragma unroll
        for (int bj = 0; bj < 2; ++bj)
#pragma unroll
            for (int n = 0; n < 2; ++n) bv[bj][n] = bias ? *(const f32x4*)(bias + (size_t)u.aux * bias_stride + colb + bj * 128 + 4 * n) : (f32x4){0.f, 0.f, 0.f, 0.f};
        EPI_ROWS_BEGIN
#pragma unroll
            for (int bj = 0; bj < 2; ++bj) *(u32x4*)(O + (size_t)row * ldo + colb + bj * 128) = pack8(acc[ai][bj][m][0] + bv[bj][0], acc[ai][bj][m][1] + bv[bj][1]);
        EPI_ROWS_END
    }
};
struct EpiGu {
    bf16_t* ACT; const float* b_gu;
    DI void operator()(const f32x4 (&acc)[2][2][4][2], const Unit& u, int wr, int wc, int fr, int fq) const {
        f32x4 bg[2], bu[2];
#pragma unroll
        for (int bj = 0; bj < 2; ++bj) { const int oc = u.pn * 128 + bj * 64 + wc * 16 + 4 * fq; bg[bj] = *(const f32x4*)(b_gu + (size_t)u.aux * 2048 + oc); bu[bj] = *(const f32x4*)(b_gu + (size_t)u.aux * 2048 + 1024 + oc); }
        EPI_ROWS_BEGIN
#pragma unroll
            for (int bj = 0; bj < 2; ++bj) { const int oc = u.pn * 128 + bj * 64 + wc * 16 + 4 * fq;
                const f32x4 g = acc[ai][bj][m][0] + bg[bj], up = acc[ai][bj][m][1] + bu[bj]; float a[4];
#pragma unroll
                for (int j = 0; j < 4; ++j) { const float gt = fminf(g[j], 7.0f), ut = fminf(fmaxf(up[j], -7.0f), 7.0f); a[j] = gt * sigmoidf_(1.702f * gt) * (ut + 1.0f); }
                *(u32x2*)(ACT + (size_t)row * 1024 + oc) = (u32x2){cvt_pk_bf16(a[0], a[1]), cvt_pk_bf16(a[2], a[3])}; }
        EPI_ROWS_END
    }
};

DI void phase_inproj(const Params& p, int layer, LAS unsigned char* lds) {
    SchedDense S; S.T.init(MT / 256, NPROJ / 256, lgdim(), lbid()); S.A = wsp<bf16_t>(p, WS_H); S.lda = 1024; S.Bt = wsp<bf16_t>(p, WS_WIN) + (size_t)layer * NPROJ * 1024; S.K = 1024;
    EpiInproj E{wsp<bf16_t>(p, WS_P), wsp<f32x2>(p, WS_ROPE)};
    pg8::gemm_phase(lds, 1024, S, E);
}
DI void phase_merge(const Params& p, int layer, LAS unsigned char* lds) {
    SchedMerge S; S.T.init(MT / 256, 4, lgdim(), lbid()); S.A = wsp<bf16_t>(p, WS_ABC); S.Bt = wsp<bf16_t>(p, WS_WBR) + (size_t)layer * 3 * 1024 * 512;
    EpiMerge E{wsp<bf16_t>(p, WS_MRG), wsp<bf16_t>(p, WS_P)};
    pg8::gemm_phase(lds, 512, S, E);
}
DI void phase_outproj(const Params& p, int layer, LAS unsigned char* lds) {
    SchedDense S; S.T.init(MT / 256, 4, lgdim(), lbid()); S.A = wsp<bf16_t>(p, WS_MRG); S.lda = 1024; S.Bt = wsp<bf16_t>(p, WS_WOUT) + (size_t)layer * 1024 * 1024; S.K = 1024;
    EpiStore E{wsp<bf16_t>(p, WS_Y), 1024, nullptr, 0};
    pg8::gemm_phase(lds, 1024, S, E);
}
DI void phase_moe_gu(const Params& p, int layer, LAS unsigned char* lds) {
    SchedMoe<8> S; S.init(wsp<int>(p, WS_BLKE), lgdim(), lbid()); S.A = wsp<bf16_t>(p, WS_XG); S.Bt = wsp<bf16_t>(p, WS_WGU) + (size_t)layer * 32 * 2048 * 1024; S.bstride = (size_t)2048 * 1024;
    EpiGu E{wsp<bf16_t>(p, WS_ACT), SMP(SM_BGU) + (size_t)layer * 32 * 2048};
    pg8::gemm_phase(lds, 1024, S, E);
}
DI void phase_moe_dn(const Params& p, int layer, LAS unsigned char* lds) {
    SchedMoe<4> S; S.init(wsp<int>(p, WS_BLKE), lgdim(), lbid()); S.A = wsp<bf16_t>(p, WS_ACT); S.Bt = wsp<bf16_t>(p, WS_WDN) + (size_t)layer * 32 * 1024 * 1024; S.bstride = (size_t)1024 * 1024;
    EpiStore E{wsp<bf16_t>(p, WS_YS), 1024, SMP(SM_BDN) + (size_t)layer * 32 * 1024, 1024};
    pg8::gemm_phase(lds, 1024, S, E);
}
DI int chain_tok(int dir, int b, int j, int tau) {
    if (dir == 0) return j < 4 ? ML + b * 256 + j * 64 + tau : b * 4096 + (j - 4) * 64 + tau;
    return j < 4 ? ML + b * 256 + (3 - j) * 64 + (63 - tau) : b * 4096 + (67 - j) * 64 + (63 - tau);
}
DI void phase_gates(const Params& p, int layer) {
    const int lane = ltid() & 63, gw = lbid() * 8 + (ltid() >> 6), nw = lgdim() * 8;
    const float* gb = SMP(SM_GBIAS) + layer * 16;
    for (int u = gw; u < NCHAIN * NSLOT; u += nw) {
        const int ch = u / NSLOT, j = u % NSLOT, dir = ch >> 5, b = (ch >> 2) & 7, h = ch & 3;
        const int tok = chain_tok(dir, b, j, lane);
        const float* g = wsp<float>(p, WS_GPRE) + (size_t)tok * 16;
        const float li = g[(dir * 2) * 4 + h] + gb[(dir * 2) * 4 + h];
        const float lf = log_sigmoid(g[(dir * 2 + 1) * 4 + h] + gb[(dir * 2 + 1) * 4 + h]);
        float bc = lf;
#pragma unroll
        for (int o = 1; o < 64; o <<= 1) { const float t = __shfl_up(bc, o); if (lane >= o) bc += t; }
        const float a = li - bc; float cm = a;
#pragma unroll
        for (int o = 1; o < 64; o <<= 1) { const float t = __shfl_up(cm, o); if (lane >= o) cm = fmaxf(cm, t); }
        const size_t o = (size_t)u * 64 + lane;
        wsp<float>(p, WS_GA)[o] = a; wsp<float>(p, WS_GCM)[o] = cm; wsp<float>(p, WS_GB)[o] = bc;
    }
}
DI float chain_m(const Params& p, int ch, int j) {
    const float* gcm = wsp<float>(p, WS_GCM) + (size_t)ch * NSLOT * 64 + 63; const float* gbb = wsp<float>(p, WS_GB) + (size_t)ch * NSLOT * 64 + 63;
    float m = 0.f; for (int i = 0; i < j; ++i) m = gbb[i * 64] + fmaxf(m, gcm[i * 64]); return m;
}
DI float chain_m_wave(const Params& p, int ch, int j, int lane) {
    const float* gcm = wsp<float>(p, WS_GCM) + (size_t)ch * NSLOT * 64 + 63; const float* gbb = wsp<float>(p, WS_GB) + (size_t)ch * NSLOT * 64 + 63;
    float A = gbb[lane * 64], B = gcm[lane * 64] + A;
    float xa[4], xb[4];
#pragma unroll
    for (int i = 0; i < 4; ++i) { xa[i] = gbb[(64 + i) * 64]; xb[i] = gcm[(64 + i) * 64] + xa[i]; }
#pragma unroll
    for (int o = 1; o < 64; o <<= 1) { const float fa = __shfl_up(A, o), fb = __shfl_up(B, o); if (lane >= o) { B = fmaxf(fb + A, B); A = fa + A; } }
    const float mi = fmaxf(A, B);
    float m = j == 0 ? 0.f : __shfl(mi, (j < 64 ? j : 64) - 1);
#pragma unroll
    for (int i = 0; i < 3; ++i) if (64 + i < j) m = fmaxf(m + xa[i], xb[i]);
    return m;
}

#define MFMA16(a, b, c) __builtin_amdgcn_mfma_f32_16x16x32_bf16((a), (b), (c), 0, 0, 0)
DI bf16x8 tr_frag(LAS unsigned char* base, int off0, int off1) {
    const s16x4 lo = __builtin_amdgcn_ds_read_tr16_b64_v4i16((LAS s16x4*)(base + off0)); const s16x4 hi = __builtin_amdgcn_ds_read_tr16_b64_v4i16((LAS s16x4*)(base + off1));
    return __builtin_shufflevector(lo, hi, 0, 1, 2, 3, 4, 5, 6, 7);
}
DI bf16x8 pack_frag(const float (&a)[4], const float (&b)[4]) { const u32x4 w = (u32x4){cvt_pk_bf16(a[0], a[1]), cvt_pk_bf16(a[2], a[3]), cvt_pk_bf16(b[0], b[1]), cvt_pk_bf16(b[2], b[3])}; return __builtin_bit_cast(bf16x8, w); }

DI void mlstm_u_unit(const Params& p, int u, LAS unsigned char* lds) {
    const int tid = ltid(), lane = tid & 63, wave = __builtin_amdgcn_readfirstlane(tid >> 6), g = lane >> 4, c = lane & 15;
    const int ch = u / (NSLOT - 1), j = u % (NSLOT - 1), dir = ch >> 5, b = (ch >> 2) & 7, h = ch & 3;
    const int tokb = dir == 0 ? (j < 4 ? ML + b * 256 + j * 64 : b * 4096 + (j - 4) * 64) : (j < 4 ? ML + b * 256 + (3 - j) * 64 : b * 4096 + (67 - j) * 64);
    constexpr int VS = 304, KS = 272;
    LAS unsigned char* Vs = lds; LAS unsigned char* Kw = lds + 64 * VS; LAS float* wl = (LAS float*)(lds + 64 * VS + 64 * KS);
    const size_t slot = (size_t)ch * NSLOT + j;
    if (tid < 64) { const int tau = dir ? 63 - tid : tid; const float mj = chain_m_wave(p, ch, j, tid); const float Mend = fmaxf(mj, wsp<float>(p, WS_GCM)[slot * 64 + 63]); wl[tid] = __expf(wsp<float>(p, WS_GA)[slot * 64 + tau] - Mend); }
    __syncthreads();
    { const int s = tid >> 3, pc = tid & 7; const bf16_t* row = wsp<bf16_t>(p, WS_P) + (size_t)(tokb + s) * NPROJ + h * 128 + pc * 16;
      const u32x4 v0 = *(const u32x4*)(row + PV), v1 = *(const u32x4*)(row + PV + 8); *(LAS u32x4*)(Vs + s * VS + pc * 32) = v0; *(LAS u32x4*)(Vs + s * VS + pc * 32 + 16) = v1;
      const u32x4 k0 = *(const u32x4*)(row + PK), k1 = *(const u32x4*)(row + PK + 8); const float w = wl[s]; u32x4 o0, o1;
#pragma unroll
      for (int e = 0; e < 4; ++e) { o0[e] = cvt_pk_bf16(w * bflo(k0[e]), w * bfhi(k0[e])); o1[e] = cvt_pk_bf16(w * bflo(k1[e]), w * bfhi(k1[e])); }
      *(LAS u32x4*)(Kw + s * KS + pc * 32) = o0; *(LAS u32x4*)(Kw + s * KS + pc * 32 + 16) = o1;
      *(LAS unsigned*)(Vs + s * VS + 256 + pc * 4) = pc == 0 ? 0x3F80u : 0u; }
    __syncthreads();
    bf16x8 kf[2];
#pragma unroll
    for (int kk = 0; kk < 2; ++kk) { const int o = (32 * kk + 8 * g + (c >> 2)) * KS + (16 * wave + 4 * (c & 3)) * 2; kf[kk] = tr_frag(Kw, o, o + 4 * KS); }
    bf16_t* uc = wsp<bf16_t>(p, WS_UC) + slot * 16384; float* un = wsp<float>(p, WS_UN) + slot * 128;
#pragma unroll
    for (int vb = 0; vb < 9; ++vb) { f32x4 acc = (f32x4){0.f, 0.f, 0.f, 0.f};
#pragma unroll
        for (int kk = 0; kk < 2; ++kk) { const int o = (32 * kk + 8 * g + (c >> 2)) * VS + (16 * vb + 4 * (c & 3)) * 2; acc = MFMA16(kf[kk], tr_frag(Vs, o, o + 4 * VS), acc); }
        if (vb < 8) *(u32x2*)(uc + (16 * vb + c) * 128 + 16 * wave + 4 * g) = (u32x2){cvt_pk_bf16(acc[0], acc[1]), cvt_pk_bf16(acc[2], acc[3])};
        else if (c == 0) *(f32x4*)(un + 16 * wave + 4 * g) = acc; }
    __syncthreads();
}
DI void phase_scan(const Params& p) {
    const int gt = lbid() * 512 + ltid(), nthr = lgdim() * 512;
    for (int w = gt; w < NCHAIN * 2048; w += nthr) {
        const int ch = w >> 11, e8 = w & 2047;
        const float* gcm = wsp<float>(p, WS_GCM) + (size_t)ch * NSLOT * 64 + 63; const float* gbb = wsp<float>(p, WS_GB) + (size_t)ch * NSLOT * 64 + 63;
        u32x4* base = (u32x4*)(wsp<bf16_t>(p, WS_UC) + (size_t)ch * NSLOT * 16384) + e8;
        float* nb = wsp<float>(p, WS_UN) + (size_t)ch * NSLOT * 128 + e8;
        float c[8], nn = 0.f, m = 0.f;
#pragma unroll
        for (int i = 0; i < 8; ++i) c[i] = 0.f;
        for (int j = 0; j < NSLOT; ++j) {
            u32x4 uu = (u32x4){0u, 0u, 0u, 0u}; float un = 0.f;
            if (j < NSLOT - 1) { uu = base[(size_t)j * 2048]; if (e8 < 128) un = nb[j * 128]; }
            base[(size_t)j * 2048] = (u32x4){pk2(c[0], c[1]), pk2(c[2], c[3]), pk2(c[4], c[5]), pk2(c[6], c[7])};
            if (e8 < 128) nb[j * 128] = nn;
            const float cme = gcm[j * 64], be = gbb[j * 64]; const float Mend = fmaxf(m, cme); const float dec = __expf(m - Mend); m = be + Mend;
            c[0] = dec * c[0] + bflo(uu[0]); c[1] = dec * c[1] + bfhi(uu[0]); c[2] = dec * c[2] + bflo(uu[1]); c[3] = dec * c[3] + bfhi(uu[1]);
            c[4] = dec * c[4] + bflo(uu[2]); c[5] = dec * c[5] + bfhi(uu[2]); c[6] = dec * c[6] + bflo(uu[3]); c[7] = dec * c[7] + bfhi(uu[3]);
            nn = dec * nn + un;
        }
    }
}
DI void mlstm_h_unit(const Params& p, int layer, int u, LAS unsigned char* lds) {
    const int tid = ltid(), lane = tid & 63, wave = __builtin_amdgcn_readfirstlane(tid >> 6), g = lane >> 4, c = lane & 15;
    const int b = u / (4 * 68), h = (u / 68) & 3, cc = u % 68; const bool isctx = cc < 4; const int ck = isctx ? cc : cc - 4;
    const int tok0 = isctx ? ML + b * 256 + ck * 64 : b * 4096 + ck * 64;
    constexpr int QS = 272, VS = 304, CS = 272;
    LAS unsigned char* Qs = lds; LAS unsigned char* Ks = lds + 64 * QS; LAS unsigned char* Vs = lds + 128 * QS; LAS unsigned char* Cs = Vs + 64 * VS;
    LAS float* G = (LAS float*)(Cs + 2 * 144 * CS);
    const bf16_t* P = wsp<bf16_t>(p, WS_P);
    { const int t = tid >> 3, pc = tid & 7; const bf16_t* row = P + (size_t)(tok0 + t) * NPROJ + h * 128 + pc * 16;
      *(LAS u32x4*)(Qs + t * QS + pc * 32) = *(const u32x4*)(row + PQ); *(LAS u32x4*)(Qs + t * QS + pc * 32 + 16) = *(const u32x4*)(row + PQ + 8);
      *(LAS u32x4*)(Ks + t * QS + pc * 32) = *(const u32x4*)(row + PK); *(LAS u32x4*)(Ks + t * QS + pc * 32 + 16) = *(const u32x4*)(row + PK + 8);
      *(LAS u32x4*)(Vs + t * VS + pc * 32) = *(const u32x4*)(row + PV); *(LAS u32x4*)(Vs + t * VS + pc * 32 + 16) = *(const u32x4*)(row + PV + 8);
      *(LAS unsigned*)(Vs + t * VS + 256 + pc * 4) = pc == 0 ? 0x3F80u : 0u; }
#pragma unroll
    for (int dir = 0; dir < 2; ++dir) {
        const int ch = (dir * 8 + b) * 4 + h; const int j = dir == 0 ? (isctx ? ck : 4 + ck) : (isctx ? 3 - ck : 67 - ck); const size_t slot = (size_t)ch * NSLOT + j;
        const u32x4* src = (const u32x4*)(wsp<bf16_t>(p, WS_UC) + slot * 16384); LAS unsigned char* Cd = Cs + dir * 144 * CS;
#pragma unroll
        for (int k = 0; k < 4; ++k) { const int idx = tid + 512 * k; *(LAS u32x4*)(Cd + (idx >> 4) * CS + (idx & 15) * 16) = src[idx]; }
        if (tid < 64) { const float* nv = wsp<float>(p, WS_UN) + slot * 128 + 2 * tid; *(LAS unsigned*)(Cd + 128 * CS + tid * 4) = pk2(nv[0], nv[1]); }
        for (int idx = tid; idx < 960; idx += 512) *(LAS unsigned*)(Cd + (129 + (idx >> 6)) * CS + (idx & 63) * 4) = 0u;
        if (tid >= 256 && tid < 320) { const int s = tid - 256, tau = dir ? 63 - s : s; const float mprev = chain_m_wave(p, ch, j, s);
            const float a = wsp<float>(p, WS_GA)[slot * 64 + tau], cm = wsp<float>(p, WS_GCM)[slot * 64 + tau], bb = wsp<float>(p, WS_GB)[slot * 64 + tau]; const float Mt = fmaxf(mprev, cm);
            LAS float* Gd = G + dir * 256; Gd[s] = a; Gd[64 + s] = Mt; Gd[128 + s] = __expf(mprev - Mt); Gd[192 + s] = __expf(-(bb + Mt)); }
    }
    __syncthreads();
    const int dir = wave >> 2, tb = wave & 3, t = 16 * tb + c;
    const LAS float* Gd = G + dir * 256; const float Mt = Gd[64 + t], wi = Gd[128 + t], fl = Gd[192 + t];
    bf16x8 qf[4];
#pragma unroll
    for (int kk = 0; kk < 4; ++kk) qf[kk] = *(const LAS bf16x8*)(Qs + t * QS + (kk * 32 + g * 8) * 2);
    f32x4 acc[9];
    { const LAS unsigned char* Cd = Cs + dir * 144 * CS;
#pragma unroll
      for (int vb = 0; vb < 9; ++vb) { f32x4 a = (f32x4){0.f, 0.f, 0.f, 0.f};
#pragma unroll
          for (int kk = 0; kk < 4; ++kk) a = MFMA16(*(const LAS bf16x8*)(Cd + (16 * vb + c) * CS + (kk * 32 + g * 8) * 2), qf[kk], a);
          acc[vb] = a * wi; } }
#pragma unroll
    for (int pr = 0; pr < 2; ++pr) {
        const bool needed = dir == 0 ? (2 * pr <= tb) : (2 * pr + 1 >= tb);
        if (needed) {
            f32x4 sA = (f32x4){0.f, 0.f, 0.f, 0.f}, sB = sA;
#pragma unroll
            for (int kk = 0; kk < 4; ++kk) { sA = MFMA16(*(const LAS bf16x8*)(Ks + (32 * pr + c) * QS + (kk * 32 + g * 8) * 2), qf[kk], sA); sB = MFMA16(*(const LAS bf16x8*)(Ks + (32 * pr + 16 + c) * QS + (kk * 32 + g * 8) * 2), qf[kk], sB); }
            float pA[4], pB[4];
#pragma unroll
            for (int i = 0; i < 4; ++i) { const int sa = 32 * pr + 4 * g + i, sb = sa + 16;
                const bool vA = dir == 0 ? (sa <= t) : (sa >= t), vB = dir == 0 ? (sb <= t) : (sb >= t);
                pA[i] = vA ? sA[i] * __expf(Gd[sa] - Mt) : 0.f; pB[i] = vB ? sB[i] * __expf(Gd[sb] - Mt) : 0.f; }
            const bf16x8 pf = pack_frag(pA, pB);
#pragma unroll
            for (int vb = 0; vb < 9; ++vb) { const int o = (32 * pr + 4 * g + (c >> 2)) * VS + (16 * vb + 4 * (c & 3)) * 2; acc[vb] = MFMA16(tr_frag(Vs, o, o + 16 * VS), pf, acc[vb]); }
        }
    }
    { const float den = __shfl(acc[8][0], c); const float inv = 1.0f / fmaxf(fabsf(den), fl);
#pragma unroll
      for (int vb = 0; vb < 8; ++vb) acc[vb] = acc[vb] * inv; }
    __syncthreads();
    LAS float* Hx = (LAS float*)lds;
    if (dir == 1) {
#pragma unroll
        for (int vb = 0; vb < 8; ++vb) *(LAS f32x4*)(Hx + t * 132 + 16 * vb + 4 * g) = acc[vb]; }
    __syncthreads();
    if (dir == 0) {
        float s = 0.f;
#pragma unroll
        for (int vb = 0; vb < 8; ++vb) { acc[vb] = acc[vb] + *(const LAS f32x4*)(Hx + t * 132 + 16 * vb + 4 * g); s += (acc[vb][0] + acc[vb][1]) + (acc[vb][2] + acc[vb][3]); }
        s += __shfl_xor(s, 16); s += __shfl_xor(s, 32); const float mean = s * (1.0f / 128.0f); float q = 0.f;
#pragma unroll
        for (int vb = 0; vb < 8; ++vb) { const f32x4 d = acc[vb] - mean; q += (d[0] * d[0] + d[1] * d[1]) + (d[2] * d[2] + d[3] * d[3]); }
        q += __shfl_xor(q, 16); q += __shfl_xor(q, 32); const float rstd = 1.0f / sqrtf(q * (1.0f / 128.0f) + LN_EPS);
        const size_t tok = (size_t)(tok0 + t); const float* ng = SMP(SM_NORMG) + (size_t)layer * 512 + h * 128;
#pragma unroll
        for (int vb = 0; vb < 8; ++vb) { const int v0 = 16 * vb + 4 * g; const f32x4 gg = *(const f32x4*)(ng + v0); const u32x2 ow = *(const u32x2*)(P + tok * NPROJ + PO + h * 128 + v0);
            const f32x4 r = (acc[vb] - mean) * rstd * gg * (f32x4){bflo(ow[0]), bfhi(ow[0]), bflo(ow[1]), bfhi(ow[1])};
            *(u32x2*)(wsp<bf16_t>(p, WS_ABC) + tok * 1536 + h * 128 + v0) = (u32x2){cvt_pk_bf16(r[0], r[1]), cvt_pk_bf16(r[2], r[3])}; }
    }
    __syncthreads();
}

DI int na_koff(int key, int chunk) { return key * 128 + ((chunk ^ (key & 7)) << 4); }
#define NA_STEP(KEYA, KEYB, MASKED, BROW) do { \
        f32x4 sA = (f32x4){0.f, 0.f, 0.f, 0.f}, sB = sA; \
        _Pragma("unroll") for (int kk = 0; kk < 2; ++kk) { sA = MFMA16(*(const LAS bf16x8*)(KL + na_koff((KEYA) + c, kk * 4 + g)), qf[kk], sA); sB = MFMA16(*(const LAS bf16x8*)(KL + na_koff((KEYB) + c, kk * 4 + g)), qf[kk], sB); } \
        float xa[4], xb[4]; float mx = -1.0e30f; \
        _Pragma("unroll") for (int i = 0; i < 4; ++i) { xa[i] = sA[i]; xb[i] = sB[i]; if (MASKED) { xa[i] += T[(BROW) + idxA[i]]; xb[i] += T[(BROW) + idxB[i]]; } mx = fmaxf(mx, fmaxf(xa[i], xb[i])); } \
        mx = fmaxf(mx, __shfl_xor(mx, 16)); mx = fmaxf(mx, __shfl_xor(mx, 32)); \
        const float mn = fmaxf(m, mx), al = __builtin_amdgcn_exp2f(m - mn); m = mn; float ps = 0.f; \
        _Pragma("unroll") for (int i = 0; i < 4; ++i) { xa[i] = __builtin_amdgcn_exp2f(xa[i] - mn); xb[i] = __builtin_amdgcn_exp2f(xb[i] - mn); ps += xa[i] + xb[i]; } \
        l = l * al + ps; const bf16x8 pf = pack_frag(xa, xb); \
        _Pragma("unroll") for (int db = 0; db < 4; ++db) { const int ka = (KEYA) + 4 * g + (c >> 2), kb2 = (KEYB) + 4 * g + (c >> 2), chk = 2 * db + ((c & 3) >> 1), by = 8 * (c & 1); \
            acc[db] = MFMA16(tr_frag(VL, na_koff(ka, chk) + by, na_koff(kb2, chk) + by), pf, acc[db] * al); } \
    } while (0)
DI void na_ctx_unit(const Params& p, int u, LAS unsigned char* lds) {
    const int tid = ltid(), lane = tid & 63, wave = __builtin_amdgcn_readfirstlane(tid >> 6), g = lane >> 4, c = lane & 15;
    const int b = u >> 5, h = (u >> 2) & 7, qb = u & 3, ct = wave & 3, half = wave >> 2;
    const int tokq = ML + b * 256 + qb * 64 + 16 * ct + c;
    const bf16_t* P = wsp<bf16_t>(p, WS_P);
    LAS unsigned char* KL = lds; LAS unsigned char* VL = lds + 65536; const LAS float* T = (const LAS float*)lds; const int idxA[4] = {0, 0, 0, 0}, idxB[4] = {0, 0, 0, 0}; (void)T; (void)idxA; (void)idxB;
    bf16x8 qf[2];
#pragma unroll
    for (int kk = 0; kk < 2; ++kk) qf[kk] = *(const bf16x8*)(P + (size_t)tokq * NPROJ + PNQ + h * 64 + kk * 32 + g * 8);
    { const int key = tid >> 1, hf = tid & 1; const bf16_t* row = P + (size_t)(ML + b * 256 + key) * NPROJ + h * 64 + hf * 32;
#pragma unroll
      for (int q = 0; q < 4; ++q) { *(LAS u32x4*)(KL + na_koff(key, hf * 4 + q)) = *(const u32x4*)(row + PNK + q * 8); *(LAS u32x4*)(VL + na_koff(key, hf * 4 + q)) = *(const u32x4*)(row + PNV + q * 8); } }
    __syncthreads();
    float m = -1.0e30f, l = 0.f; f32x4 acc[4];
#pragma unroll
    for (int db = 0; db < 4; ++db) acc[db] = (f32x4){0.f, 0.f, 0.f, 0.f};
#pragma unroll 1
    for (int st = 0; st < 4; ++st) { const int k0 = 128 * half + 32 * st; NA_STEP(k0, k0 + 16, false, 0); }
    __syncthreads();
    l += __shfl_xor(l, 16); l += __shfl_xor(l, 32);
    LAS float* X = (LAS float*)lds + (ct * 64 + lane) * 20;
    if (half == 1) { X[0] = m; X[1] = l;
#pragma unroll
        for (int db = 0; db < 4; ++db) *(LAS f32x4*)(X + 4 + 4 * db) = acc[db]; }
    __syncthreads();
    if (half == 0) { const float m1 = X[0], l1 = X[1]; const float mn = fmaxf(m, m1), e0 = __builtin_amdgcn_exp2f(m - mn), e1 = __builtin_amdgcn_exp2f(m1 - mn); const float inv = 1.0f / (l * e0 + l1 * e1);
#pragma unroll
        for (int db = 0; db < 4; ++db) { const f32x4 o = (acc[db] * e0 + *(const LAS f32x4*)(X + 4 + 4 * db) * e1) * inv;
            *(u32x2*)(wsp<bf16_t>(p, WS_ABC) + (size_t)tokq * 1536 + 512 + h * 64 + 16 * db + 4 * g) = (u32x2){cvt_pk_bf16(o[0], o[1]), cvt_pk_bf16(o[2], o[3])}; } }
    __syncthreads();
}
DI void na_lat_unit(const Params& p, int layer, int u, LAS unsigned char* lds) {
    const int tid = ltid(), lane = tid & 63, wave = __builtin_amdgcn_readfirstlane(tid >> 6), g = lane >> 4, c = lane & 15;
    const int b = u >> 6, h = (u >> 3) & 7, r0 = (u & 7) * 8, ct = wave & 3, half = wave >> 2;
    const bf16_t* P = wsp<bf16_t>(p, WS_P);
    LAS unsigned char* KL = lds; LAS unsigned char* VL = lds + 65536; LAS float* T = (LAS float*)(lds + 131072); LAS unsigned* X = (LAS unsigned*)(lds + 131072 + 2048) + (ct * 64 + lane) * 10;
    const bf16_t* Qb = P + (size_t)(b * 4096 + 16 * ct + c) * NPROJ + PNQ + h * 64 + g * 8;
    { const int key = tid >> 1, hf = tid & 1; const bf16_t* row = P + (size_t)(ML + b * 256 + key) * NPROJ + h * 64 + hf * 32;
#pragma unroll
      for (int q = 0; q < 4; ++q) { *(LAS u32x4*)(KL + na_koff(key, hf * 4 + q)) = *(const u32x4*)(row + PNK + q * 8); *(LAS u32x4*)(VL + na_koff(key, hf * 4 + q)) = *(const u32x4*)(row + PNV + q * 8); }
      if (tid < 480) { const int e = tid & 31; T[tid] = e < 31 ? SMP(SM_RPB)[(((size_t)layer * 8 + h) * 15 + (tid >> 5)) * 31 + e] * 1.4426950408889634f : -1.0e30f; } }
    __syncthreads();
    const int qc = 16 * ct + c, cs = min(max(qc - 8, 0), 48), c0 = ct == 0 ? 0 : ct == 1 ? 8 : ct == 2 ? 24 : 32;
    int idxA[4], idxB[4];
#pragma unroll
    for (int i = 0; i < 4; ++i) { const int kcA = c0 + 4 * g + i, kcB = kcA + 16; idxA[i] = (kcA >= cs && kcA < cs + 16) ? kcA - qc + 15 : 31; idxB[i] = (kcB >= cs && kcB < cs + 16) ? kcB - qc + 15 : 31; }
    float sm[4], sl[4]; f32x4 sacc[4][4];
#pragma unroll
    for (int k = 0; k < 4; ++k) {
        bf16x8 qf[2];
#pragma unroll
        for (int kk = 0; kk < 2; ++kk) qf[kk] = *(const bf16x8*)(Qb + (size_t)(r0 + 2 * k + half) * 64 * NPROJ + kk * 32);
        float m = -1.0e30f, l = 0.f; f32x4 acc[4];
#pragma unroll
        for (int db = 0; db < 4; ++db) acc[db] = (f32x4){0.f, 0.f, 0.f, 0.f};
#pragma unroll 4
        for (int st = 0; st < 8; ++st) { const int k0 = 32 * st; NA_STEP(k0, k0 + 16, false, 0); }
        sm[k] = m; sl[k] = l;
#pragma unroll
        for (int db = 0; db < 4; ++db) sacc[k][db] = acc[db];
    }
    __syncthreads();
    { const int rs0 = min(max(r0 - 4, 0), 56), kr = rs0 + (tid >> 6), key = (kr & 7) * 64 + (tid & 63); const bf16_t* row = P + (size_t)(b * 4096 + kr * 64 + (tid & 63)) * NPROJ + h * 64;
#pragma unroll
      for (int q = 0; q < 8; ++q) { *(LAS u32x4*)(KL + na_koff(key, q)) = *(const u32x4*)(row + PNK + q * 8); *(LAS u32x4*)(VL + na_koff(key, q)) = *(const u32x4*)(row + PNV + q * 8); } }
    bf16x8 qf[2];
#pragma unroll
    for (int kk = 0; kk < 2; ++kk) qf[kk] = *(const bf16x8*)(Qb + (size_t)r0 * 64 * NPROJ + kk * 32);
    __syncthreads();
#pragma unroll 1
    for (int jp = 0; jp < 4; ++jp) {
#pragma unroll
        for (int jj = 0; jj < 2; ++jj) {
            const int j = 2 * jp + jj, r = r0 + j, rs = min(max(r - 4, 0), 56);
            const bool pfetch = (j < 7) && (min(max(r - 3, 0), 56) != rs);
            u32x4 nk = (u32x4){0u, 0u, 0u, 0u}, nv = nk;
            if (pfetch) { const bf16_t* row = P + (size_t)(b * 4096 + (rs + 8) * 64 + (tid >> 3)) * NPROJ + h * 64 + (tid & 7) * 8; nk = *(const u32x4*)(row + PNK); nv = *(const u32x4*)(row + PNV); }
            bf16x8 qn[2];
#pragma unroll
            for (int kk = 0; kk < 2; ++kk) qn[kk] = *(const bf16x8*)(Qb + (size_t)min(r + 1, r0 + 7) * 64 * NPROJ + kk * 32);
            const bool holder = (half == jj);
            float m = holder ? sm[0] : -1.0e30f, l = holder ? sl[0] : 0.f; f32x4 acc[4];
#pragma unroll
            for (int db = 0; db < 4; ++db) acc[db] = holder ? sacc[0][db] : (f32x4){0.f, 0.f, 0.f, 0.f};
#pragma unroll
            for (int st = 0; st < 4; ++st) { const int kr = rs + 4 * half + st; const int k0 = (kr & 7) * 64 + c0; NA_STEP(k0, k0 + 16, true, (kr - r + 7) * 32); }
            l += __shfl_xor(l, 16); l += __shfl_xor(l, 32);
            if (half == 1) { X[0] = __builtin_bit_cast(unsigned, m); X[1] = __builtin_bit_cast(unsigned, l);
#pragma unroll
                for (int db = 0; db < 4; ++db) { X[2 + 2 * db] = cvt_pk_bf16(acc[db][0], acc[db][1]); X[3 + 2 * db] = cvt_pk_bf16(acc[db][2], acc[db][3]); } }
            __syncthreads();
            if (half == 0) { const float m1 = __builtin_bit_cast(float, X[0]), l1 = __builtin_bit_cast(float, X[1]); const float mn = fmaxf(m, m1), e0 = __builtin_amdgcn_exp2f(m - mn), e1 = __builtin_amdgcn_exp2f(m1 - mn);
                const float inv = 1.0f / (l * e0 + l1 * e1); const size_t tokq = (size_t)(b * 4096 + r * 64 + qc);
#pragma unroll
                for (int db = 0; db < 4; ++db) { const unsigned w0 = X[2 + 2 * db], w1 = X[3 + 2 * db]; const f32x4 o1 = (f32x4){bflo(w0), bfhi(w0), bflo(w1), bfhi(w1)}; const f32x4 o = (acc[db] * e0 + o1 * e1) * inv;
                    *(u32x2*)(wsp<bf16_t>(p, WS_ABC) + tokq * 1536 + 512 + h * 64 + 16 * db + 4 * g) = (u32x2){cvt_pk_bf16(o[0], o[1]), cvt_pk_bf16(o[2], o[3])}; } }
            if (pfetch) { const int key = (rs & 7) * 64 + (tid >> 3); *(LAS u32x4*)(KL + na_koff(key, tid & 7)) = nk; *(LAS u32x4*)(VL + na_koff(key, tid & 7)) = nv; }
            qf[0] = qn[0]; qf[1] = qn[1];
            __syncthreads();
        }
#pragma unroll
        for (int k = 0; k < 3; ++k) { sm[k] = sm[k + 1]; sl[k] = sl[k + 1];
#pragma unroll
            for (int db = 0; db < 4; ++db) sacc[k][db] = sacc[k + 1][db]; }
    }
}
#undef NA_STEP

DI void sgu_unit(const Params& p, int layer, int u, LAS unsigned char* lds) {
    const int tid = ltid(), lane = tid & 63, wave = __builtin_amdgcn_readfirstlane(tid >> 6), g = lane >> 4, c = lane & 15;
    const int g4 = u & 3, n = (u >> 2) % 34, b = (u >> 2) / 34;
    const int tok0 = n < 32 ? b * 4096 + n * 128 : ML + b * 256 + (n - 32) * 128;
    constexpr int RS = 272;
    LAS unsigned char* vn = lds; LAS unsigned char* Wl = lds + 128 * RS; LAS float* st = (LAS float*)(lds + 256 * RS);
    const bf16_t* P = wsp<bf16_t>(p, WS_P);
    u32x4 wv[16];
#pragma unroll
    for (int i = 0; i < 16; ++i) wv[i] = *(const u32x4*)(P + (size_t)(tok0 + wave * 16 + i) * NPROJ + PSV + lane * 8);
#pragma unroll
    for (int i = 0; i < 16; ++i) { const int pp = wave * 16 + i; const u32x4 w = wv[i];
        const float x[8] = {bflo(w[0]), bfhi(w[0]), bflo(w[1]), bfhi(w[1]), bflo(w[2]), bfhi(w[2]), bflo(w[3]), bfhi(w[3])}; float s = 0.f;
#pragma unroll
        for (int e = 0; e < 8; ++e) s += x[e];
        const float mean = wave_sum(s) * (1.0f / 512.0f); float q = 0.f;
#pragma unroll
        for (int e = 0; e < 8; ++e) q += (x[e] - mean) * (x[e] - mean);
        const float rstd = 1.0f / sqrtf(wave_sum(q) * (1.0f / 512.0f) + LN_EPS);
        if (lane == 0) { st[pp * 2] = mean; st[pp * 2 + 1] = rstd; } }
    __syncthreads();
    { const int pp = tid >> 2, pc = tid & 3; const float mean = st[pp * 2], rstd = st[pp * 2 + 1];
      const float* lg = SMP(SM_SGLNG) + (size_t)layer * 512 + g4 * 128 + pc * 32; const float* lb = SMP(SM_SGLNB) + (size_t)layer * 512 + g4 * 128 + pc * 32;
      const bf16_t* src = P + (size_t)(tok0 + pp) * NPROJ + PSV + g4 * 128 + pc * 32;
      const float* wsrc = SMP(SM_SGW) + (((size_t)layer * 4 + g4) * 128 + pp) * 128 + pc * 32;
#pragma unroll
      for (int q = 0; q < 4; ++q) { const u32x4 w = *(const u32x4*)(src + q * 8); const f32x4 g0 = *(const f32x4*)(lg + q * 8), g1 = *(const f32x4*)(lg + q * 8 + 4), b0 = *(const f32x4*)(lb + q * 8), b1 = *(const f32x4*)(lb + q * 8 + 4);
          const f32x4 x0 = ((f32x4){bflo(w[0]), bfhi(w[0]), bflo(w[1]), bfhi(w[1])} - mean) * rstd * g0 + b0, x1 = ((f32x4){bflo(w[2]), bfhi(w[2]), bflo(w[3]), bfhi(w[3])} - mean) * rstd * g1 + b1;
          *(LAS u32x4*)(vn + pp * RS + pc * 64 + q * 16) = pack8(x0, x1);
          const f32x4 w0 = *(const f32x4*)(wsrc + q * 8), w1 = *(const f32x4*)(wsrc + q * 8 + 4); *(LAS u32x4*)(Wl + pp * RS + pc * 64 + q * 16) = pack8(w0, w1); } }
    __syncthreads();
    bf16x8 wf[4];
#pragma unroll
    for (int kk = 0; kk < 4; ++kk) wf[kk] = *(const LAS bf16x8*)(Wl + (16 * wave + c) * RS + (kk * 32 + g * 8) * 2);
    const size_t tok = (size_t)(tok0 + 16 * wave + c); const float bs = SMP(SM_SGB)[((size_t)layer * 4 + g4) * 128 + 16 * wave + c];
#pragma unroll
    for (int cb = 0; cb < 8; ++cb) { f32x4 acc = (f32x4){0.f, 0.f, 0.f, 0.f};
#pragma unroll
        for (int kk = 0; kk < 4; ++kk) { const int o = (32 * kk + 8 * g + (c >> 2)) * RS + (16 * cb + 4 * (c & 3)) * 2; acc = MFMA16(tr_frag(vn, o, o + 4 * RS), wf[kk], acc); }
        const u32x2 uw = *(const u32x2*)(P + tok * NPROJ + PSU + g4 * 128 + 16 * cb + 4 * g);
        const f32x4 o = (f32x4){bflo(uw[0]), bfhi(uw[0]), bflo(uw[1]), bfhi(uw[1])} * (acc + bs);
        *(u32x2*)(wsp<bf16_t>(p, WS_ABC) + tok * 1536 + 1024 + g4 * 128 + 16 * cb + 4 * g) = (u32x2){cvt_pk_bf16(o[0], o[1]), cvt_pk_bf16(o[2], o[3])}; }
    __syncthreads();
}

DI void mlstm_u_unit_naive(const Params& p, int u, LAS unsigned char* lds) {
    const int tid = ltid(), ch = u / (NSLOT - 1), j = u % (NSLOT - 1), dir = ch >> 5, b = (ch >> 2) & 7, h = ch & 3;
    LAS float* Vs = (LAS float*)lds; LAS float* Ks = Vs + 64 * 128;
    const float mj = chain_m(p, ch, j);
    const float Mend = fmaxf(mj, wsp<float>(p, WS_GCM)[((size_t)ch * NSLOT + j) * 64 + 63]);
    const bf16_t* P = wsp<bf16_t>(p, WS_P);
    for (int i = tid; i < 64 * 128; i += 512) { const int tau = i >> 7, d = i & 127; const int tok = chain_tok(dir, b, j, tau);
        const float w = __expf(wsp<float>(p, WS_GA)[((size_t)ch * NSLOT + j) * 64 + tau] - Mend);
        Vs[i] = bf2f(P[(size_t)tok * NPROJ + PV + h * 128 + d]); Ks[i] = w * bf2f(P[(size_t)tok * NPROJ + PK + h * 128 + d]); }
    __syncthreads();
    { const int v = tid >> 2, d0 = (tid & 3) * 32; float acc[32];
#pragma unroll
      for (int i = 0; i < 32; ++i) acc[i] = 0.f;
      for (int tau = 0; tau < 64; ++tau) { const float vv = Vs[tau * 128 + v];
#pragma unroll
          for (int i = 0; i < 32; ++i) acc[i] += vv * Ks[tau * 128 + d0 + i]; }
      bf16_t* dst = wsp<bf16_t>(p, WS_UC) + (((size_t)ch * NSLOT + j) * 128 + v) * 128 + d0;
#pragma unroll
      for (int i = 0; i < 32; i += 2) *(unsigned*)(dst + i) = pk2(acc[i], acc[i + 1]); }
    if (tid < 128) { float s = 0.f; for (int tau = 0; tau < 64; ++tau) s += Ks[tau * 128 + tid]; wsp<float>(p, WS_UN)[((size_t)ch * NSLOT + j) * 128 + tid] = s; }
    __syncthreads();
}
DI void mlstm_h_unit_naive(const Params& p, int layer, int u, LAS unsigned char* lds) {
    const int tid = ltid(), b = u / (4 * 68), h = (u / 68) & 3, cc = u % 68;
    const bool isctx = cc < 4; const int ck = isctx ? cc : cc - 4;
    const int tok0 = isctx ? ML + b * 256 + ck * 64 : b * 4096 + ck * 64;
    LAS float* Qs = (LAS float*)lds; LAS float* Ks = Qs + 64 * 129; LAS float* Vs = Ks + 64 * 129;
    LAS float* Ss = Vs + 64 * 129;
    LAS float* aux = Ss + 64 * 65;
    const bf16_t* P = wsp<bf16_t>(p, WS_P);
    for (int i = tid; i < 64 * 128; i += 512) { const int t = i >> 7, d = i & 127; const size_t o = (size_t)(tok0 + t) * NPROJ + h * 128 + d;
        Qs[t * 129 + d] = bf2f(P[o + PQ]); Ks[t * 129 + d] = bf2f(P[o + PK]); Vs[t * 129 + d] = bf2f(P[o + PV]); }
    __syncthreads();
    float hacc[16];
#pragma unroll
    for (int i = 0; i < 16; ++i) hacc[i] = 0.f;
    const int t = tid >> 3, sg = tid & 7, v0 = sg * 16;
    for (int dir = 0; dir < 2; ++dir) {
        const int ch = (dir * 8 + b) * 4 + h; const int j = dir == 0 ? (isctx ? ck : 4 + ck) : (isctx ? 3 - ck : 67 - ck);
        const float mprev = chain_m(p, ch, j);
        const float* ga = wsp<float>(p, WS_GA) + ((size_t)ch * NSLOT + j) * 64; const float* gcm = wsp<float>(p, WS_GCM) + ((size_t)ch * NSLOT + j) * 64; const float* gbv = wsp<float>(p, WS_GB) + ((size_t)ch * NSLOT + j) * 64;
        const bf16_t* C = wsp<bf16_t>(p, WS_UC) + ((size_t)ch * NSLOT + j) * 16384; const float* nvec = wsp<float>(p, WS_UN) + ((size_t)ch * NSLOT + j) * 128;
        { const int taut = dir ? 63 - t : t; const float Mt = fmaxf(mprev, gcm[taut]);
          for (int s = sg; s < 64; s += 8) { const int taus = dir ? 63 - s : s; float v = 0.f;
              if (taus <= taut) { float dsum = 0.f; for (int d = 0; d < 128; ++d) dsum += Qs[t * 129 + d] * Ks[s * 129 + d]; v = dsum * __expf(ga[taus] - Mt); }
              Ss[t * 65 + s] = v; }
          if (sg == 0) { float dn = 0.f; for (int d = 0; d < 128; ++d) dn += Qs[t * 129 + d] * nvec[d]; aux[t] = __expf(mprev - Mt); aux[64 + t] = dn; aux[128 + t] = __expf(-(gbv[taut] + Mt)); } }
        __syncthreads();
        { const float wi = aux[t];
          float den = wi * aux[64 + t]; for (int s = 0; s < 64; ++s) den += Ss[t * 65 + s];
          const float dd = fmaxf(fabsf(den), aux[128 + t]);
#pragma unroll 1
          for (int vv = 0; vv < 16; ++vv) { const int v = v0 + vv; float num = 0.f;
              for (int s = 0; s < 64; ++s) num += Ss[t * 65 + s] * Vs[s * 129 + v];
              float cq = 0.f; const u32x4* cr = (const u32x4*)(C + (size_t)v * 128);
              for (int d8 = 0; d8 < 16; ++d8) { const u32x4 w = cr[d8]; const LAS float* qq = Qs + t * 129 + d8 * 8;
                  cq += bflo(w[0]) * qq[0] + bfhi(w[0]) * qq[1] + bflo(w[1]) * qq[2] + bfhi(w[1]) * qq[3] + bflo(w[2]) * qq[4] + bfhi(w[2]) * qq[5] + bflo(w[3]) * qq[6] + bfhi(w[3]) * qq[7]; }
              const float val = (num + wi * cq) / dd;
#pragma unroll
              for (int k = 0; k < 16; ++k) if (k == vv) hacc[k] += val; } }
        __syncthreads();
    }
    { float s = 0.f;
#pragma unroll
      for (int i = 0; i < 16; ++i) s += hacc[i];
      s += __shfl_xor(s, 1); s += __shfl_xor(s, 2); s += __shfl_xor(s, 4);
      const float mean = s * (1.0f / 128.0f); float q = 0.f;
#pragma unroll
      for (int i = 0; i < 16; ++i) { const float d = hacc[i] - mean; q += d * d; }
      q += __shfl_xor(q, 1); q += __shfl_xor(q, 2); q += __shfl_xor(q, 4);
      const float rstd = 1.0f / sqrtf(q * (1.0f / 128.0f) + LN_EPS);
      const size_t tok = (size_t)(tok0 + t); const float* ng = SMP(SM_NORMG) + (size_t)layer * 512 + h * 128 + v0;
      const u32x4* op = (const u32x4*)(P + tok * NPROJ + PO + h * 128 + v0); const u32x4 o0 = op[0], o1 = op[1];
      const float og[16] = {bflo(o0[0]), bfhi(o0[0]), bflo(o0[1]), bfhi(o0[1]), bflo(o0[2]), bfhi(o0[2]), bflo(o0[3]), bfhi(o0[3]), bflo(o1[0]), bfhi(o1[0]), bflo(o1[1]), bfhi(o1[1]), bflo(o1[2]), bfhi(o1[2]), bflo(o1[3]), bfhi(o1[3])};
      float r[16];
#pragma unroll
      for (int i = 0; i < 16; ++i) r[i] = (hacc[i] - mean) * rstd * ng[i] * og[i];
      u32x4* dst = (u32x4*)(wsp<bf16_t>(p, WS_ABC) + tok * 1536 + h * 128 + v0);
      dst[0] = (u32x4){pk2(r[0], r[1]), pk2(r[2], r[3]), pk2(r[4], r[5]), pk2(r[6], r[7])}; dst[1] = (u32x4){pk2(r[8], r[9]), pk2(r[10], r[11]), pk2(r[12], r[13]), pk2(r[14], r[15])}; }
    __syncthreads();
}

DI void na_task(const Params& p, int layer, int task, LAS float* ws  ) {
    const int lane = ltid() & 63; const int row = task >> 3, hd = task & 7;
    const bf16_t* P = wsp<bf16_t>(p, WS_P);
    const bool latent = row < ML; const int b = latent ? row >> 12 : (row - ML) >> 8;
    ws[lane] = bf2f(P[(size_t)row * NPROJ + PNQ + hd * 64 + lane]);
    asm volatile("s_waitcnt lgkmcnt(0)" ::: "memory");
    int r = 0, qc = 0, rs = 0, cs = 0;
    if (latent) { const int t = row & 4095; r = t >> 6; qc = t & 63; rs = min(max(r - 4, 0), 56); cs = min(max(qc - 8, 0), 48); }
    const int nkeys = latent ? 384 : 256;
    float sc[6]; float mx = -3.0e38f;
#pragma unroll
    for (int i = 0; i < 6; ++i) { const int kk = lane + 64 * i; sc[i] = -3.0e38f;
        if (kk < nkeys) { int krow; float bias = 0.f;
            if (latent && kk < 128) { const int kr = rs + (kk >> 4), kc = cs + (kk & 15); krow = b * 4096 + kr * 64 + kc; bias = SMP(SM_RPB)[(((size_t)layer * 8 + hd) * 15 + (kr - r + 7)) * 31 + (kc - qc + 15)]; }
            else krow = ML + b * 256 + (latent ? kk - 128 : kk);
            const u32x4* kp = (const u32x4*)(P + (size_t)krow * NPROJ + PNK + hd * 64); float s = 0.f;
#pragma unroll
            for (int c8 = 0; c8 < 8; ++c8) { const u32x4 w = kp[c8];
#pragma unroll
                for (int e = 0; e < 4; ++e) s += bflo(w[e]) * ws[c8 * 8 + 2 * e] + bfhi(w[e]) * ws[c8 * 8 + 2 * e + 1]; }
            sc[i] = s + bias; mx = fmaxf(mx, sc[i]); } }
    mx = wave_max(mx); float sum = 0.f;
#pragma unroll
    for (int i = 0; i < 6; ++i) { const int kk = lane + 64 * i; if (kk < nkeys) { const float e = __expf(sc[i] - mx); sum += e; ws[64 + kk] = e; } }
    sum = wave_sum(sum);
    asm volatile("s_waitcnt lgkmcnt(0)" ::: "memory");
    float o = 0.f;
    for (int kk = 0; kk < nkeys; ++kk) { int krow;
        if (latent && kk < 128) krow = b * 4096 + (rs + (kk >> 4)) * 64 + cs + (kk & 15); else krow = ML + b * 256 + (latent ? kk - 128 : kk);
        o += ws[64 + kk] * bf2f(P[(size_t)krow * NPROJ + PNV + hd * 64 + lane]); }
    wsp<bf16_t>(p, WS_ABC)[(size_t)row * 1536 + 512 + hd * 64 + lane] = (bf16_t)f2bf(o / sum);
}

DI void sgu_unit_naive(const Params& p, int layer, int u, LAS unsigned char* lds) {
    const int tid = ltid(), lane = tid & 63, wave = tid >> 6;
    const int g = u & 3, n = (u >> 2) % 34, b = (u >> 2) / 34;
    const int tok0 = n < 32 ? b * 4096 + n * 128 : ML + b * 256 + (n - 32) * 128;
    LAS float* vn = (LAS float*)lds;
    LAS float* wsm = vn + 128 * 128;
    LAS float* st = wsm + 128 * 129;
    const bf16_t* P = wsp<bf16_t>(p, WS_P);
    for (int i = 0; i < 16; ++i) { const int pp = wave * 16 + i; const u32x4 w = *(const u32x4*)(P + (size_t)(tok0 + pp) * NPROJ + PSV + lane * 8);
        const float x[8] = {bflo(w[0]), bfhi(w[0]), bflo(w[1]), bfhi(w[1]), bflo(w[2]), bfhi(w[2]), bflo(w[3]), bfhi(w[3])}; float s = 0.f;
#pragma unroll
        for (int e = 0; e < 8; ++e) s += x[e];
        const float mean = wave_sum(s) * (1.0f / 512.0f); float q = 0.f;
#pragma unroll
        for (int e = 0; e < 8; ++e) q += (x[e] - mean) * (x[e] - mean);
        const float rstd = 1.0f / sqrtf(wave_sum(q) * (1.0f / 512.0f) + LN_EPS);
        if (lane == 0) { st[pp * 2] = mean; st[pp * 2 + 1] = rstd; } }
    __syncthreads();
    const float* lg = SMP(SM_SGLNG) + (size_t)layer * 512 + g * 128; const float* lb = SMP(SM_SGLNB) + (size_t)layer * 512 + g * 128;
    for (int i = tid; i < 128 * 128; i += 512) { const int pp = i >> 7, c = i & 127;
        vn[i] = (bf2f(P[(size_t)(tok0 + pp) * NPROJ + PSV + g * 128 + c]) - st[pp * 2]) * st[pp * 2 + 1] * lg[c] + lb[c];
        wsm[pp * 129 + c] = SMP(SM_SGW)[(((size_t)layer * 4 + g) * 128 + pp) * 128 + c]; }
    __syncthreads();
    { const int q = tid >> 2, c0 = (tid & 3) * 32; float acc[32];
#pragma unroll
      for (int i = 0; i < 32; ++i) acc[i] = 0.f;
      for (int pp = 0; pp < 128; ++pp) { const float w = wsm[q * 129 + pp];
#pragma unroll
          for (int i = 0; i < 32; ++i) acc[i] += w * vn[pp * 128 + c0 + i]; }
      const float bs = SMP(SM_SGB)[((size_t)layer * 4 + g) * 128 + q];
      const size_t tok = (size_t)(tok0 + q);
#pragma unroll
      for (int i = 0; i < 32; i += 2) { const unsigned uu = *(const unsigned*)(P + tok * NPROJ + PSU + g * 128 + c0 + i);
          *(unsigned*)(wsp<bf16_t>(p, WS_ABC) + tok * 1536 + 1024 + g * 128 + c0 + i) = pk2(bflo(uu) * (acc[i] + bs), bfhi(uu) * (acc[i + 1] + bs)); } }
    __syncthreads();
}


#ifndef REP_U
#define REP_U 1
#endif
#ifndef REP_SGU
#define REP_SGU 1
#endif
#ifndef REP_NA
#define REP_NA 1
#endif
#ifndef MF_U
#define MF_U 1
#endif
#ifndef MF_H
#define MF_H 1
#endif
#ifndef MF_NA
#define MF_NA 1
#endif
#ifndef MF_SGU
#define MF_SGU 1
#endif
DI void phase_mix1(const Params& p, int layer, LAS unsigned char* lds) {
    const int G = lgdim(), blk = lbid();
#pragma unroll 1
    for (int r_ = 0; r_ < REP_U; ++r_)
#pragma unroll 1
    for (int u = blk; u < NCHAIN * (NSLOT - 1); u += G) { if (MF_U) mlstm_u_unit(p, u, lds); else mlstm_u_unit_naive(p, u, lds); }
#pragma unroll 1
    for (int r_ = 0; r_ < REP_SGU; ++r_)
#pragma unroll 1
    for (int u = blk; u < NB * 34 * 4; u += G) { if (MF_SGU) sgu_unit(p, layer, u, lds); else sgu_unit_naive(p, layer, u, lds); }
    if (MF_NA) {
        for (int r_ = 0; r_ < REP_NA; ++r_) {
#pragma unroll 1
            for (int u = blk; u < 512; u += G) na_lat_unit(p, layer, u, lds);
            if (layer != DEPTH - 1) {
#pragma unroll 1
                for (int u = blk; u < 256; u += G) na_ctx_unit(p, u, lds); }
        }
    } else { const int wave = ltid() >> 6; LAS float* ws = (LAS float*)lds + wave * 512;
#pragma unroll 1
        for (int t = blk * 8 + wave; t < MT * 8; t += G * 8) na_task(p, layer, t, ws); }
}
DI void phase_mix3(const Params& p, int layer, LAS unsigned char* lds) {
#pragma unroll 1
    for (int u = lbid(); u < NB * 4 * 68; u += lgdim()) { if (MF_H) mlstm_h_unit(p, layer, u, lds); else mlstm_h_unit_naive(p, layer, u, lds); }
}
constexpr int NPH = 2 + 11 * DEPTH;
#ifndef REP_PRO
#define REP_PRO 1
#endif
#ifndef REP_G_IN
#define REP_G_IN 1
#endif
#ifndef REP_G_MO
#define REP_G_MO 1
#endif
#ifndef REP_G_GU
#define REP_G_GU 1
#endif
#ifndef REP_G_DN
#define REP_G_DN 1
#endif
#ifndef REP_MIX1
#define REP_MIX1 1
#endif
#ifndef REP_MIX3
#define REP_MIX3 1
#endif
#ifndef STAMP_MASK
#define STAMP_MASK 0
#endif
#define RUN(rep, call) do { _Pragma("unroll 1") for (int r_ = 0; r_ < (rep); ++r_) { call; } } while (0)
__global__ void __launch_bounds__(512, 2) fwd(Params p) {
    extern __shared__ __attribute__((aligned(16))) unsigned char lds_raw[];
    LAS unsigned char* lds = (LAS unsigned char*)lds_raw;
    volatile LAS unsigned* misc = (volatile LAS unsigned*)(lds + LDS_MISC);
    if (threadIdx.x < 64) misc[threadIdx.x] = 0u;
    __syncthreads();
    XcdBarrier bar = xcd_barrier_post(wsp<unsigned>(p, WS_CTL) + CW_BAR + p.li * XCD_BAR_WORDS, misc);
    const int lo = p.ph_lo, hi = p.ph_hi;
    unsigned long long t_acc = 0ull, t_prev = STAMP_MASK ? (unsigned long long)wall_clock64() : 0ull;
#define STAMP(t) do { if (STAMP_MASK) { const unsigned long long now_ = (unsigned long long)wall_clock64(); if ((STAMP_MASK >> (t)) & 1) t_acc += now_ - t_prev; t_prev = now_; } } while (0)
#define IN(k) (lo <= (k) && (k) < hi)
#define LP ({ Params q_ = p; asm volatile("" : "+s"(q_.z)); q_; })
#define SEAM(k) do { if (IN(k) && IN((k) + 1)) { XcdBarrier b2_ = bar; asm volatile("" : "+s"(b2_.bar), "+s"(b2_.x)); xcd_barrier(b2_); } } while (0)
    if (IN(0)) RUN(REP_PRO, phase_prologue_a(LP, lds));
    SEAM(0); STAMP(0);
    if (IN(1)) phase_init(LP, lds);
    SEAM(1); STAMP(1);
    for (int L = 0; L < DEPTH; ++L) {
        const int b = 2 + 11 * L;
        if (IN(b + 0)) { phase_gates(LP, L); RUN(REP_G_IN, phase_inproj(LP, L, lds)); }
        SEAM(b + 0); STAMP(2);
        if (IN(b + 1)) RUN(REP_MIX1, phase_mix1(LP, L, lds));
        SEAM(b + 1); STAMP(3);
        if (IN(b + 2)) phase_scan(LP);
        SEAM(b + 2); STAMP(4);
        if (IN(b + 3)) RUN(REP_MIX3, phase_mix3(LP, L, lds));
        SEAM(b + 3); STAMP(5);
        if (IN(b + 4)) RUN(REP_G_MO, phase_merge(LP, L, lds));
        SEAM(b + 4); STAMP(6);
        if (IN(b + 5)) RUN(REP_G_MO, phase_outproj(LP, L, lds));
        SEAM(b + 5); STAMP(7);
        if (IN(b + 6)) phase_ln1_router(LP, L, lds);
        SEAM(b + 6); STAMP(8);
        if (IN(b + 7)) phase_scatter(LP, L, lds);
        SEAM(b + 7); STAMP(9);
        if (IN(b + 8)) RUN(REP_G_GU, phase_moe_gu(LP, L, lds));
        SEAM(b + 8); STAMP(10);
        if (IN(b + 9)) RUN(REP_G_DN, phase_moe_dn(LP, L, lds));
        SEAM(b + 9); STAMP(11);
        if (IN(b + 10)) phase_ln2(LP, L, lds);
        SEAM(b + 10); STAMP(12);
    }
    if (STAMP_MASK) { __syncthreads(); if (blockIdx.x == 0 && threadIdx.x == 0) p.out[0] = (float)t_acc * 1.0e-3f; }
#undef IN
#undef SEAM
}

#ifndef N_LAUNCH_MODE
#define N_LAUNCH_MODE 1
#endif
extern "C" void kernel_launch(void* const* d_in, const int* in_sizes, int n_in, void* d_out, int out_size, void* d_ws, size_t ws_size, hipStream_t stream) {
    static int grid = 0;
    if (grid == 0) {
        if (n_in != 26 || ws_size < WS_END) { fprintf(stderr, "kernel_launch: expected 26 inputs and >= %zu bytes of workspace (got %d, %zu)\n", (size_t)WS_END, n_in, ws_size); grid = -1; return; }
        int dev = 0, cus = 0, per_cu = 0;
        if (hipGetDevice(&dev) != hipSuccess || hipDeviceGetAttribute(&cus, hipDeviceAttributeMultiprocessorCount, dev) != hipSuccess) { grid = -1; return; }
        if (hipFuncSetAttribute((const void*)fwd, hipFuncAttributeMaxDynamicSharedMemorySize, LDS_BYTES) != hipSuccess) { fprintf(stderr, "kernel_launch: hipFuncSetAttribute failed\n"); grid = -1; return; }
        if (hipOccupancyMaxActiveBlocksPerMultiprocessor(&per_cu, (const void*)fwd, 512, LDS_BYTES) != hipSuccess || per_cu < 1) fprintf(stderr, "kernel_launch: occupancy query reports %d\n", per_cu);
        (void)hipGetLastError();
        grid = cus;
        if (grid != 256) fprintf(stderr, "kernel_launch: %d CUs; the row phases assume 256 workgroups\n", grid);
        grid = 256;
    }
    if (grid < 0) return;
    (void)hipMemsetAsync((char*)d_ws + WS_CTL, 0, CTL_BYTES, stream);
    Params p{};
    const float** pf = (const float**)&p;
    for (int i = 0; i < 26; ++i) pf[i] = (const float*)d_in[i];
    p.out = (float*)d_out; p.ws = (unsigned char*)d_ws;
#if N_LAUNCH_MODE == 1
    p.ph_lo = 0; p.ph_hi = NPH; p.li = 0; p.pad = 0; p.z = 0;
    hipLaunchKernelGGL(fwd, dim3(grid), dim3(512), LDS_BYTES, stream, p);
#else
    for (int ph = 0; ph < NPH; ++ph) { p.ph_lo = ph; p.ph_hi = ph + 1; p.li = 0; p.pad = 0; p.z = 0; hipLaunchKernelGGL(fwd, dim3(grid), dim3(512), LDS_BYTES, stream, p); }
#endif
    const hipError_t le = hipPeekAtLastError();
    if (le != hipSuccess) fprintf(stderr, "kernel_launch: launch failed: %s\n", hipGetErrorName(le));
}
```
